# Optimizing an MI355X kernel written in HIP

```python
import math
import jax, jax.numpy as jnp
from jax import lax
import numpy as np

D_MODEL = 1024
BATCH = 2
SEQ = 8192
DEPTH = 1
DEC_BATCH = 16
DEC_SEQ = 16
PAST_LEN = 2048

CHUNK = 64
Q_BLOCK = 128
EPS = 1e-6
D_SSD = 512
SSD_HEAD_DIM = 64
N_SSD_HEADS = D_SSD // SSD_HEAD_DIM
N_SSD_GROUPS = 2
SSD_HEADS_PER_GROUP = N_SSD_HEADS // N_SSD_GROUPS
D_STATE = 128
SSD_CONV_W = 4
SSD_CONV_DIM = D_SSD + 2 * N_SSD_GROUPS * D_STATE
D_FOX = 512
FOX_HEAD_DIM = 64
N_FOX_HEADS = D_FOX // FOX_HEAD_DIM
FOX_SCALE = FOX_HEAD_DIM ** -0.5
D_MIX = D_SSD + D_FOX
IN_COLS = D_SSD + SSD_CONV_DIM + N_SSD_HEADS + 3 * D_FOX + N_FOX_HEADS
D_FF = 2816
FFN_CONV_W = 3

kernel_name = 'hymba_ssd_fox_convffn_stream_step'


def rmsnorm(x, g):
    xf = x.astype(jnp.float32)
    y = xf * lax.rsqrt(jnp.mean(xf * xf, axis=-1, keepdims=True) + EPS)
    return (y * g.astype(jnp.float32)).astype(x.dtype)


def causal_dwconv(x, prev, w, b):
    L = x.shape[1]
    xp = jnp.concatenate([prev.astype(x.dtype), x], axis=1)
    y = b.astype(x.dtype)
    for j in range(w.shape[0]):
        y = y + xp[:, j:j + L] * w[j].astype(x.dtype)
    return y, xp[:, L:]


def split_columns(u):
    sizes = (D_SSD, SSD_CONV_DIM, N_SSD_HEADS, D_FOX, D_FOX, D_FOX, N_FOX_HEADS)
    out, off = [], 0
    for s in sizes:
        out.append(u[..., off:off + s])
        off += s
    return out


def ssd_scan(xs, dt, a, bm, cm, s0):
    b, L, h, p = xs.shape
    n = bm.shape[-1]
    q = min(CHUNK, L)
    c = L // q
    f32 = jnp.float32
    xdt = (xs.astype(f32) * dt[..., None]).reshape(b, c, q, h, p)
    bc = bm.astype(f32).reshape(b, c, q, h, n)
    cc = cm.astype(f32).reshape(b, c, q, h, n)
    a_cs = jnp.cumsum((dt * a).reshape(b, c, q, h), axis=2)
    seg = a_cs[:, :, :, None, :] - a_cs[:, :, None, :, :]
    causal = (jnp.arange(q)[:, None] >= jnp.arange(q)[None, :])[None, None, :, :, None]
    decay = jnp.exp(jnp.where(causal, seg, -jnp.inf))
    scores = jnp.einsum('bclhn,bcshn->bclsh', cc, bc) * decay
    y_diag = jnp.einsum('bclsh,bcshp->bclhp', scores, xdt)
    to_end = jnp.exp(a_cs[:, :, -1:, :] - a_cs)
    chunk_states = jnp.einsum('bclhn,bclh,bclhp->bchpn', bc, to_end, xdt)
    chunk_decay = jnp.exp(a_cs[:, :, -1, :])

    def step(s, inp):
        st, dec = inp
        return s * dec[:, :, None, None] + st, s

    s_final, s_prev = lax.scan(step, s0.astype(f32),
                               (jnp.moveaxis(chunk_states, 1, 0), jnp.moveaxis(chunk_decay, 1, 0)))
    s_prev = jnp.moveaxis(s_prev, 0, 1)
    y_off = jnp.einsum('bclhn,bchpn,bclh->bclhp', cc, s_prev, jnp.exp(a_cs))
    return (y_diag + y_off).reshape(b, L, h, p), s_final


def ssd_mixer(z, xbc, dt_raw, conv_prev, s0, conv_w, conv_b, dt_bias, a_log, d_skip, norm_g):
    b, L, _ = z.shape
    f32 = jnp.float32
    xbc, conv_new = causal_dwconv(xbc, conv_prev, conv_w, conv_b)
    xbc = jax.nn.silu(xbc)
    gn = N_SSD_GROUPS * D_STATE
    xs = xbc[..., :D_SSD].reshape(b, L, N_SSD_HEADS, SSD_HEAD_DIM)
    bm = jnp.repeat(xbc[..., D_SSD:D_SSD + gn].reshape(b, L, N_SSD_GROUPS, D_STATE), SSD_HEADS_PER_GROUP, axis=2)
    cm = jnp.repeat(xbc[..., D_SSD + gn:].reshape(b, L, N_SSD_GROUPS, D_STATE), SSD_HEADS_PER_GROUP, axis=2)
    dt = jax.nn.softplus(dt_raw.astype(f32) + dt_bias.astype(f32))
    a = -jnp.exp(a_log.astype(f32))
    y, s_final = ssd_scan(xs, dt, a, bm, cm, s0)
    y = y + xs.astype(f32) * d_skip.astype(f32)[:, None]
    y = (y.reshape(b, L, D_SSD) * jax.nn.silu(z.astype(f32))).reshape(b, L, N_SSD_GROUPS, D_SSD // N_SSD_GROUPS)
    y = y * lax.rsqrt(jnp.mean(y * y, axis=-1, keepdims=True) + EPS)
    y = y.reshape(b, L, D_SSD) * norm_g.astype(f32)
    return y.astype(z.dtype), conv_new, s_final.astype(s0.dtype)


def fox_block(q, k, v, fq, fk, q_pos, k_pos):
    s = jnp.einsum('bqhd,bkhd->bhqk', q, k).astype(jnp.float32) * FOX_SCALE
    s = s + (jnp.swapaxes(fq, 1, 2)[:, :, :, None] - jnp.swapaxes(fk, 1, 2)[:, :, None, :])
    s = jnp.where((k_pos[None, :] <= q_pos[:, None])[None, None], s, -jnp.inf)
    p = jax.nn.softmax(s, axis=-1)
    return jnp.einsum('bhqk,bkhd->bqhd', p.astype(v.dtype), v)


def fox_prompt(q, k, v, logf):
    b, L, h, d = q.shape
    F = jnp.cumsum(logf, axis=1)
    nb = L // Q_BLOCK
    qb = jnp.moveaxis(q.reshape(b, nb, Q_BLOCK, h, d), 1, 0)
    fb = jnp.moveaxis(F.reshape(b, nb, Q_BLOCK, h), 1, 0)
    pos = jnp.arange(L, dtype=jnp.int32)
    pb = pos.reshape(nb, Q_BLOCK)
    out = lax.map(lambda blk: fox_block(blk[0], k, v, blk[1], F, blk[2], pos), (qb, fb, pb))
    return jnp.moveaxis(out, 0, 1).reshape(b, L, h * d)


def fox_sample(q, k, v, logf, ck, cv, clogf):
    b, T, h, d = q.shape
    P = ck.shape[1]
    k_all = jnp.concatenate([ck.astype(k.dtype), k], axis=1)
    v_all = jnp.concatenate([cv.astype(v.dtype), v], axis=1)
    F = jnp.cumsum(jnp.concatenate([clogf.astype(jnp.float32), logf], axis=1), axis=1)
    q_pos = P + jnp.arange(T, dtype=jnp.int32)
    k_pos = jnp.arange(P + T, dtype=jnp.int32)
    out = fox_block(q, k_all, v_all, F[:, P:], F, q_pos, k_pos)
    return out.reshape(b, T, h * d)


def conv_ffn(n, prev, w_up, cw, cb, w_down):
    u, new = causal_dwconv(n @ w_up, prev, cw, cb)
    g, v = u[..., :D_FF], u[..., D_FF:]
    return (jax.nn.silu(g) * v) @ w_down, new


def setup_inputs(seed: int = 0) -> dict:
    key = jax.random.key(seed)
    ks = jax.random.split(key, 24)
    f32 = jnp.float32
    nrm = lambda k, shape, s=1.0: jax.random.normal(k, shape, f32) * s
    dt0 = jnp.exp(jax.random.uniform(ks[12], (DEPTH, N_SSD_HEADS), f32) * (math.log(0.1) - math.log(0.001)) + math.log(0.001))
    return {
        'x_prompt': nrm(ks[0], (BATCH, SEQ, D_MODEL)),
        'x_sample': nrm(ks[1], (DEC_BATCH, DEC_SEQ, D_MODEL)),
        'cache_fox_k': nrm(ks[2], (DEPTH, DEC_BATCH, PAST_LEN, N_FOX_HEADS, FOX_HEAD_DIM)),
        'cache_fox_v': nrm(ks[3], (DEPTH, DEC_BATCH, PAST_LEN, N_FOX_HEADS, FOX_HEAD_DIM)),
        'cache_fox_logf': jax.nn.log_sigmoid(nrm(ks[4], (DEPTH, DEC_BATCH, PAST_LEN, N_FOX_HEADS)) + 3.0),
        'state_ssd': nrm(ks[5], (DEPTH, DEC_BATCH, N_SSD_HEADS, SSD_HEAD_DIM, D_STATE), 0.5),
        'state_ssd_conv': nrm(ks[6], (DEPTH, DEC_BATCH, SSD_CONV_W - 1, SSD_CONV_DIM)),
        'state_ffn_conv': nrm(ks[7], (DEPTH, DEC_BATCH, FFN_CONV_W - 1, 2 * D_FF)),
        'norm1_g': 1.0 + nrm(ks[8], (DEPTH, D_MODEL), 0.02),
        'w_in': nrm(ks[9], (DEPTH, D_MODEL, IN_COLS), D_MODEL ** -0.5),
        'ssd_conv_w': nrm(ks[10], (DEPTH, SSD_CONV_W, SSD_CONV_DIM), SSD_CONV_W ** -0.5),
        'ssd_conv_b': nrm(ks[11], (DEPTH, SSD_CONV_DIM), 0.02),
        'ssd_dt_bias': dt0 + jnp.log(-jnp.expm1(-dt0)),
        'ssd_a_log': jnp.log(jax.random.uniform(ks[13], (DEPTH, N_SSD_HEADS), f32, 1.0, 16.0)),
        'ssd_d': 1.0 + nrm(ks[14], (DEPTH, N_SSD_HEADS), 0.1),
        'ssd_norm_g': 1.0 + nrm(ks[15], (DEPTH, D_SSD), 0.02),
        'fox_f_bias': jax.random.uniform(ks[16], (DEPTH, N_FOX_HEADS), f32, 1.0, 5.0),
        'w_out': nrm(ks[17], (DEPTH, D_MIX, D_MODEL), D_MIX ** -0.5),
        'norm2_g': 1.0 + nrm(ks[18], (DEPTH, D_MODEL), 0.02),
        'w_up': nrm(ks[19], (DEPTH, D_MODEL, 2 * D_FF), D_MODEL ** -0.5),
        'ffn_conv_w': nrm(ks[20], (DEPTH, FFN_CONV_W, 2 * D_FF), FFN_CONV_W ** -0.5),
        'ffn_conv_b': nrm(ks[21], (DEPTH, 2 * D_FF), 0.02),
        'w_down': nrm(ks[22], (DEPTH, D_FF, D_MODEL), D_FF ** -0.5),
        'final_norm_g': 1.0 + nrm(ks[23], (D_MODEL,), 0.02),
    }


def reference(x_prompt, x_sample, cache_fox_k, cache_fox_v, cache_fox_logf, state_ssd, state_ssd_conv,
              state_ffn_conv, norm1_g, w_in, ssd_conv_w, ssd_conv_b, ssd_dt_bias, ssd_a_log, ssd_d,
              ssd_norm_g, fox_f_bias, w_out, norm2_g, w_up, ffn_conv_w, ffn_conv_b, w_down, final_norm_g):

    def trunk(x, fox_cache, ssd_state, ssd_conv_state, ffn_conv_state):
        b, L, _ = x.shape
        ks_, vs_, lfs_, sss_, scs_, fcs_ = [], [], [], [], [], []
        for l in range(DEPTH):
            n = rmsnorm(x, norm1_g[l])
            z, xbc, dt_raw, q, k, v, f_raw = split_columns(n @ w_in[l])
            y_ssd, sc_new, ss_new = ssd_mixer(z, xbc, dt_raw, ssd_conv_state[l], ssd_state[l], ssd_conv_w[l],
                                              ssd_conv_b[l], ssd_dt_bias[l], ssd_a_log[l], ssd_d[l], ssd_norm_g[l])
            q = q.reshape(b, L, N_FOX_HEADS, FOX_HEAD_DIM)
            k = k.reshape(b, L, N_FOX_HEADS, FOX_HEAD_DIM)
            v = v.reshape(b, L, N_FOX_HEADS, FOX_HEAD_DIM)
            logf = jax.nn.log_sigmoid(f_raw.astype(jnp.float32) + fox_f_bias[l].astype(jnp.float32))
            if fox_cache is None:
                y_fox = fox_prompt(q, k, v, logf)
            else:
                y_fox = fox_sample(q, k, v, logf, fox_cache[0][l], fox_cache[1][l], fox_cache[2][l])
            h = x + jnp.concatenate([y_ssd, y_fox.astype(x.dtype)], axis=-1) @ w_out[l]
            y_ffn, fc_new = conv_ffn(rmsnorm(h, norm2_g[l]), ffn_conv_state[l], w_up[l], ffn_conv_w[l],
                                     ffn_conv_b[l], w_down[l])
            x = h + y_ffn
            ks_.append(k)
            vs_.append(v)
            lfs_.append(logf.astype(x.dtype))
            sss_.append(ss_new)
            scs_.append(sc_new)
            fcs_.append(fc_new)
        return (rmsnorm(x, final_norm_g), jnp.stack(ks_), jnp.stack(vs_), jnp.stack(lfs_),
                jnp.stack(sss_), jnp.stack(scs_), jnp.stack(fcs_))

    dt_p = x_prompt.dtype
    bp = x_prompt.shape[0]
    (y_prompt, p_fox_k, p_fox_v, p_fox_logf, p_ssd, p_ssd_conv, p_ffn_conv) = trunk(
        x_prompt, None,
        jnp.zeros((DEPTH, bp, N_SSD_HEADS, SSD_HEAD_DIM, D_STATE), dt_p),
        jnp.zeros((DEPTH, bp, SSD_CONV_W - 1, SSD_CONV_DIM), dt_p),
        jnp.zeros((DEPTH, bp, FFN_CONV_W - 1, 2 * D_FF), dt_p))
    (y_sample, s_fox_k, s_fox_v, s_fox_logf, s_ssd, s_ssd_conv, s_ffn_conv) = trunk(
        x_sample, (cache_fox_k, cache_fox_v, cache_fox_logf), state_ssd, state_ssd_conv, state_ffn_conv)
    return (y_prompt, y_sample, p_fox_k, p_fox_v, p_fox_logf, p_ssd, p_ssd_conv, p_ffn_conv,
            s_fox_k, s_fox_v, s_fox_logf, s_ssd, s_ssd_conv, s_ffn_conv)
```

```cpp
#include <hip/hip_runtime.h>
#include <hip/hip_cooperative_groups.h>
#include <cstdint>
#include <cstdio>
namespace cg = cooperative_groups;

typedef unsigned short bf16_t;
typedef __attribute__((ext_vector_type(8))) short bf16x8;
typedef __attribute__((ext_vector_type(4))) short s16x4;
typedef __attribute__((ext_vector_type(4))) float f32x4;
typedef __attribute__((ext_vector_type(16))) float f32x16;
typedef __attribute__((ext_vector_type(4))) unsigned u32x4;
typedef __attribute__((ext_vector_type(2))) unsigned u32x2;
#define DEV __device__ __forceinline__

constexpr int TP = 16384, TS = 256, TA = TP + TS;
constexpr int DM = 1024, SEQ = 8192, DFF = 2816, NUP = 5632, INC = 3088;
constexpr float EPS = 1e-6f;
constexpr float LOG2E = 1.4426950408889634f;
constexpr float QSCALE = 0.125f * LOG2E;
constexpr int LDS_TOTAL = 135168;

constexpr size_t O_Y = 0;
constexpr size_t O_PK = (size_t)TA * 1024;
constexpr size_t O_PV = O_PK + (size_t)TP * 512;
constexpr size_t O_PLF = O_PV + (size_t)TP * 512;
constexpr size_t O_PSSD = O_PLF + (size_t)TP * 8;
constexpr size_t O_PSC = O_PSSD + 2 * 8 * 64 * 128;
constexpr size_t O_PFC = O_PSC + 2 * 3 * 1024;
constexpr size_t O_SK = O_PFC + 2 * 2 * 5632;
constexpr size_t O_SV = O_SK + (size_t)TS * 512;
constexpr size_t O_SLF = O_SV + (size_t)TS * 512;
constexpr size_t O_SSSD = O_SLF + (size_t)TS * 8;
constexpr size_t O_SSC = O_SSSD + 16 * 8 * 64 * 128;
constexpr size_t O_SFC = O_SSC + 16 * 3 * 1024;
constexpr size_t O_END = O_SFC + 16 * 2 * 5632;

constexpr size_t W_WIN = 0;
constexpr size_t W_WOUT = W_WIN + (size_t)3072 * 1024 * 2;
constexpr size_t W_WUP = W_WOUT + (size_t)1024 * 1024 * 2;
constexpr size_t W_WDN = W_WUP + (size_t)5632 * 1024 * 2;
constexpr size_t W_DT = W_WDN + (size_t)1024 * 2816 * 2;
constexpr size_t W_ACS = W_DT + (size_t)TA * 8 * 4;
constexpr size_t W_DEC = W_ACS + (size_t)TA * 8 * 4;
constexpr size_t W_G = W_DEC + (size_t)272 * 8 * 4;
constexpr size_t W_SS2 = W_G + (size_t)16 * 8192 * 4;
constexpr size_t W_SS3 = W_SS2 + (size_t)TA * 4;
constexpr size_t W_CSS = W_SS3 + (size_t)TA * 4;
constexpr size_t W_BAR = W_CSS + (size_t)16 * 65536 * 4;
constexpr size_t W_CNT = W_BAR + 16384;
constexpr size_t W_SATT = W_BAR + 32768;
constexpr size_t W_RA = (W_SATT + (size_t)256 * 512 * 2 + 255) / 256 * 256;
constexpr size_t SZ_RA = (size_t)TA * 1024 * 2;
constexpr size_t W_RB = W_RA + SZ_RA;
constexpr size_t W_Z = W_RB + SZ_RA;
constexpr size_t SZ_H = (size_t)TA * 512 * 2;
constexpr size_t W_Q = W_Z + SZ_H;
constexpr size_t W_K = W_Q + SZ_H;
constexpr size_t W_V = W_K + SZ_H;
constexpr size_t W_CG = W_V + SZ_H;
constexpr size_t W_U = W_RB;
constexpr size_t W_HALO = W_RB;
constexpr size_t SZ_U = (size_t)TA * 2816 * 2;
constexpr size_t W_ACT = W_V + SZ_H;
constexpr size_t W_END = W_ACT + SZ_U;
static_assert(W_U + SZ_U <= W_ACT, "U overlaps ACT");
static_assert(W_END <= (size_t)256 * 1024 * 1024, "workspace too large");

struct Params {
    const float* x_prompt; const float* x_sample; const float* cache_k; const float* cache_v; const float* cache_logf;
    const float* state_ssd; const float* state_ssd_conv; const float* state_ffn_conv; const float* norm1_g; const float* w_in;
    const float* ssd_conv_w; const float* ssd_conv_b; const float* ssd_dt_bias; const float* ssd_a_log; const float* ssd_d;
    const float* ssd_norm_g; const float* fox_f_bias; const float* w_out; const float* norm2_g; const float* w_up;
    const float* ffn_conv_w; const float* ffn_conv_b; const float* w_down; const float* final_norm_g;
    float* out; unsigned char* ws;
};

DEV unsigned cvtpk(float lo, float hi) { unsigned r; asm("v_cvt_pk_bf16_f32 %0, %1, %2" : "=v"(r) : "v"(lo), "v"(hi)); return r; }
DEV bf16_t f2bf(float f) { return (bf16_t)(cvtpk(f, 0.f) & 0xffffu); }
DEV float bf2f(bf16_t b) { return __uint_as_float(((unsigned)b) << 16); }
DEV float bflo(unsigned u) { return __uint_as_float(u << 16); }
DEV float bfhi(unsigned u) { return __uint_as_float(u & 0xffff0000u); }
DEV float silu_f(float x) { return x * __builtin_amdgcn_rcpf(1.f + __builtin_amdgcn_exp2f(x * -LOG2E)); }
DEV float softplus_f(float x) { return x > 20.f ? x : log1pf(expf(x)); }
DEV float wave_sum(float v) {
#pragma unroll
    for (int o = 32; o > 0; o >>= 1) v += __shfl_xor(v, o);
    return v;
}
DEV float wave_max(float v) {
#pragma unroll
    for (int o = 32; o > 0; o >>= 1) v = fmaxf(v, __shfl_xor(v, o));
    return v;
}
DEV int up_natcol(int r) { const int pn = r >> 8, i = r & 255; return i < 128 ? pn * 128 + i : DFF + pn * 128 + (i - 128); }

constexpr int BM = 256, BK = 64, HALF = 128, HT = HALF * BK;
DEV int lds_byte(int r, int c) { int st = (r >> 4) * 2 + (c >> 5), rr = r & 15, cc = c & 31, ob = rr * 64 + cc * 2; return st * 1024 + (ob ^ (((ob >> 9) & 1) << 5)); }
DEV void stage_rc(int b, int& R, int& C) { int st = b / 1024, sb = b % 1024, swz = sb ^ (((sb >> 9) & 1) << 5); R = (st >> 1) * 16 + swz / 64; C = (st & 1) * 32 + (swz % 64) / 2; }

struct NoPre { DEV void operator()(int, int) const {} };
template <class Epi, class Pre = NoPre>
DEV void gemm_phase(const bf16_t* __restrict__ A, const bf16_t* __restrict__ Bt, const int M, const int N, const int K, const Epi& epi, const Pre& pre = Pre()) {
    extern __shared__ __attribute__((aligned(16))) bf16_t shm[];
#define SA(b, h) (shm + ((b) * 2 + (h)) * HT)
#define SB(b, h) (shm + (4 + (b) * 2 + (h)) * HT)
#define STAGE(P, BASE, br, kt) do { const char* _gb = (const char*)(BASE + (long)(br) * K + (long)(kt) * BK); \
      __builtin_amdgcn_global_load_lds((const unsigned*)(_gb + so0), (unsigned*)((char*)(P) + tid16), 16, 0, 0); \
      __builtin_amdgcn_global_load_lds((const unsigned*)(_gb + so1), (unsigned*)((char*)(P) + tid16 + 8192), 16, 0, 0); } while (0)
#define LDA(dst, b, h) for (int m = 0; m < 4; ++m) for (int k = 0; k < 2; ++k) \
    dst[m][k] = *reinterpret_cast<const bf16x8*>((char*)SA(b, h) + lds_byte(wr * 64 + m * 16 + fr, k * 32 + fq * 8))
#define LDB(dst, b, h) for (int n = 0; n < 2; ++n) for (int k = 0; k < 2; ++k) \
    dst[n][k] = *reinterpret_cast<const bf16x8*>((char*)SB(b, h) + lds_byte(wc * 32 + n * 16 + fr, k * 32 + fq * 8))
#define MMA(ai, bj, At_, Bt_) do { __builtin_amdgcn_s_setprio(1); \
    for (int m = 0; m < 4; ++m) for (int n = 0; n < 2; ++n) for (int k = 0; k < 2; ++k) \
      acc[ai][bj][m][n] = __builtin_amdgcn_mfma_f32_16x16x32_bf16(Bt_[n][k], At_[m][k], acc[ai][bj][m][n], 0, 0, 0); \
    __builtin_amdgcn_s_setprio(0); } while (0)
#define WAIT_V(n) asm volatile("s_waitcnt vmcnt(" #n ")" ::: "memory")
#define WAIT_L(n) asm volatile("s_waitcnt lgkmcnt(" #n ")" ::: "memory")
#define BAR __builtin_amdgcn_s_barrier()
#define SCHED __builtin_amdgcn_sched_barrier(0)
    const int nM = M / BM, nN = N / BM, nwg = nM * nN;
    int tidg = threadIdx.x; asm volatile("" : "+v"(tidg));
    const int wid = tidg >> 6, lane = tidg & 63, wr = wid >> 2, wc = wid & 3, fr = lane & 15, fq = lane >> 4;
    const int nt = K / BK;
    const int tid16 = tidg * 16;
    unsigned so0, so1; { int r_, c_; stage_rc(tid16, r_, c_); so0 = (unsigned)(r_ * K + c_) * 2u; stage_rc(tid16 + 8192, r_, c_); so1 = (unsigned)(r_ * K + c_) * 2u; }
    for (int L = blockIdx.x; L < nwg; L += gridDim.x) {
        int wgid = L;
        { int q = nwg / 8, r = nwg % 8, xcd = wgid % 8, off = wgid / 8; wgid = (xcd < r ? xcd * (q + 1) : r * (q + 1) + (xcd - r) * q) + off; }
        const int nig = 8 * nN, gid = wgid / nig, fm = gid * 8, gsz = min(nM - fm, 8);
        const int pm = fm + ((wgid % nig) % gsz), pn = (wgid % nig) / gsz, brow = pm * BM, bcol = pn * BM;
        pre(pm, pn);
        f32x4 acc[2][2][4][2];
#pragma unroll
        for (int a = 0; a < 2; ++a)
#pragma unroll
            for (int b = 0; b < 2; ++b)
#pragma unroll
                for (int m = 0; m < 4; ++m)
#pragma unroll
                    for (int n = 0; n < 2; ++n) acc[a][b][m][n] = (f32x4){0.f, 0.f, 0.f, 0.f};
        bf16x8 At[4][2], B0[2][2], B1[2][2];
        STAGE(SB(0, 0), Bt, bcol, 0); STAGE(SA(0, 0), A, brow, 0);
        STAGE(SB(0, 1), Bt, bcol + HALF, 0); STAGE(SA(0, 1), A, brow + HALF, 0);
        if (wr == 1) BAR;
        WAIT_V(4); BAR;
        STAGE(SB(1, 0), Bt, bcol, 1); STAGE(SA(1, 0), A, brow, 1); STAGE(SB(1, 1), Bt, bcol + HALF, 1);
        WAIT_V(6); BAR;
        for (int t = 0; t < nt - 2; t += 2) {
            LDB(B0, 0, 0); SCHED; LDA(At, 0, 0); STAGE(SA(1, 1), A, brow + HALF, t + 1);
            WAIT_L(8); BAR; WAIT_L(0); MMA(0, 0, At, B0); BAR; SCHED;
            LDB(B1, 0, 1); STAGE(SB(0, 0), Bt, bcol, t + 2);
            BAR; WAIT_L(0); MMA(0, 1, At, B1); BAR;
            LDA(At, 0, 1); STAGE(SA(0, 0), A, brow, t + 2);
            BAR; WAIT_L(0); MMA(1, 0, At, B0); BAR; SCHED;
            STAGE(SB(0, 1), Bt, bcol + HALF, t + 2);
            WAIT_V(6); BAR; MMA(1, 1, At, B1); BAR;
            LDB(B0, 1, 0); SCHED; LDA(At, 1, 0); STAGE(SA(0, 1), A, brow + HALF, t + 2);
            WAIT_L(8); BAR; WAIT_L(0); MMA(0, 0, At, B0); BAR; SCHED;
            LDB(B1, 1, 1); STAGE(SB(1, 0), Bt, bcol, t + 3);
            BAR; WAIT_L(0); MMA(0, 1, At, B1); BAR;
            LDA(At, 1, 1); STAGE(SA(1, 0), A, brow, t + 3);
            BAR; WAIT_L(0); MMA(1, 0, At, B0); BAR; SCHED;
            STAGE(SB(1, 1), Bt, bcol + HALF, t + 3);
            WAIT_V(6); BAR; MMA(1, 1, At, B1); BAR;
        }
        { LDB(B0, 0, 0); LDA(At, 0, 0); STAGE(SA(1, 1), A, brow + HALF, nt - 1);
          BAR; WAIT_L(0); MMA(0, 0, At, B0); BAR;
          LDB(B1, 0, 1); BAR; WAIT_L(0); MMA(0, 1, At, B1); BAR;
          LDA(At, 0, 1); WAIT_V(4); BAR; WAIT_L(0); MMA(1, 0, At, B0); MMA(1, 1, At, B1); BAR; }
        { LDB(B0, 1, 0); LDA(At, 1, 0); WAIT_V(2); BAR; WAIT_L(0); MMA(0, 0, At, B0); BAR;
          LDB(B1, 1, 1); WAIT_V(0); BAR; WAIT_L(0); MMA(0, 1, At, B1); BAR;
          LDA(At, 1, 1); BAR; WAIT_L(0); MMA(1, 0, At, B0); MMA(1, 1, At, B1); BAR; }
        if (wr == 0) BAR;
        { int t2 = threadIdx.x; asm volatile("" : "+v"(t2)); const int w2 = t2 >> 6, l2 = t2 & 63; epi(acc, pm, pn, w2 >> 2, w2 & 3, l2 & 15, l2 >> 4); }
    }
#undef SA
#undef SB
#undef STAGE
#undef LDA
#undef LDB
#undef MMA
}

#define EPI_LOOP_BEGIN \
    _Pragma("unroll") for (int ai = 0; ai < 2; ++ai) _Pragma("unroll") for (int m = 0; m < 4; ++m) { \
        const int row = pm * BM + ai * HALF + wr * 64 + m * 16 + fr;
#define EPI_COLS_BEGIN \
        _Pragma("unroll") for (int bj = 0; bj < 2; ++bj) _Pragma("unroll") for (int n = 0; n < 2; ++n) { \
            const int col = pn * BM + bj * HALF + wc * 32 + n * 16 + fq * 4; const f32x4 v = acc[ai][bj][m][n];

struct EpiIn {
    bf16_t *Z, *XBC, *Q, *K, *V; float* out;
    DEV void operator()(const f32x4 (&acc)[2][2][4][2], int pm, int pn, int wr, int wc, int fr, int fq) const {
        EPI_LOOP_BEGIN
            const bool smp = row >= TP; const int rs = row - TP;
            EPI_COLS_BEGIN
                if (pn < 2) { *(u32x2*)(Z + (size_t)row * 512 + col) = (u32x2){cvtpk(v[0], v[1]), cvtpk(v[2], v[3])}; }
                else if (pn < 6) { const int c = col - 512; *(u32x2*)(XBC + (size_t)row * 1024 + c) = (u32x2){cvtpk(v[0], v[1]), cvtpk(v[2], v[3])};
                    if (!smp) { const int t = row & 8191; if (t >= 8189) *(f32x4*)(out + O_PSC + (size_t)((row >> 13) * 3 + (t - 8189)) * 1024 + c) = v; }
                    else { const int t = rs & 15; if (t >= 13) *(f32x4*)(out + O_SSC + (size_t)((rs >> 4) * 3 + (t - 13)) * 1024 + c) = v; } }
                else if (pn < 8) { const int c = col - 1536; *(u32x2*)(Q + (size_t)row * 512 + c) = (u32x2){cvtpk(v[0] * QSCALE, v[1] * QSCALE), cvtpk(v[2] * QSCALE, v[3] * QSCALE)}; }
                else if (pn < 10) { const int c = col - 2048; *(u32x2*)(K + (size_t)row * 512 + c) = (u32x2){cvtpk(v[0], v[1]), cvtpk(v[2], v[3])};
                    if (!smp) __builtin_nontemporal_store(v, (f32x4*)(out + O_PK + (size_t)row * 512 + c)); else *(f32x4*)(out + O_SK + (size_t)rs * 512 + c) = v; }
                else { const int c = col - 2560; *(u32x2*)(V + (size_t)row * 512 + c) = (u32x2){cvtpk(v[0], v[1]), cvtpk(v[2], v[3])};
                    if (!smp) __builtin_nontemporal_store(v, (f32x4*)(out + O_PV + (size_t)row * 512 + c)); else *(f32x4*)(out + O_SV + (size_t)rs * 512 + c) = v; }
            }
        }
    }
};

struct EpiOut {
    const float* xp; const float* xs; float* H; bf16_t* Hb; float* SS;
    DEV void operator()(const f32x4 (&acc)[2][2][4][2], int pm, int pn, int wr, int wc, int fr, int fq) const {
        EPI_LOOP_BEGIN
            const float* xr = row < TP ? xp + (size_t)row * 1024 : xs + (size_t)(row - TP) * 1024; float ss = 0.f;
            EPI_COLS_BEGIN
                const f32x4 h = v + *(const f32x4*)(xr + col);
                *(u32x2*)(Hb + (size_t)row * 1024 + col) = (u32x2){cvtpk(h[0], h[1]), cvtpk(h[2], h[3])};
                ss += h[0] * h[0] + h[1] * h[1] + h[2] * h[2] + h[3] * h[3];
            }
            ss += __shfl_xor(ss, 16); ss += __shfl_xor(ss, 32);
            if (fq == 0) atomicAdd(SS + row, ss);
        }
    }
};

struct EpiUp {
    const float* SS; bf16_t* U; float* out; int hf;
    DEV void operator()(const f32x4 (&acc)[2][2][4][2], int pm, int pn, int wr, int wc, int fr, int fq) const {
        EPI_LOOP_BEGIN
            const float rs = rsqrtf(SS[row] * (1.f / 1024.f) + EPS);
            float* st = nullptr;
            if (row < TP) { const int t = row & 8191; if (t >= 8190) st = out + O_PFC + (size_t)((row >> 13) * 2 + (t - 8190)) * NUP; }
            else { const int r2 = row - TP, t = r2 & 15; if (t >= 14) st = out + O_SFC + (size_t)((r2 >> 4) * 2 + (t - 14)) * NUP; }
            EPI_COLS_BEGIN
                const f32x4 u = v * rs;
                *(u32x2*)(U + (size_t)row * DFF + col) = (u32x2){cvtpk(u[0], u[1]), cvtpk(u[2], u[3])};
                if (st) *(f32x4*)(st + up_natcol(hf * DFF + col)) = u;
            }
        }
    }
};

constexpr int TPITCH = 528;
struct EpiUpFused {
    const float* SS; float* out; bf16_t* ACT; bf16_t* HALO; const float* cw; const float* cbias; const float* stf; char* lds;
    DEV void operator()(const f32x4 (&acc)[2][2][4][2], int pm, int pn, int wr, int wc, int fr, int fq) const {
        int tid = threadIdx.x; asm volatile("" : "+v"(tid));
        const int lc = (tid & 31) * 4, run = tid >> 5, ja = pn * 128 + lc; const bool smp = pm == 64;
        float wg[3][4], wv[3][4], bg[4], bv[4];
#pragma unroll
        for (int e = 0; e < 4; ++e) { bg[e] = cbias[ja + e]; bv[e] = cbias[DFF + ja + e];
#pragma unroll
            for (int j = 0; j < 3; ++j) { wg[j][e] = cw[j * NUP + ja + e]; wv[j][e] = cw[j * NUP + DFF + ja + e]; } }
        float ssq[8];
#pragma unroll
        for (int q = 0; q < 8; ++q) ssq[q] = SS[pm * BM + (q >> 2) * HALF + wr * 64 + (q & 3) * 16 + fr];
        EPI_LOOP_BEGIN
            const float rs = rsqrtf(ssq[ai * 4 + m] * (1.f / 1024.f) + EPS);
            float* st = nullptr;
            if (row < TP) { const int t = row & 8191; if (t >= 8190) st = out + O_PFC + (size_t)((row >> 13) * 2 + (t - 8190)) * NUP; }
            else { const int r2 = row - TP, t = r2 & 15; if (t >= 14) st = out + O_SFC + (size_t)((r2 >> 4) * 2 + (t - 14)) * NUP; }
            const int rl = row - pm * BM;
            EPI_COLS_BEGIN
                const f32x4 u = v * rs;
                *(u32x2*)(lds + rl * TPITCH + (col - pn * BM) * 2) = (u32x2){cvtpk(u[0], u[1]), cvtpk(u[2], u[3])};
                if (st) *(f32x4*)(st + up_natcol(col)) = u;
            }
        }
        __syncthreads();
        if (tid < 256) { const int r4 = tid >> 6, c = (tid & 63) * 4, rowl = r4 < 2 ? r4 : 252 + r4;
            *(u32x2*)(HALO + (size_t)(pm * 4 + r4) * NUP + pn * BM + c) = *(const u32x2*)(lds + rowl * TPITCH + c * 2); }
        auto ldrow = [&](int rowl, float* g, float* vv) { const u32x2 a = *(const u32x2*)(lds + rowl * TPITCH + lc * 2), c = *(const u32x2*)(lds + rowl * TPITCH + (128 + lc) * 2);
            g[0] = bflo(a[0]); g[1] = bfhi(a[0]); g[2] = bflo(a[1]); g[3] = bfhi(a[1]); vv[0] = bflo(c[0]); vv[1] = bfhi(c[0]); vv[2] = bflo(c[1]); vv[3] = bfhi(c[1]); };
        float g2[4], g1[4], v2[4], v1[4]; int rstart = 0;
        if (smp) { const float* s0 = stf + (size_t)(run * 2) * NUP, *s1 = s0 + NUP;
#pragma unroll
            for (int e = 0; e < 4; ++e) { g2[e] = s0[ja + e]; v2[e] = s0[DFF + ja + e]; g1[e] = s1[ja + e]; v1[e] = s1[DFF + ja + e]; } }
        else if (run == 0) { ldrow(0, g2, v2); ldrow(1, g1, v1); rstart = 2; }
        else { ldrow(16 * run - 2, g2, v2); ldrow(16 * run - 1, g1, v1); }
#pragma unroll 4
        for (int r = rstart; r < 16; ++r) { const int rowl = 16 * run + r; float g0[4], v0[4]; ldrow(rowl, g0, v0);
            float a[4];
#pragma unroll
            for (int e = 0; e < 4; ++e) { const float cg = bg[e] + wg[0][e] * g2[e] + wg[1][e] * g1[e] + wg[2][e] * g0[e], cv = bv[e] + wv[0][e] * v2[e] + wv[1][e] * v1[e] + wv[2][e] * v0[e];
                a[e] = silu_f(cg) * cv; g2[e] = g1[e]; g1[e] = g0[e]; v2[e] = v1[e]; v1[e] = v0[e]; }
            *(u32x2*)(ACT + (size_t)(pm * BM + rowl) * DFF + ja) = (u32x2){cvtpk(a[0], a[1]), cvtpk(a[2], a[3])}; }
        __syncthreads();
    }
};
struct FfnFixup { const Params* pp;
    DEV void operator()(int pm, int pn) const {
        const Params& p = *pp; unsigned char* ws = p.ws; const bf16_t* HALO = (const bf16_t*)(ws + W_HALO); bf16_t* ACT = (bf16_t*)(ws + W_ACT);
        if (pm >= 64) return;
        int tid = threadIdx.x; asm volatile("" : "+v"(tid));
        for (int it = tid; it < 2 * 352; it += 512) {
            const int cg8 = it % 352, rr = it / 352; const int ja = cg8 * 8, pc = (ja >> 7) * 256 + (ja & 127);
            const bool first = (pm & 31) == 0;
            float g[3][8], v[3][8];
            auto unpack = [&](const bf16_t* rowp, float* go, float* vo) { const u32x4 a = *(const u32x4*)(rowp + pc), c = *(const u32x4*)(rowp + pc + 128);
#pragma unroll
                for (int e = 0; e < 4; ++e) { go[2 * e] = bflo(a[e]); go[2 * e + 1] = bfhi(a[e]); vo[2 * e] = bflo(c[e]); vo[2 * e + 1] = bfhi(c[e]); } };
            auto zero = [&](float* go, float* vo) {
#pragma unroll
                for (int e = 0; e < 8; ++e) { go[e] = 0.f; vo[e] = 0.f; } };
            const bf16_t* mine = HALO + (size_t)(pm * 4) * NUP; const bf16_t* prev = HALO + (size_t)((pm - 1) * 4) * NUP;
            unpack(mine + (size_t)rr * NUP, g[2], v[2]);
            if (rr == 1) { unpack(mine, g[1], v[1]); if (first) zero(g[0], v[0]); else unpack(prev + (size_t)3 * NUP, g[0], v[0]); }
            else { if (first) { zero(g[1], v[1]); zero(g[0], v[0]); } else { unpack(prev + (size_t)3 * NUP, g[1], v[1]); unpack(prev + (size_t)2 * NUP, g[0], v[0]); } }
            u32x4 o;
#pragma unroll
            for (int e = 0; e < 4; ++e) { float a[2];
#pragma unroll
                for (int q = 0; q < 2; ++q) { const int i = 2 * e + q; float cg = p.ffn_conv_b[ja + i], cv = p.ffn_conv_b[DFF + ja + i];
#pragma unroll
                    for (int j = 0; j < 3; ++j) { cg += p.ffn_conv_w[j * NUP + ja + i] * g[j][i]; cv += p.ffn_conv_w[j * NUP + DFF + ja + i] * v[j][i]; }
                    a[q] = silu_f(cg) * cv; }
                o[e] = cvtpk(a[0], a[1]); }
            *(u32x4*)(ACT + (size_t)(pm * BM + rr) * DFF + ja) = o;
        }
        asm volatile("s_waitcnt vmcnt(0)" ::: "memory");
        __syncthreads();
    }
};

struct EpiDown {
    const bf16_t* Hb; float* SS; float* Ho;
    DEV void operator()(const f32x4 (&acc)[2][2][4][2], int pm, int pn, int wr, int wc, int fr, int fq) const {
        EPI_LOOP_BEGIN
            float ss = 0.f;
            EPI_COLS_BEGIN
                const size_t hoff = (size_t)row * 1024 + col;
                const u32x2 hb = *(const u32x2*)(Hb + hoff); const f32x4 h = v + (f32x4){bflo(hb[0]), bfhi(hb[0]), bflo(hb[1]), bfhi(hb[1])};
                *(f32x4*)(Ho + hoff) = h;
                ss += h[0] * h[0] + h[1] * h[1] + h[2] * h[2] + h[3] * h[3];
            }
            ss += __shfl_xor(ss, 16); ss += __shfl_xor(ss, 32);
            if (fq == 0) atomicAdd(SS + row, ss);
        }
    }
};

struct NoPost { DEV void operator()(int) const {} };
template <int NT = 1, class EpiE, class Post = NoPost>
DEV void sample_gemm(const bf16_t* __restrict__ A, const bf16_t* __restrict__ Bt, const int N, const int K, const EpiE& epi, char* lds, const Post& post = Post()) {
    int tid = threadIdx.x; asm volatile("" : "+v"(tid));
    const int lane = tid & 63, wid = tid >> 6, fr = lane & 15, fq = lane >> 4;
    constexpr int TW = 32 * NT;
    float* red = (float*)lds;
    const int ntile = 8 * (N / TW), kw = K / 8;
    for (int mt = blockIdx.x; mt < ntile; mt += gridDim.x) {
        const int r0 = (mt & 7) * 32, c0 = (mt >> 3) * TW;
        f32x4 acc[2][2 * NT];
#pragma unroll
        for (int i = 0; i < 2; ++i)
#pragma unroll
            for (int j = 0; j < 2 * NT; ++j) acc[i][j] = (f32x4){0.f, 0.f, 0.f, 0.f};
        const bf16_t* Ap = A + (size_t)(TP + r0 + fr) * K + wid * kw + fq * 8;
        const bf16_t* Bp = Bt + (size_t)(c0 + fr) * K + wid * kw + fq * 8;
#pragma unroll
        for (int ks = 0; ks < kw; ks += 32) {
            const bf16x8 a0 = *(const bf16x8*)(Ap + ks), a1 = *(const bf16x8*)(Ap + (size_t)16 * K + ks);
#pragma unroll
            for (int j = 0; j < 2 * NT; ++j) { const bf16x8 bj = *(const bf16x8*)(Bp + (size_t)(16 * j) * K + ks);
                acc[0][j] = __builtin_amdgcn_mfma_f32_16x16x32_bf16(bj, a0, acc[0][j], 0, 0, 0); acc[1][j] = __builtin_amdgcn_mfma_f32_16x16x32_bf16(bj, a1, acc[1][j], 0, 0, 0); }
        }
#pragma unroll
        for (int i = 0; i < 2; ++i)
#pragma unroll
            for (int j = 0; j < 2 * NT; ++j) *(f32x4*)(red + wid * (32 * TW) + (16 * i + fr) * TW + 16 * j + 4 * fq) = acc[i][j];
        __syncthreads();
#pragma unroll
        for (int q = 0; q < NT; ++q) { const int idx = tid + 512 * q, row = idx / (TW / 2), col = (idx % (TW / 2)) * 2; float v0 = 0.f, v1 = 0.f;
#pragma unroll
            for (int w = 0; w < 8; ++w) { const float2 t = *(const float2*)(red + w * (32 * TW) + row * TW + col); v0 += t.x; v1 += t.y; }
            epi(TP + r0 + row, c0 + col, v0, v1, lane); }
        __syncthreads();
        post(mt);
    }
}
struct EpiInE { bf16_t *Z, *XBC, *Q, *K, *V; float* out;
    DEV void operator()(int row, int col, float v0, float v1, int lane) const { const int rs = row - TP;
        if (col < 512) *(unsigned*)(Z + (size_t)row * 512 + col) = cvtpk(v0, v1);
        else if (col < 1536) { const int c = col - 512; *(unsigned*)(XBC + (size_t)row * 1024 + c) = cvtpk(v0, v1); const int t = rs & 15;
            if (t >= 13) *(float2*)(out + O_SSC + (size_t)((rs >> 4) * 3 + (t - 13)) * 1024 + c) = make_float2(v0, v1); }
        else if (col < 2048) *(unsigned*)(Q + (size_t)row * 512 + col - 1536) = cvtpk(v0 * QSCALE, v1 * QSCALE);
        else if (col < 2560) { const int c = col - 2048; *(unsigned*)(K + (size_t)row * 512 + c) = cvtpk(v0, v1); *(float2*)(out + O_SK + (size_t)rs * 512 + c) = make_float2(v0, v1); }
        else { const int c = col - 2560; *(unsigned*)(V + (size_t)row * 512 + c) = cvtpk(v0, v1); *(float2*)(out + O_SV + (size_t)rs * 512 + c) = make_float2(v0, v1); } } };
struct EpiResE { const float* res; const bf16_t* resb; float* H; bf16_t* Hb; float* SS;
    DEV void operator()(int row, int col, float v0, float v1, int lane) const {
        float h0, h1; if (res) { const float2 r = *(const float2*)(res + (size_t)row * 1024 + col); h0 = r.x + v0; h1 = r.y + v1; } else { const unsigned r = *(const unsigned*)(resb + (size_t)row * 1024 + col); h0 = bflo(r) + v0; h1 = bfhi(r) + v1; }
        if (H) *(float2*)(H + (size_t)row * 1024 + col) = make_float2(h0, h1);
        if (Hb) *(unsigned*)(Hb + (size_t)row * 1024 + col) = cvtpk(h0, h1);
        float ss = h0 * h0 + h1 * h1; ss += __shfl_xor(ss, 1); ss += __shfl_xor(ss, 2); ss += __shfl_xor(ss, 4); ss += __shfl_xor(ss, 8);
        if ((lane & 15) == 0) atomicAdd(SS + row, ss); } };

DEV float reduce16(float (&a)[16], int lane) {
    { const bool hi = lane & 32;
#pragma unroll
      for (int i = 0; i < 8; ++i) { const float send = hi ? a[i] : a[i + 8]; const float keep = hi ? a[i + 8] : a[i]; a[i] = keep + __shfl_xor(send, 32); } }
    { const bool hi = lane & 16;
#pragma unroll
      for (int i = 0; i < 4; ++i) { const float send = hi ? a[i] : a[i + 4]; const float keep = hi ? a[i + 4] : a[i]; a[i] = keep + __shfl_xor(send, 16); } }
    { const bool hi = lane & 8;
#pragma unroll
      for (int i = 0; i < 2; ++i) { const float send = hi ? a[i] : a[i + 2]; const float keep = hi ? a[i + 2] : a[i]; a[i] = keep + __shfl_xor(send, 8); } }
    { const bool hi = lane & 4; const float send = hi ? a[0] : a[1]; const float keep = hi ? a[1] : a[0]; a[0] = keep + __shfl_xor(send, 4); }
    a[0] += __shfl_xor(a[0], 2); a[0] += __shfl_xor(a[0], 1);
    return a[0];
}

template <class CS>
DEV void transpose4(const float* __restrict__ W, int ldw, int k0, const CS& cs, bf16_t* __restrict__ WT, int ldt, int r0, const float* __restrict__ gk, float* tile) {
    int tid = threadIdx.x; asm volatile("" : "+v"(tid));
    float v[4][8];
#pragma unroll
    for (int s = 0; s < 4; ++s) { const int c0 = cs(s);
#pragma unroll
        for (int e = 0; e < 8; ++e) { const int idx = tid + e * 512, j = idx >> 6, i = idx & 63; v[s][e] = W[(size_t)(k0 + j) * ldw + c0 + i]; } }
#pragma unroll
    for (int e = 0; e < 8; ++e) { const int idx = tid + e * 512, j = idx >> 6, i = idx & 63; const float g = gk ? gk[k0 + j] : 1.f;
#pragma unroll
        for (int s = 0; s < 4; ++s) tile[s * 4160 + j * 65 + i] = v[s][e] * g; }
    __syncthreads();
#pragma unroll
    for (int s = 0; s < 4; ++s)
#pragma unroll
        for (int e = 0; e < 4; ++e) { const int idx = tid + e * 512, i = idx >> 5, j2 = (idx & 31) * 2;
            *(unsigned*)(WT + (size_t)(r0 + 64 * s + i) * ldt + k0 + j2) = cvtpk(tile[s * 4160 + j2 * 65 + i], tile[s * 4160 + (j2 + 1) * 65 + i]); }
    __syncthreads();
}

DEV void weight_unit(const Params& p, int u, float* tile) {
    unsigned char* ws = p.ws;
    if (u < 192) { const int kt = u & 15, nb = u >> 4; const int r0 = nb * 256; const int c0 = r0 < 1536 ? r0 : r0 + 8;
        transpose4(p.w_in, INC, kt * 64, [&](int s) { return c0 + 64 * s; }, (bf16_t*)(ws + W_WIN), 1024, r0, nullptr, tile); }
    else if (u < 256) { const int v = u - 192, kt = v & 15, nb = v >> 4;
        transpose4(p.w_out, 1024, kt * 64, [&](int s) { return nb * 256 + 64 * s; }, (bf16_t*)(ws + W_WOUT), 1024, nb * 256, nullptr, tile); }
    else if (u < 608) { const int v = u - 256, kt = v & 15, nb = v >> 4;
        transpose4(p.w_up, NUP, kt * 64, [&](int s) { return up_natcol(nb * 256 + 64 * s); }, (bf16_t*)(ws + W_WUP), 1024, nb * 256, p.norm2_g, tile); }
    else { const int v = u - 608, kt = v % 44, nb = v / 44;
        transpose4(p.w_down, 1024, kt * 64, [&](int s) { return nb * 256 + 64 * s; }, (bf16_t*)(ws + W_WDN), DFF, nb * 256, nullptr, tile); }
}
DEV void weight_units_on_idle(const Params& p, int u0, int u1, int lo_want, char* lds) {
    const int lo = (int)gridDim.x > lo_want + 32 ? lo_want : 0;
    if ((int)blockIdx.x >= lo) for (int u = u0 + (int)blockIdx.x - lo; u < u1; u += (int)gridDim.x - lo) weight_unit(p, u, (float*)lds);
}

DEV void phase0(const Params& p, char* lds) {
    unsigned char* ws = p.ws;
    const int tid = threadIdx.x, lane = tid & 63, wid = tid >> 6;
    float* tile = (float*)lds;
    float* thin = (float*)(lds + 32768);
    for (int u = blockIdx.x; u < 192; u += gridDim.x) weight_unit(p, u, tile);
    for (int idx = tid; idx < 4096; idx += 512) { const int k = idx >> 2, part = idx & 3; const f32x4 v = *(const f32x4*)(p.w_in + (size_t)k * INC + (part < 2 ? 1536 + 4 * part : 3080 + 4 * (part - 2)));
        thin[(4 * part) * 1024 + k] = v[0]; thin[(4 * part + 1) * 1024 + k] = v[1]; thin[(4 * part + 2) * 1024 + k] = v[2]; thin[(4 * part + 3) * 1024 + k] = v[3]; }
    for (int i = blockIdx.x * 512 + tid; i < 2 * TA; i += gridDim.x * 512) ((float*)(ws + W_SS2))[i] = 0.f;
    __syncthreads();
    bf16_t* XN = (bf16_t*)(ws + W_RA); float* DT = (float*)(ws + W_DT);
    const int rstep = gridDim.x * 8;
    f32x4 gq[4];
#pragma unroll
    for (int i = 0; i < 4; ++i) gq[i] = *(const f32x4*)(p.norm1_g + i * 256 + lane * 4);
    for (int row0 = blockIdx.x * 8 + wid; row0 < TA; row0 += 2 * rstep) {
        const bool two = row0 + rstep < TA;
        f32x4 x[2][4]; float ss[2] = {0.f, 0.f};
#pragma unroll
        for (int rr = 0; rr < 2; ++rr) { const int row = (rr == 0 || two) ? row0 + rr * rstep : row0;
            const float* xr = row < TP ? p.x_prompt + (size_t)row * 1024 : p.x_sample + (size_t)(row - TP) * 1024;
#pragma unroll
            for (int i = 0; i < 4; ++i) { x[rr][i] = *(const f32x4*)(xr + i * 256 + lane * 4); ss[rr] += x[rr][i][0] * x[rr][i][0] + x[rr][i][1] * x[rr][i][1] + x[rr][i][2] * x[rr][i][2] + x[rr][i][3] * x[rr][i][3]; } }
#pragma unroll
        for (int rr = 0; rr < 2; ++rr) { const int row = row0 + rr * rstep; ss[rr] = wave_sum(ss[rr]); const float rs = rsqrtf(ss[rr] * (1.f / 1024.f) + EPS);
#pragma unroll
            for (int i = 0; i < 4; ++i) { x[rr][i] = x[rr][i] * rs * gq[i];
                if (rr == 0 || two) *(u32x2*)(XN + (size_t)row * 1024 + i * 256 + lane * 4) = (u32x2){cvtpk(x[rr][i][0], x[rr][i][1]), cvtpk(x[rr][i][2], x[rr][i][3])}; } }
        float pa0[16], pa1[16];
#pragma unroll
        for (int j = 0; j < 16; ++j) { float a0 = 0.f, a1 = 0.f;
#pragma unroll
            for (int i = 0; i < 4; ++i) { const f32x4 w = *(const f32x4*)(thin + j * 1024 + i * 256 + lane * 4);
                a0 += x[0][i][0] * w[0] + x[0][i][1] * w[1] + x[0][i][2] * w[2] + x[0][i][3] * w[3]; a1 += x[1][i][0] * w[0] + x[1][i][1] * w[1] + x[1][i][2] * w[2] + x[1][i][3] * w[3]; }
            pa0[j] = a0; pa1[j] = a1; }
        const int jj = (lane >> 2) & 15;
        const float m0 = reduce16(pa0, lane), m1 = reduce16(pa1, lane);
#pragma unroll
        for (int rr = 0; rr < 2; ++rr) { const int row = row0 + rr * rstep; const float mine = rr ? m1 : m0;
            if ((rr == 0 || two) && (lane & 3) == 0) {
                if (jj < 8) { DT[(size_t)row * 8 + jj] = softplus_f(mine + p.ssd_dt_bias[jj]); }
                else { const int h = jj - 8; const float lf = -softplus_f(-(mine + p.fox_f_bias[h]));
                    if (row < TP) p.out[O_PLF + (size_t)row * 8 + h] = lf; else p.out[O_SLF + (size_t)(row - TP) * 8 + h] = lf; } } }
    }
}

DEV void cumsum_prompt_unit(const Params& p, int b, char* lds) {
    int tid = threadIdx.x; asm volatile("" : "+v"(tid)); const int lane = tid & 63, wid = tid >> 6;
    constexpr int PITCH = 2308;
    float* buf = (float*)lds;
    const float* lf = p.out + O_PLF + (size_t)b * SEQ * 8;
    float* G = (float*)(p.ws + W_G) + ((size_t)b * 8 + wid) * SEQ;
    float carry = 0.f;
    for (int q = 0; q < 4; ++q) { const int t0 = q * 2048;
#pragma unroll
        for (int i = 0; i < 8; ++i) { const int idx = tid + 512 * i, t = idx >> 1, hh = (idx & 1) * 4; const f32x4 v = *(const f32x4*)(lf + (size_t)(t0 + t) * 8 + hh);
            const int o = t + 4 * (t >> 5);
            buf[hh * PITCH + o] = v[0]; buf[(hh + 1) * PITCH + o] = v[1]; buf[(hh + 2) * PITCH + o] = v[2]; buf[(hh + 3) * PITCH + o] = v[3]; }
        __syncthreads();
        float* seg = buf + wid * PITCH + 36 * lane; f32x4 v[8]; float run = 0.f;
#pragma unroll
        for (int j = 0; j < 8; ++j) { v[j] = *(const f32x4*)(seg + 4 * j); v[j][0] += run; v[j][1] += v[j][0]; v[j][2] += v[j][1]; v[j][3] += v[j][2]; run = v[j][3]; }
        float sc = run;
#pragma unroll
        for (int o = 1; o < 64; o <<= 1) { const float t = __shfl_up(sc, o); if (lane >= o) sc += t; }
        const float pre = carry + sc - run;
#pragma unroll
        for (int j = 0; j < 8; ++j) { v[j] = (v[j] + pre) * (-LOG2E); *(f32x4*)(seg + 4 * j) = v[j]; }
        carry += __shfl(sc, 63);
        __syncthreads();
#pragma unroll
        for (int j = 0; j < 8; ++j) { const int t = 4 * (lane + 64 * j); *(f32x4*)(G + t0 + t) = *(const f32x4*)(buf + wid * PITCH + t + 4 * (t >> 5)); }
        __syncthreads();
    }
}

DEV void sample_attn_unit(const Params& p, int b, int h, char* lds) {
    int tid = threadIdx.x; asm volatile("" : "+v"(tid)); const int lane = tid & 63, wid = tid >> 6, fr = lane & 15, fq = lane >> 4;
    float* bl = (float*)lds;
    float* red = (float*)(lds + 8448);
    float* red2 = (float*)(lds + 8960);
    float* stat = (float*)(lds + 9472);
    float* ored = (float*)(lds + 16384);
    const bf16_t* Q = (const bf16_t*)(p.ws + W_Q);
    const float* clf = p.cache_logf + (size_t)b * 2048 * 8 + h;
    { float v4[4]; float run = 0.f;
#pragma unroll
      for (int i = 0; i < 4; ++i) { run += clf[(size_t)(tid * 4 + i) * 8]; v4[i] = run; }
      float v = run;
#pragma unroll
      for (int o = 1; o < 64; o <<= 1) { const float t = __shfl_up(v, o); if (lane >= o) v += t; }
      if (lane == 63) red[wid] = v;
      __syncthreads();
      float add = v - run; for (int w = 0; w < wid; ++w) add += red[w];
#pragma unroll
      for (int i = 0; i < 4; ++i) bl[tid * 4 + i] = -(add + v4[i]) * LOG2E;
      if (tid == 511) { float f = add + run; for (int i = 0; i < 16; ++i) { f += p.out[O_SLF + (size_t)(b * 16 + i) * 8 + h]; bl[2048 + i] = -f * LOG2E; } }
      __syncthreads(); }
    bf16x8 qf[2];
#pragma unroll
    for (int k = 0; k < 2; ++k) qf[k] = *(const bf16x8*)(Q + (size_t)(TP + b * 16 + fr) * 512 + h * 64 + k * 32 + fq * 8);
    f32x4 sc[17];
#pragma unroll
    for (int i = 0; i < 17; ++i) { const int kt = wid + 8 * i; f32x4 c = (f32x4){-INFINITY, -INFINITY, -INFINITY, -INFINITY};
        if (kt < 129) {
            const float* kr = kt < 128 ? p.cache_k + ((size_t)(b * 2048 + kt * 16 + fr) * 8 + h) * 64 : p.out + O_SK + ((size_t)(b * 16 + fr) * 8 + h) * 64;
            c = *(const f32x4*)(bl + kt * 16 + fq * 4);
#pragma unroll
            for (int k = 0; k < 2; ++k) { const f32x4 a0 = *(const f32x4*)(kr + k * 32 + fq * 8), a1 = *(const f32x4*)(kr + k * 32 + fq * 8 + 4);
                const u32x4 av = (u32x4){cvtpk(a0[0], a0[1]), cvtpk(a0[2], a0[3]), cvtpk(a1[0], a1[1]), cvtpk(a1[2], a1[3])};
                c = __builtin_amdgcn_mfma_f32_16x16x32_bf16(__builtin_bit_cast(bf16x8, av), qf[k], c, 0, 0, 0); }
            if (kt == 128) {
#pragma unroll
                for (int j = 0; j < 4; ++j) if (fq * 4 + j > fr) c[j] = -INFINITY; }
        }
        sc[i] = c; }
    float m = -INFINITY;
#pragma unroll
    for (int i = 0; i < 17; ++i) m = fmaxf(m, fmaxf(fmaxf(sc[i][0], sc[i][1]), fmaxf(sc[i][2], sc[i][3])));
    m = fmaxf(m, __shfl_xor(m, 16)); m = fmaxf(m, __shfl_xor(m, 32));
    if (fq == 0) red[wid * 16 + fr] = m;
    __syncthreads();
    m = red[fr];
#pragma unroll
    for (int w = 1; w < 8; ++w) m = fmaxf(m, red[w * 16 + fr]);
    float l = 0.f;
#pragma unroll
    for (int i = 0; i < 17; ++i) {
#pragma unroll
        for (int j = 0; j < 4; ++j) { sc[i][j] = exp2f(sc[i][j] - m); l += sc[i][j]; } }
    l += __shfl_xor(l, 16); l += __shfl_xor(l, 32);
    if (fq == 0) red2[wid * 16 + fr] = l;
    __syncthreads();
    if (tid < 16) { float a = 0.f; for (int w = 0; w < 8; ++w) a += red2[w * 16 + tid]; stat[tid] = a; }
    f32x4 oT[4];
#pragma unroll
    for (int dt = 0; dt < 4; ++dt) oT[dt] = (f32x4){0.f, 0.f, 0.f, 0.f};
#pragma unroll
    for (int ii = 0; ii < 9; ++ii) { const int ktA = wid + 16 * ii, ktB = ktA + 8;
        if (ktA < 129) {
            const f32x4 sA = sc[2 * ii]; f32x4 sB = (f32x4){0.f, 0.f, 0.f, 0.f}; if (2 * ii + 1 < 17) sB = sc[(2 * ii + 1 < 17) ? 2 * ii + 1 : 0];
            const bool vB = ktB < 129;
            const u32x4 bv = (u32x4){cvtpk(sA[0], sA[1]), cvtpk(sA[2], sA[3]), vB ? cvtpk(sB[0], sB[1]) : 0u, vB ? cvtpk(sB[2], sB[3]) : 0u};
            const int keyA = ktA * 16 + fq * 4, keyB = ktB * 16 + fq * 4;
            const float* vA = keyA < 2048 ? p.cache_v + ((size_t)(b * 2048 + keyA) * 8 + h) * 64 : p.out + O_SV + ((size_t)(b * 16 + keyA - 2048) * 8 + h) * 64;
            const float* vBp = keyB < 2048 ? p.cache_v + ((size_t)(b * 2048 + keyB) * 8 + h) * 64 : p.out + O_SV + ((size_t)(b * 16 + (keyB - 2048)) * 8 + h) * 64;
#pragma unroll
            for (int dt = 0; dt < 4; ++dt) { float va[8];
#pragma unroll
                for (int e = 0; e < 4; ++e) { va[e] = vA[(size_t)e * 512 + dt * 16 + fr]; va[4 + e] = vB ? vBp[(size_t)e * 512 + dt * 16 + fr] : 0.f; }
                const u32x4 av = (u32x4){cvtpk(va[0], va[1]), cvtpk(va[2], va[3]), cvtpk(va[4], va[5]), cvtpk(va[6], va[7])};
                oT[dt] = __builtin_amdgcn_mfma_f32_16x16x32_bf16(__builtin_bit_cast(bf16x8, av), __builtin_bit_cast(bf16x8, bv), oT[dt], 0, 0, 0); }
        } }
#pragma unroll
    for (int dt = 0; dt < 4; ++dt) *(f32x4*)(ored + (wid * 16 + fr) * 64 + dt * 16 + fq * 4) = oT[dt];
    __syncthreads();
    bf16_t* SATT = (bf16_t*)(p.ws + W_SATT);
    for (int idx = tid; idx < 1024; idx += 512) { const int qi = idx >> 6, d = idx & 63; float a = 0.f;
#pragma unroll
        for (int w = 0; w < 8; ++w) a += ored[(w * 16 + qi) * 64 + d];
        SATT[(size_t)(b * 16 + qi) * 512 + h * 64 + d] = f2bf(a / stat[qi]); }
    __syncthreads();
}

struct SsdSrc { bool smp; int b, c, g; };
DEV SsdSrc ssd_decode(int u) { SsdSrc s; if (u < 512) { s.smp = false; s.b = u >> 8; s.c = (u >> 1) & 127; s.g = u & 1; } else { const int v = u - 512; s.smp = true; s.b = v >> 1; s.c = 0; s.g = v & 1; } return s; }
DEV int ssd_token(const SsdSrc& s, int l) { if (!s.smp) return s.b * SEQ + s.c * 64 + l; return l >= 48 ? TP + s.b * 16 + (l - 48) : -1; }
typedef __attribute__((address_space(3))) char* ldsp_t;

constexpr int L_ACS = 0, L_DT = 1024, L_RDT = 2048, L_TE = 3072, L_BM = 4096, L_CM = L_BM + 17408, L_BT = L_CM + 17408, L_XT = L_BT + 18432, L_XTE = L_XT + 36864;
static_assert(L_XTE + 36864 <= LDS_TOTAL, "ssd lds");

DEV void ssd_chunk_unit(const Params& p, int u, char* lds) {
    const SsdSrc s = ssd_decode(u);
    int tid = threadIdx.x; asm volatile("" : "+v"(tid)); const int lane = tid & 63, wid = tid >> 6, fr = lane & 15, fq = lane >> 4;
    unsigned char* ws = p.ws;
    const bf16_t* XBC = (const bf16_t*)(ws + W_RB); const float* DT = (const float*)(ws + W_DT);
    float* acs_l = (float*)(lds + L_ACS); float* dt_l = (float*)(lds + L_DT); float* rdt_l = (float*)(lds + L_RDT); float* te_l = (float*)(lds + L_TE);
    bf16_t* Bm = (bf16_t*)(lds + L_BM); bf16_t* Cm = (bf16_t*)(lds + L_CM); bf16_t* BTl = (bf16_t*)(lds + L_BT); bf16_t* XT = (bf16_t*)(lds + L_XT); bf16_t* XTE = (bf16_t*)(lds + L_XTE);
    const int uidx = s.smp ? 256 + s.b : s.b * 128 + s.c;
    int col, role, li; if (tid < 256) { role = 0; li = tid; col = s.g * 256 + tid; } else if (tid < 384) { role = 1; li = tid - 256; col = 512 + s.g * 128 + li; } else { role = 2; li = tid - 384; col = 768 + s.g * 128 + li; }
    const bf16_t* xcol = XBC + (size_t)(s.smp ? TP + s.b * 16 - 48 : s.b * SEQ + s.c * 64) * 1024 + col;
    const float* scol = p.state_ssd_conv + (size_t)(s.b * 3) * 1024 + col;
    auto ldb = [&](int lb, float* o) {
        if (!s.smp) {
#pragma unroll
            for (int i = 0; i < 16; ++i) o[i] = bf2f(xcol[(size_t)(lb + i) * 1024]); }
        else {
#pragma unroll
            for (int i = 0; i < 16; ++i) { const int l = lb + i; o[i] = l >= 48 ? bf2f(xcol[(size_t)l * 1024]) : (l >= 45 ? scol[(size_t)(l - 45) * 1024] : 0.f); } } };
    float x3, x2, x1;
    if (!s.smp) { const bool has = s.c > 0; const bf16_t* xh = has ? xcol : xcol + 3 * 1024;
        const float a = bf2f(xh[-3 * 1024]), bb = bf2f(xh[-2 * 1024]), cc = bf2f(xh[-1 * 1024]); x3 = has ? a : 0.f; x2 = has ? bb : 0.f; x1 = has ? cc : 0.f; }
    else { x3 = 0.f; x2 = 0.f; x1 = 0.f; }
    float xv[16]; ldb(0, xv);
    const float w0 = p.ssd_conv_w[col], w1 = p.ssd_conv_w[1024 + col], w2 = p.ssd_conv_w[2048 + col], w3 = p.ssd_conv_w[3072 + col], cb = p.ssd_conv_b[col];
    if (wid < 4) { const int h = s.g * 4 + wid; const int tok = ssd_token(s, lane);
        const float dt = tok >= 0 ? DT[(size_t)tok * 8 + h] : 0.f; const float a = -expf(p.ssd_a_log[h]);
        float v = dt * a;
#pragma unroll
        for (int o = 1; o < 64; o <<= 1) { const float t = __shfl_up(v, o); if (lane >= o) v += t; }
        const float tot = __shfl(v, 63);
        acs_l[wid * 64 + lane] = v; dt_l[wid * 64 + lane] = dt; rdt_l[wid * 64 + lane] = dt > 0.f ? 1.f / dt : 0.f; te_l[wid * 64 + lane] = expf(tot - v);
        if (tok >= 0) ((float*)(ws + W_ACS))[(size_t)tok * 8 + h] = v;
        if (lane == 63) ((float*)(ws + W_DEC))[uidx * 8 + h] = expf(tot); }
    __syncthreads();
    { const int hl = li >> 6, pp = li & 63;
      bf16_t* CG = (bf16_t*)(ws + W_CG);
#pragma unroll
      for (int lb = 0; lb < 64; lb += 16) { float xn[16];
        if (lb + 16 < 64) ldb(lb + 16, xn);
        float vv[16];
#pragma unroll
        for (int i = 0; i < 16; ++i) { const float x0 = xv[i]; const float y = cb + w0 * x3 + w1 * x2 + w2 * x1 + w3 * x0; x3 = x2; x2 = x1; x1 = x0; vv[i] = silu_f(y); }
        if (role == 0) {
#pragma unroll
            for (int i8 = 0; i8 < 16; i8 += 8) { u32x4 a, b;
#pragma unroll
                for (int q = 0; q < 4; ++q) { const int i = i8 + 2 * q, l = lb + i; const float xd0 = vv[i] * dt_l[hl * 64 + l], xd1 = vv[i + 1] * dt_l[hl * 64 + l + 1];
                    a[q] = cvtpk(xd0, xd1); b[q] = cvtpk(xd0 * te_l[hl * 64 + l], xd1 * te_l[hl * 64 + l + 1]); }
                *(u32x4*)(XT + (hl * 64 + pp) * 72 + lb + i8) = a; *(u32x4*)(XTE + (hl * 64 + pp) * 72 + lb + i8) = b; } }
        else if (role == 1) {
#pragma unroll
            for (int i8 = 0; i8 < 16; i8 += 8) { u32x4 a;
#pragma unroll
                for (int q = 0; q < 4; ++q) { const int i = i8 + 2 * q, l = lb + i; const unsigned pk = cvtpk(vv[i], vv[i + 1]); a[q] = pk;
                    Bm[l * 136 + li] = (bf16_t)(pk & 0xffffu); Bm[(l + 1) * 136 + li] = (bf16_t)(pk >> 16); }
                *(u32x4*)(BTl + li * 72 + lb + i8) = a; } }
        else {
#pragma unroll
            for (int i = 0; i < 16; ++i) { const int l = lb + i; const bf16_t bv = f2bf(vv[i]); Cm[l * 136 + li] = bv; const int tok = ssd_token(s, l); if (tok >= 0) CG[(size_t)tok * 256 + s.g * 128 + li] = bv; } }
        if (lb + 16 < 64) {
#pragma unroll
            for (int i = 0; i < 16; ++i) xv[i] = xn[i]; } } }
    __syncthreads();
    const int hl = wid >> 1, half = wid & 1, h = s.g * 4 + hl; const float dsk = p.ssd_d[h];
    bf16_t* YD = (bf16_t*)(ws + W_RA);
    const bf16_t* XTh = XT + hl * 64 * 72; const bf16_t* XTEh = XTE + hl * 64 * 72;
#pragma unroll
    for (int lti = 0; lti < 2; ++lti) { const int lt = half * 2 + lti; const int l = lt * 16 + fr; const float acl = acs_l[hl * 64 + l];
        u32x2 pk[4];
#pragma unroll
        for (int st = 0; st < 4; ++st) { pk[st] = (u32x2){0u, 0u};
            if (st <= lt) { f32x4 c = (f32x4){0.f, 0.f, 0.f, 0.f};
#pragma unroll
                for (int k = 0; k < 4; ++k) { const bf16x8 a = *(const bf16x8*)(Bm + (st * 16 + fr) * 136 + k * 32 + fq * 8), bb = *(const bf16x8*)(Cm + l * 136 + k * 32 + fq * 8);
                    c = __builtin_amdgcn_mfma_f32_16x16x32_bf16(a, bb, c, 0, 0, 0); }
                float e[4];
#pragma unroll
                for (int j = 0; j < 4; ++j) { const int sp = st * 16 + fq * 4 + j; e[j] = (l >= sp) ? c[j] * __expf(acl - acs_l[hl * 64 + sp]) : 0.f; }
                pk[st] = (u32x2){cvtpk(e[0], e[1]), cvtpk(e[2], e[3])}; } }
        const int tok = ssd_token(s, l);
#pragma unroll
        for (int pt = 0; pt < 4; ++pt) { f32x4 y = (f32x4){0.f, 0.f, 0.f, 0.f};
#pragma unroll
            for (int i = 0; i < 2; ++i) { if (2 * i <= lt) {
                const u32x2 x0 = *(const u32x2*)(XTh + (pt * 16 + fr) * 72 + i * 32 + fq * 4), x1 = *(const u32x2*)(XTh + (pt * 16 + fr) * 72 + i * 32 + 16 + fq * 4);
                const u32x4 av = (u32x4){x0[0], x0[1], x1[0], x1[1]}, bv = (u32x4){pk[2 * i][0], pk[2 * i][1], pk[2 * i + 1][0], pk[2 * i + 1][1]};
                y = __builtin_amdgcn_mfma_f32_16x16x32_bf16(__builtin_bit_cast(bf16x8, av), __builtin_bit_cast(bf16x8, bv), y, 0, 0, 0); } }
            if (tok >= 0) { const float rd = rdt_l[hl * 64 + l] * dsk; f32x4 o;
#pragma unroll
                for (int j = 0; j < 4; ++j) o[j] = y[j] + bf2f(XTh[(pt * 16 + fq * 4 + j) * 72 + l]) * rd;
                *(u32x2*)(YD + (size_t)tok * 512 + h * 64 + pt * 16 + fq * 4) = (u32x2){cvtpk(o[0], o[1]), cvtpk(o[2], o[3])}; } } }
    float* CS = s.smp ? (float*)(ws + W_CSS) + ((size_t)s.b * 8 + h) * 8192 : p.out + O_Y + ((size_t)(s.b * 128 + s.c) * 8 + h) * 8192;
#pragma unroll
    for (int nti = 0; nti < 4; ++nti) { const int nt = half * 4 + nti;
#pragma unroll
        for (int pt = 0; pt < 4; ++pt) { f32x4 c = (f32x4){0.f, 0.f, 0.f, 0.f};
#pragma unroll
            for (int i = 0; i < 2; ++i) { const bf16x8 a = *(const bf16x8*)(BTl + (nt * 16 + fr) * 72 + i * 32 + fq * 8), bb = *(const bf16x8*)(XTEh + (pt * 16 + fr) * 72 + i * 32 + fq * 8);
                c = __builtin_amdgcn_mfma_f32_16x16x32_bf16(a, bb, c, 0, 0, 0); }
            *(f32x4*)(CS + (size_t)(pt * 16 + fr) * 128 + nt * 16 + fq * 4) = c; } }
    __syncthreads();
}

DEV void ssd_scan(const Params& p, float* dummy = nullptr) {
    unsigned char* ws = p.ws; const float* DEC = (const float*)(ws + W_DEC);
    if (threadIdx.x < 256) {
        typedef __attribute__((ext_vector_type(2))) float f32x2v;
        for (int e2 = blockIdx.x * 256 + threadIdx.x; e2 < 2 * 32768; e2 += gridDim.x * 256) { const int e = e2 * 2, b = e >> 16, rest = e & 65535, h = rest >> 13;
            float* cs = p.out + O_Y + (size_t)b * 128 * 65536 + rest; float* cd = dummy ? dummy + (size_t)b * 128 * 65536 + rest : cs; f32x2v sv = (f32x2v){0.f, 0.f};
#pragma unroll 32
            for (int c = 0; c < 128; ++c) { const f32x2v t = *(const f32x2v*)(cs + (size_t)c * 65536); *(f32x2v*)(cd + (size_t)c * 65536) = sv; sv = sv * DEC[(b * 128 + c) * 8 + h] + t; }
            *(f32x2v*)((dummy ? dummy : p.out + O_PSSD) + e) = sv; }
    } else {
        for (int e4 = blockIdx.x * 256 + (threadIdx.x - 256); e4 < 16 * 16384; e4 += gridDim.x * 256) { const int e = e4 * 4, b = e >> 16, h = (e >> 13) & 7;
            const f32x4 s0 = *(const f32x4*)(p.state_ssd + e), c0 = *(const f32x4*)((const float*)(ws + W_CSS) + e);
            *(f32x4*)((dummy ? dummy : p.out + O_SSSD) + e) = s0 * DEC[(256 + b) * 8 + h] + c0; }
    }
}

DEV void ssd_final_unit(const Params& p, int u, char* lds) {
    const SsdSrc s = ssd_decode(u);
    int tid = threadIdx.x; asm volatile("" : "+v"(tid)); const int lane = tid & 63, wid = tid >> 6, fr = lane & 15, fq = lane >> 4;
    unsigned char* ws = p.ws;
    const int hl = wid >> 1, half = wid & 1, h = s.g * 4 + hl;
    float* ssl = (float*)lds;
    const float* sp = s.smp ? p.state_ssd + ((size_t)s.b * 8 + h) * 8192 : p.out + O_Y + ((size_t)(s.b * 128 + s.c) * 8 + h) * 8192;
    const bf16_t* CG = (const bf16_t*)(ws + W_CG); const bf16_t* YD = (const bf16_t*)(ws + W_RA); const float* ACS = (const float*)(ws + W_ACS);
    const bf16_t* Z = (const bf16_t*)(ws + W_Z); bf16_t* MIX = (bf16_t*)(ws + W_RB);
    if (s.smp) { const int r = tid >> 5, c8 = (tid & 31) * 8;
        *(u32x4*)(MIX + (size_t)(TP + s.b * 16 + r) * 1024 + 512 + s.g * 256 + c8) = *(const u32x4*)((const bf16_t*)(ws + W_SATT) + (size_t)(s.b * 16 + r) * 512 + s.g * 256 + c8); }
    f32x4 acc[2][4]; int tok[2]; bool tv[2];
#pragma unroll
    for (int lti = 0; lti < 2; ++lti) { tok[lti] = ssd_token(s, (half * 2 + lti) * 16 + fr); tv[lti] = !s.smp || (half * 2 + lti == 3);
#pragma unroll
        for (int pt = 0; pt < 4; ++pt) acc[lti][pt] = (f32x4){0.f, 0.f, 0.f, 0.f}; }
    f32x4 yd[2][4]; u32x2 zz[2][4]; float ea[2] = {0.f, 0.f}; f32x4 ng[4];
#pragma unroll
    for (int pt = 0; pt < 4; ++pt) ng[pt] = *(const f32x4*)(p.ssd_norm_g + h * 64 + pt * 16 + fq * 4);
#pragma unroll
    for (int lti = 0; lti < 2; ++lti) if (tv[lti]) { ea[lti] = ACS[(size_t)tok[lti] * 8 + h];
#pragma unroll
        for (int pt = 0; pt < 4; ++pt) { const int ch = h * 64 + pt * 16 + fq * 4; { const u32x2 yb = *(const u32x2*)(YD + (size_t)tok[lti] * 512 + ch); yd[lti][pt] = (f32x4){bflo(yb[0]), bfhi(yb[0]), bflo(yb[1]), bfhi(yb[1])}; } zz[lti][pt] = *(const u32x2*)(Z + (size_t)tok[lti] * 512 + ch); } }
    if (tv[0] || tv[1]) {
#pragma unroll
        for (int k = 0; k < 4; ++k) { bf16x8 cb[2];
#pragma unroll
            for (int lti = 0; lti < 2; ++lti) { u32x4 t = (u32x4){0u, 0u, 0u, 0u}; if (tv[lti]) t = *(const u32x4*)(CG + (size_t)tok[lti] * 256 + s.g * 128 + k * 32 + fq * 8); cb[lti] = __builtin_bit_cast(bf16x8, t); }
#pragma unroll
            for (int pt = 0; pt < 4; ++pt) { const float* r = sp + (size_t)(pt * 16 + fr) * 128 + k * 32 + fq * 8; const f32x4 a0 = *(const f32x4*)r, a1 = *(const f32x4*)(r + 4);
                const u32x4 av = (u32x4){cvtpk(a0[0], a0[1]), cvtpk(a0[2], a0[3]), cvtpk(a1[0], a1[1]), cvtpk(a1[2], a1[3])};
#pragma unroll
                for (int lti = 0; lti < 2; ++lti) if (tv[lti]) acc[lti][pt] = __builtin_amdgcn_mfma_f32_16x16x32_bf16(__builtin_bit_cast(bf16x8, av), cb[lti], acc[lti][pt], 0, 0, 0); } } }
#pragma unroll
    for (int lti = 0; lti < 2; ++lti) { const int l = (half * 2 + lti) * 16 + fr; float ss = 0.f;
        if (tv[lti]) { const float eav = __expf(ea[lti]);
#pragma unroll
            for (int pt = 0; pt < 4; ++pt) { const u32x2 z2 = zz[lti][pt];
                const float z0 = bflo(z2[0]), z1 = bfhi(z2[0]), z2f = bflo(z2[1]), z3 = bfhi(z2[1]);
                f32x4 y = yd[lti][pt] + acc[lti][pt] * eav; y[0] *= silu_f(z0); y[1] *= silu_f(z1); y[2] *= silu_f(z2f); y[3] *= silu_f(z3);
                acc[lti][pt] = y; ss += y[0] * y[0] + y[1] * y[1] + y[2] * y[2] + y[3] * y[3]; }
            ss += __shfl_xor(ss, 16); ss += __shfl_xor(ss, 32);
            if (fq == 0) ssl[l * 4 + hl] = ss; } }
    __syncthreads();
#pragma unroll
    for (int lti = 0; lti < 2; ++lti) { const int l = (half * 2 + lti) * 16 + fr;
        if (tv[lti]) { const f32x4 q = *(const f32x4*)(ssl + l * 4); const float rs = rsqrtf((q[0] + q[1] + q[2] + q[3]) * (1.f / 256.f) + EPS);
#pragma unroll
            for (int pt = 0; pt < 4; ++pt) { const int ch = h * 64 + pt * 16 + fq * 4; const f32x4 y = acc[lti][pt] * rs * ng[pt];
                *(u32x2*)(MIX + (size_t)tok[lti] * 1024 + ch) = (u32x2){cvtpk(y[0], y[1]), cvtpk(y[2], y[3])}; } } }
    __syncthreads();
}

namespace att {
constexpr int D = 64, QDM = 512, NW = 8, QBLK = 32, QB = QBLK * NW, KVBLK = 64, NQB = SEQ / QB, OPITCH = 1024;
constexpr float C2 = 1.0f;
constexpr int THR = 48;
constexpr int SLOTB = 8192, LDS_K = 0, LDS_V = 3 * SLOTB, LDS_WS = 6 * SLOTB, LDS_OST = LDS_WS + NW * 256, LDS_BYTES = LDS_OST + NW * 4096, LDS_GB = LDS_BYTES;
static_assert(LDS_GB + SEQ * 4 <= LDS_TOTAL, "attention lds");
#define SBAR() __builtin_amdgcn_sched_barrier(0)
#define PIN(x) asm volatile("" : "+v"(x))
#define MFMA(a, b, c) __builtin_amdgcn_mfma_f32_32x32x16_bf16(a, b, c, 0, 0, 0)
#define WAIT_BAR(N) asm volatile("s_waitcnt vmcnt(" #N ") lgkmcnt(0)\n\ts_barrier" ::: "memory")
DEV int crow(int r, int hi) { return (r & 3) + 8 * (r >> 2) + 4 * hi; }
DEV void glds16(const void* g, unsigned lds_base) {
    unsigned sv; asm volatile("s_mov_b32 %0, m0\n\ts_mov_b32 m0, %2\n\ts_nop 0\n\tglobal_load_lds_dwordx4 %1, off\n\ts_mov_b32 m0, %0" : "=&s"(sv) : "v"(g), "s"(lds_base) : "memory"); }
typedef __attribute__((address_space(3))) const char* lds_cptr;
typedef short v4i16_t __attribute__((ext_vector_type(4)));
DEV void kload2(bf16x8* kf, lds_cptr kp, int d0) { kf[2 * d0] = *(const __attribute__((address_space(3))) bf16x8*)(kp + d0 * 2048); kf[2 * d0 + 1] = *(const __attribute__((address_space(3))) bf16x8*)(kp + d0 * 2048 + 512); }
DEV s16x4 vtr(lds_cptr p) { return __builtin_bit_cast(s16x4, __builtin_amdgcn_ds_read_tr16_b64_v4i16((__attribute__((address_space(3))) v4i16_t*)p)); }
#define MX3(a, b, c) __builtin_fmaxf(__builtin_fmaxf((a), (b)), (c))
DEV float rowmax(const f32x16& p0, const f32x16& p1) {
    float a = MX3(p0[0], p0[1], p1[0]), b = MX3(p0[2], p0[3], p1[1]); a = MX3(a, p1[2], p1[3]);
#pragma unroll
    for (int r = 4; r < 16; r += 4) { a = MX3(a, p0[r], p0[r + 1]); b = MX3(b, p0[r + 2], p0[r + 3]); a = MX3(a, p1[r], p1[r + 1]); b = MX3(b, p1[r + 2], p1[r + 3]); }
    float m = __builtin_fmaxf(a, b); auto rr = __builtin_amdgcn_permlane32_swap(__float_as_uint(m), __float_as_uint(m), false, false);
    return __builtin_fmaxf(__uint_as_float(rr[0]), __uint_as_float(rr[1])); }
DEV void cmask(f32x16& p0, f32x16& p1, int jb, int qrel, int hi) {
    const int kb = 64 * jb + 4 * hi;
#pragma unroll
    for (int r = 0; r < 16; ++r) { const int kv = kb + (r & 3) + 8 * (r >> 2); if (kv > qrel) p0[r] = -INFINITY; if (kv + 32 > qrel) p1[r] = -INFINITY; } }
typedef __attribute__((address_space(3))) const f32x4* lds_f4p;
DEV void loadbias(f32x16& c0, f32x16& c1, lds_f4p gb, int t, int hi) {
#pragma unroll
    for (int i = 0; i < 4; ++i) { const f32x4 a = gb[16 * t + hi + 2 * i], b = gb[16 * t + 8 + hi + 2 * i];
        c0[4 * i] = a[0]; c0[4 * i + 1] = a[1]; c0[4 * i + 2] = a[2]; c0[4 * i + 3] = a[3]; c1[4 * i] = b[0]; c1[4 * i + 1] = b[1]; c1[4 * i + 2] = b[2]; c1[4 * i + 3] = b[3]; } }

DEV void attn64_unit(int b, int h, int qb, int bias_qb, const bf16_t* Q, const bf16_t* __restrict__ K, const bf16_t* __restrict__ V, const float* __restrict__ G, bf16_t* O, char* lds) {
    int tid = threadIdx.x; asm volatile("" : "+v"(tid));
    const int lane = tid & 63, r32 = lane & 31, hi = lane >> 5; const int wid = __builtin_amdgcn_readfirstlane(tid >> 6);
    const long rowbase = (long)b * SEQ; const int q0 = qb * QB, NT = (q0 + QB) / KVBLK;
    const bf16_t* Qw = Q + (rowbase + q0 + wid * QBLK) * QDM + h * D;
    const unsigned lds0 = (unsigned)(uintptr_t)lds; float* wsf = (float*)(lds + LDS_WS) + wid * 64;
    if (bias_qb >= 0) { const f32x4* src = (const f32x4*)(G + ((size_t)b * 8 + h) * SEQ); f32x4* dst = (f32x4*)(lds + LDS_GB); const int n4 = (bias_qb * QB + QB) / 4;
      for (int i = tid; i < n4; i += 512) dst[i] = src[i];
      asm volatile("s_waitcnt vmcnt(0) lgkmcnt(0)" ::: "memory"); }
    const lds_f4p gb = (lds_f4p)((lds_cptr)lds + LDS_GB);
    const bf16_t* ksrc = K + rowbase * QDM + h * D + (long)lane * QDM + wid * 8;
    const bf16_t* vsrc = V + rowbase * QDM + h * D + (long)(16 * (wid & 3) + (lane >> 2)) * QDM + (wid >> 2) * 32 + (lane & 3) * 8;
    const unsigned kdst = lds0 + LDS_K + wid * 1024, vdst = lds0 + LDS_V + wid * 1024;
#define DMA_K(t, slot) glds16(ksrc + (long)(t) * KVBLK * QDM, (unsigned)__builtin_amdgcn_readfirstlane(kdst + (slot)))
#define DMA_V(t, slot) glds16(vsrc + (long)(t) * KVBLK * QDM, (unsigned)__builtin_amdgcn_readfirstlane(vdst + (slot)))
    const lds_cptr vp0 = (lds_cptr)lds + LDS_V + ((lane >> 4) & 1) * 32 + (lane & 3) * 8 + (4 * hi + ((lane & 15) >> 2)) * 64;
    const lds_cptr kp0 = (lds_cptr)lds + LDS_K + hi * 1024 + r32 * 16;
    DMA_K(0, 0); DMA_V(0, 0); DMA_K(1, SLOTB);
    bf16x8 qr[4];
#pragma unroll
    for (int d0 = 0; d0 < 4; ++d0) qr[d0] = *reinterpret_cast<const bf16x8*>(&Qw[(long)r32 * QDM + d0 * 16 + hi * 8]);
    float mhat = 0.f, l_reg = 0.f; f32x16 o[2]; o[0] = f32x16{}; o[1] = f32x16{};
    const int qrel = wid * QBLK + r32; bool resc = false;
    f32x16 pA0, pA1, pB0, pB1; bf16x8 kf[8]; s16x4 vlo[8], vhi[8]; u32x4 pw0, pw1, pw2, pw3;
    int sl_prev = 0, sl_cur = 0, sl_next = SLOTB;
#define ROT() do { sl_prev = sl_cur; sl_cur = sl_next; sl_next = (sl_next == 2 * SLOTB) ? 0 : sl_next + SLOTB; } while (0)
#define EX(v) __builtin_amdgcn_exp2f(__builtin_fmaf((v), C2, nmh))
#define RESC() do { if (resc) { _Pragma("unroll") for (int d_ = 0; d_ < 2; ++d_) _Pragma("unroll") for (int r = 0; r < 16; ++r) o[d_][r] *= wsf[crow(r, hi)]; } } while (0)
    DMA_K(2, 2 * SLOTB);
    WAIT_BAR(3);
    _Pragma("unroll") for (int d0 = 0; d0 < 4; ++d0) kload2(kf, kp0, d0);
    loadbias(pA0, pA1, gb, 0, hi);
    pA0 = MFMA(kf[0], qr[0], pA0); pA1 = MFMA(kf[1], qr[0], pA1); pA0 = MFMA(kf[2], qr[1], pA0); pA1 = MFMA(kf[3], qr[1], pA1);
    pA0 = MFMA(kf[4], qr[2], pA0); pA1 = MFMA(kf[5], qr[2], pA1); pA0 = MFMA(kf[6], qr[3], pA0); pA1 = MFMA(kf[7], qr[3], pA1);
    if (NT == 4) cmask(pA0, pA1, 0, qrel, hi);
    { const float rm = rowmax(pA0, pA1); mhat = rm * C2; const float nmh = -mhat;
#pragma unroll
      for (int r = 0; r < 16; ++r) { pA0[r] = EX(pA0[r]); pA1[r] = EX(pA1[r]); } }
    WAIT_BAR(0);
    DMA_K(3, 0); DMA_V(1, SLOTB); ROT();
    _Pragma("unroll") for (int d0 = 0; d0 < 4; ++d0) kload2(kf, kp0 + sl_cur, d0);
    WAIT_BAR(2);
#define PKW(P, i) cvtpk(P[i], P[i + 1])
#define PAF(k) __builtin_bit_cast(bf16x8, pw##k)
#define VFR(i) (bf16x8){vlo[i][0], vlo[i][1], vlo[i][2], vlo[i][3], vhi[i][0], vhi[i][1], vhi[i][2], vhi[i][3]}
#define VRD(i) do { vlo[i] = vtr(vp_ + (((i) >> 2) * 4096 + ((i) & 3) * 1024)); vhi[i] = vtr(vp_ + (((i) >> 2) * 4096 + ((i) & 3) * 1024 + 512)); } while (0)
#define KRD(G_, d0) do { if (G_) { kload2(kf, kp0 + sl_next, d0); SBAR(); } } while (0)
#define GAPA(MF, a0, a1, a2, a3, W0, W1, PW) do { MF; sacc += a0; sacc += a1; sacc += a2; sacc += a3; W0; W1; PIN(PW); PIN(sacc); SBAR(); } while (0)
#define GAPB(MF, X, i) do { MF; X[i] = EX(X[i]); X[i + 1] = EX(X[i + 1]); X[i + 2] = EX(X[i + 2]); X[i + 3] = EX(X[i + 3]); PIN(X); SBAR(); } while (0)
#define STEP(C0, C1, P0, P1, t, MASK, GK, GV, GL) do { SBAR(); \
    const lds_cptr vp_ = vp0 + sl_prev; \
    VRD(0); SBAR(); float sacc = P0[0] + P0[1]; \
                    GAPA(C0 = MFMA(kf[0], qr[0], C0), P0[2], P0[3], P0[4], P0[5],     pw0[0] = PKW(P0, 0),  pw0[1] = PKW(P0, 2),  pw0); \
    VRD(4); SBAR(); GAPA(C1 = MFMA(kf[1], qr[0], C1), P0[6], P0[7], P0[8], P0[9],     pw0[2] = PKW(P0, 4),  pw0[3] = PKW(P0, 6),  pw0); \
    VRD(1); SBAR(); GAPA(C0 = MFMA(kf[2], qr[1], C0),    P0[10], P0[11], P0[12], P0[13], pw1[0] = PKW(P0, 8),  pw1[1] = PKW(P0, 10), pw1); \
    VRD(5); SBAR(); GAPA(C1 = MFMA(kf[3], qr[1], C1),    P0[14], P0[15], P1[0], P1[1],   pw1[2] = PKW(P0, 12), pw1[3] = PKW(P0, 14), pw1); \
    VRD(2); SBAR(); GAPA(C0 = MFMA(kf[4], qr[2], C0),    P1[2], P1[3], P1[4], P1[5],     pw2[0] = PKW(P1, 0),  pw2[1] = PKW(P1, 2),  pw2); \
    VRD(6); SBAR(); GAPA(C1 = MFMA(kf[5], qr[2], C1),    P1[6], P1[7], P1[8], P1[9],     pw2[2] = PKW(P1, 4),  pw2[3] = PKW(P1, 6),  pw2); \
    VRD(3); SBAR(); GAPA(C0 = MFMA(kf[6], qr[3], C0),    P1[10], P1[11], P1[12], P1[13], pw3[0] = PKW(P1, 8),  pw3[1] = PKW(P1, 10), pw3); \
    VRD(7); SBAR(); GAPA(C1 = MFMA(kf[7], qr[3], C1),    P1[14], P1[15], 0.f, 0.f,       pw3[2] = PKW(P1, 12), pw3[3] = PKW(P1, 14), pw3); \
    l_reg += sacc; \
    if (GK) DMA_K((t) + 3, sl_cur); if (GV) DMA_V((t) + 1, sl_next); \
    if (MASK) cmask(C0, C1, (t) - (NT - 4), qrel, hi); \
    { const float rm = __builtin_fmaf(rowmax(C0, C1), C2, -mhat); resc = false; \
      if (__any(rm > (float)THR)) { const float dl = __builtin_fmaxf(rm, 0.f); mhat += dl; \
          const float f = __builtin_amdgcn_exp2f(-dl); l_reg *= f; if (hi == 0) wsf[r32] = f; resc = true; } } \
    const float nmh = -mhat; SBAR(); \
    if (GL) { loadbias(P0, P1, gb, (t) + 1, hi); SBAR(); }            \
    GAPB(o[0] = MFMA(PAF(0), VFR(0), o[0]), C0, 0);              GAPB(o[1] = MFMA(PAF(0), VFR(4), o[1]), C0, 4); \
    KRD(GL, 0); GAPB(o[0] = MFMA(PAF(1), VFR(1), o[0]), C0, 8);  KRD(GL, 1); GAPB(o[1] = MFMA(PAF(1), VFR(5), o[1]), C0, 12); \
    KRD(GL, 2); GAPB(o[0] = MFMA(PAF(2), VFR(2), o[0]), C1, 0);  KRD(GL, 3); GAPB(o[1] = MFMA(PAF(2), VFR(6), o[1]), C1, 4); \
    GAPB(o[0] = MFMA(PAF(3), VFR(3), o[0]), C1, 8);              GAPB(o[1] = MFMA(PAF(3), VFR(7), o[1]), C1, 12); \
    } while (0)
    loadbias(pB0, pB1, gb, 1, hi);
    int t = 1;
    for (; t + 5 < NT; t += 2) {
        STEP(pB0, pB1, pA0, pA1, t, false, true, true, true);     WAIT_BAR(2); RESC(); ROT();
        STEP(pA0, pA1, pB0, pB1, t + 1, false, true, true, true); WAIT_BAR(2); RESC(); ROT();
    }
#define ENDW(tt) do { if ((tt) + 3 < NT) { WAIT_BAR(2); } else if ((tt) + 2 < NT) { WAIT_BAR(1); } else { WAIT_BAR(0); } } while (0)
    for (; t + 1 < NT; t += 2) {
        STEP(pB0, pB1, pA0, pA1, t, true, (t + 3 < NT), (t + 1 < NT), (t + 1 < NT));         ENDW(t);     RESC(); ROT();
        STEP(pA0, pA1, pB0, pB1, t + 1, true, (t + 4 < NT), (t + 2 < NT), (t + 2 < NT));     ENDW(t + 1); RESC(); ROT();
    }
    STEP(pB0, pB1, pA0, pA1, NT - 1, true, false, false, false); RESC();
    { float sacc = pB0[0] + pB0[1];
#pragma unroll
      for (int r = 2; r < 16; ++r) sacc += pB0[r];
#pragma unroll
      for (int r = 0; r < 16; ++r) sacc += pB1[r];
      l_reg += sacc;
      pw0 = (u32x4){PKW(pB0, 0), PKW(pB0, 2), PKW(pB0, 4), PKW(pB0, 6)}; pw1 = (u32x4){PKW(pB0, 8), PKW(pB0, 10), PKW(pB0, 12), PKW(pB0, 14)};
      pw2 = (u32x4){PKW(pB1, 0), PKW(pB1, 2), PKW(pB1, 4), PKW(pB1, 6)}; pw3 = (u32x4){PKW(pB1, 8), PKW(pB1, 10), PKW(pB1, 12), PKW(pB1, 14)};
      const lds_cptr vp_ = vp0 + sl_cur; _Pragma("unroll") for (int i = 0; i < 8; ++i) VRD(i);
      o[0] = MFMA(PAF(0), VFR(0), o[0]); o[1] = MFMA(PAF(0), VFR(4), o[1]); o[0] = MFMA(PAF(1), VFR(1), o[0]); o[1] = MFMA(PAF(1), VFR(5), o[1]);
      o[0] = MFMA(PAF(2), VFR(2), o[0]); o[1] = MFMA(PAF(2), VFR(6), o[1]); o[0] = MFMA(PAF(3), VFR(3), o[0]); o[1] = MFMA(PAF(3), VFR(7), o[1]); }
    { auto rr = __builtin_amdgcn_permlane32_swap(__float_as_uint(l_reg), __float_as_uint(l_reg), false, false); l_reg = __uint_as_float(rr[0]) + __uint_as_float(rr[1]); }
    if (hi == 0) wsf[32 + r32] = l_reg; asm volatile("s_waitcnt lgkmcnt(0)" ::: "memory");
    float rli[16];
#pragma unroll
    for (int r = 0; r < 16; ++r) rli[r] = __builtin_amdgcn_rcpf(wsf[32 + crow(r, hi)]);
    bf16_t* Ow = O + (rowbase + q0 + wid * QBLK) * OPITCH + h * D; bf16_t* stg = (bf16_t*)(lds + LDS_OST) + wid * 2048;
#pragma unroll
    for (int r = 0; r < 16; ++r) { const int orow = crow(r, hi);
#pragma unroll
        for (int d0 = 0; d0 < 2; ++d0) stg[orow * 64 + d0 * 32 + r32] = f2bf(o[d0][r] * rli[r]); }
    asm volatile("s_waitcnt lgkmcnt(0)" ::: "memory");
#pragma unroll
    for (int i = 0; i < 4; ++i) { const int row = i * 8 + (lane >> 3), ch = lane & 7; *(u32x4*)(Ow + (long)row * OPITCH + ch * 8) = *(const u32x4*)(stg + row * 64 + ch * 8); }
    asm volatile("s_waitcnt lgkmcnt(0)\n\ts_barrier" ::: "memory");
#undef DMA_K
#undef DMA_V
#undef ROT
#undef EX
#undef RESC
#undef PKW
#undef PAF
#undef VFR
#undef VRD
#undef KRD
#undef ENDW
#undef GAPA
#undef GAPB
#undef STEP
}
}

DEV void ffn_conv_gate(const Params& p, int hf) {
    unsigned char* ws = p.ws; const bf16_t* U = (const bf16_t*)(ws + W_U); bf16_t* ACT = (bf16_t*)(ws + W_ACT);
    const int nitems = (TA / 32) * 176;
    for (int it = blockIdx.x * 512 + threadIdx.x; it < nitems; it += gridDim.x * 512) {
        const int run = it / 176, cg8 = it % 176, row0 = run * 32; const int ja = hf * 1408 + cg8 * 8;
        const int lc = cg8 * 8, ug = (lc >> 7) * 256 + (lc & 127), uv = ug + 128;
        const bool smp = row0 >= TP;
        float wg[3][8], wv[3][8], bg[8], bv[8];
#pragma unroll
        for (int e = 0; e < 8; ++e) { bg[e] = p.ffn_conv_b[ja + e]; bv[e] = p.ffn_conv_b[DFF + ja + e];
#pragma unroll
            for (int j = 0; j < 3; ++j) { wg[j][e] = p.ffn_conv_w[j * NUP + ja + e]; wv[j][e] = p.ffn_conv_w[j * NUP + DFF + ja + e]; } }
        float g2[8], g1[8], v2[8], v1[8];
        auto unpack = [](const u32x4& a, float* o) {
#pragma unroll
            for (int e = 0; e < 4; ++e) { o[2 * e] = bflo(a[e]); o[2 * e + 1] = bfhi(a[e]); } };
        auto init_window = [&](int row) {
            if (smp) { const int b = (row - TP) >> 4; const float* s0 = p.state_ffn_conv + (size_t)(b * 2) * NUP, *s1 = s0 + NUP;
#pragma unroll
                for (int e = 0; e < 8; ++e) { g2[e] = s0[ja + e]; v2[e] = s0[DFF + ja + e]; g1[e] = s1[ja + e]; v1[e] = s1[DFF + ja + e]; } }
            else if ((row & 8191) == 0) {
#pragma unroll
                for (int e = 0; e < 8; ++e) { g2[e] = 0.f; v2[e] = 0.f; g1[e] = 0.f; v1[e] = 0.f; } }
            else { unpack(*(const u32x4*)(U + (size_t)(row - 2) * DFF + ug), g2); unpack(*(const u32x4*)(U + (size_t)(row - 2) * DFF + uv), v2);
                   unpack(*(const u32x4*)(U + (size_t)(row - 1) * DFF + ug), g1); unpack(*(const u32x4*)(U + (size_t)(row - 1) * DFF + uv), v1); } };
        init_window(row0);
#pragma unroll 4
        for (int r = 0; r < 32; ++r) { const int row = row0 + r;
            if (smp && r == 16) init_window(row);
            float g0[8], v0[8]; unpack(*(const u32x4*)(U + (size_t)row * DFF + ug), g0); unpack(*(const u32x4*)(U + (size_t)row * DFF + uv), v0);
            u32x4 o;
#pragma unroll
            for (int e = 0; e < 4; ++e) { float a[2];
#pragma unroll
                for (int q = 0; q < 2; ++q) { const int i = 2 * e + q; const float cg = bg[i] + wg[0][i] * g2[i] + wg[1][i] * g1[i] + wg[2][i] * g0[i], cv = bv[i] + wv[0][i] * v2[i] + wv[1][i] * v1[i] + wv[2][i] * v0[i];
                    a[q] = silu_f(cg) * cv; }
                o[e] = cvtpk(a[0], a[1]); }
            *(u32x4*)(ACT + (size_t)row * DFF + ja) = o;
#pragma unroll
            for (int e = 0; e < 8; ++e) { g2[e] = g1[e]; g1[e] = g0[e]; v2[e] = v1[e]; v1[e] = v0[e]; }
        }
    }
}

#define XB_TMO      128
#define XB_XCNT(j)  (256  + 64 * (j))
#define XB_XSUB(j)  (1280 + 64 * (j))
#define XB_XGEN(j)  (2304 + 64 * (j))
#define XB_TOP      3328
#define XB_TOPGEN   3392
#define XCD_BAR_WORDS 3456
#define XB_SPIN_CAP (1u << 18)
#define LAS __attribute__((address_space(3)))
DEV unsigned xb_ld(unsigned* p)              { return __hip_atomic_load(p, __ATOMIC_RELAXED, __HIP_MEMORY_SCOPE_AGENT); }
DEV unsigned xb_add(unsigned* p, unsigned v) { return __hip_atomic_fetch_add(p, v, __ATOMIC_RELAXED, __HIP_MEMORY_SCOPE_AGENT); }
DEV unsigned xb_xcc_id() { return (unsigned)__builtin_amdgcn_s_getreg((3 << 11) | 20) & 0xFu; }
#define XB_SPIN(cond, bar) do { unsigned _sp = 0; while (cond) { __builtin_amdgcn_s_sleep(1); \
    if ((++_sp & 255u) == 0u) { if (xb_ld(&(bar)[XB_TMO])) break; if (_sp > XB_SPIN_CAP) { atomicAdd(&(bar)[XB_TMO], 1u); break; } } } } while (0)
struct XcdBarrier { unsigned* bar; unsigned x; volatile LAS unsigned* st; };
DEV XcdBarrier xcd_barrier_post(unsigned* bar, volatile LAS unsigned* st) {
    XcdBarrier b; b.bar = bar; b.x = xb_xcc_id(); b.st = st;
    if (threadIdx.x == 0) (void)xb_add(&bar[XB_XCNT(b.x)], 1u);
    return b;
}
DEV void xcd_barrier_complete(unsigned* bar, unsigned x, unsigned& nloc, unsigned& nx) {
    const unsigned G = gridDim.x * gridDim.y * gridDim.z;
    unsigned sum, cnt, mine, sp = 0u;
    for (;;) {
        sum = 0u; cnt = 0u; mine = 0u;
#pragma unroll
        for (unsigned j = 0; j < 16; ++j) { const unsigned c = xb_ld(&bar[XB_XCNT(j)]); sum += c; cnt += (c > 0u) ? 1u : 0u; mine = (j == x) ? c : mine; }
        if (sum == G) break;
        __builtin_amdgcn_s_sleep(1);
        if ((++sp & 255u) == 0u) { if (xb_ld(&bar[XB_TMO])) break; if (sp > XB_SPIN_CAP) { atomicAdd(&bar[XB_TMO], 1u); break; } }
    }
    nloc = mine > 0u ? mine : 1u; nx = cnt > 0u ? cnt : 1u;
}
DEV void xcd_barrier(const XcdBarrier& b) {
    asm volatile("s_waitcnt vmcnt(0)" ::: "memory");
    __syncthreads();
    if (threadIdx.x == 0) {
        unsigned* bar = b.bar;
        __builtin_amdgcn_s_waitcnt(0);
        unsigned nloc = b.st[0], nx = b.st[1];
        if (nloc == 0u) { xcd_barrier_complete(bar, b.x, nloc, nx); b.st[0] = nloc; b.st[1] = nx; }
        const unsigned old = xb_add(&bar[XB_XSUB(b.x)], 1u);
        const unsigned gen = old / nloc;
        if (old + 1u == (gen + 1u) * nloc) {
            __builtin_amdgcn_fence(__ATOMIC_RELEASE, "agent");
            asm volatile("s_waitcnt vmcnt(0)" ::: "memory");
            const unsigned og = xb_add(&bar[XB_TOP], 1u);
            const unsigned tg = og / nx;
            if (og + 1u == (tg + 1u) * nx) xb_add(&bar[XB_TOPGEN], 1u);
            else XB_SPIN(xb_ld(&bar[XB_TOPGEN]) == tg, bar);
            __builtin_amdgcn_fence(__ATOMIC_ACQUIRE, "agent");
            xb_add(&bar[XB_XGEN(b.x)], 1u);
            asm volatile("s_waitcnt vmcnt(0)" ::: "memory");
        } else {
            XB_SPIN(xb_ld(&bar[XB_XGEN(b.x)]) == gen, bar);
            __builtin_amdgcn_fence(__ATOMIC_ACQUIRE, "agent");
            asm volatile("s_waitcnt vmcnt(0)" ::: "memory");
        }
    }
    __syncthreads();
}

struct EpiDownNorm {
    const bf16_t* Hb; float* X; unsigned* cnt; unsigned* tmo; const float* g; float* Y; char* lds;
    DEV void operator()(f32x4 (&acc)[2][2][4][2], int pm, int pn, int wr, int wc, int fr, int fq) const {
        float* Pl = (float*)lds; float* Sl = (float*)(lds + 4096);
        EPI_LOOP_BEGIN
            float ss = 0.f;
            EPI_COLS_BEGIN
                const u32x2 hb = *(const u32x2*)(Hb + (size_t)row * 1024 + col); const f32x4 h = v + (f32x4){bflo(hb[0]), bfhi(hb[0]), bflo(hb[1]), bfhi(hb[1])};
                acc[ai][bj][m][n] = h; ss += h[0] * h[0] + h[1] * h[1] + h[2] * h[2] + h[3] * h[3];
            }
            ss += __shfl_xor(ss, 16); ss += __shfl_xor(ss, 32);
            if (fq == 0) Pl[(row - pm * BM) * 4 + wc] = ss;
        }
        __syncthreads();
        int tid = threadIdx.x; asm volatile("" : "+v"(tid));
        if (tid < 256) { const f32x4 q = *(const f32x4*)(Pl + tid * 4); __hip_atomic_store(X + ((size_t)pm * 256 + tid) * 4 + pn, (q[0] + q[1]) + (q[2] + q[3]), __ATOMIC_RELAXED, __HIP_MEMORY_SCOPE_AGENT); }
        asm volatile("s_waitcnt vmcnt(0)" ::: "memory");
        __syncthreads();
        if (tid == 0) { (void)xb_add(cnt + pm * 16, 1u); unsigned sp = 0u;
            while (xb_ld(cnt + pm * 16) < 4u) { __builtin_amdgcn_s_sleep(1); if (++sp > (1u << 20)) { atomicAdd(tmo, 1u); break; } } }
        __syncthreads();
        if (tid < 256) { const float* xs = X + ((size_t)pm * 256 + tid) * 4; float q[4];
#pragma unroll
            for (int i = 0; i < 4; ++i) q[i] = __hip_atomic_load(xs + i, __ATOMIC_RELAXED, __HIP_MEMORY_SCOPE_AGENT);
            Sl[tid] = rsqrtf(((q[0] + q[1]) + (q[2] + q[3])) * (1.f / 1024.f) + EPS); }
        __syncthreads();
        EPI_LOOP_BEGIN
            const float rs = Sl[row - pm * BM];
            EPI_COLS_BEGIN
                const f32x4 gg = *(const f32x4*)(g + col);
                __builtin_nontemporal_store(v * rs * gg, (f32x4*)(Y + (size_t)row * 1024 + col));
            }
        }
        __syncthreads();
    }
};
struct SampleNormPost {
    float* Y; float* SS; const float* g; unsigned* cnt; char* lds;
    DEV void operator()(int mt) const {
        int tid = threadIdx.x; asm volatile("" : "+v"(tid)); const int rg = mt & 7;
        unsigned* flag = (unsigned*)(lds + 36864);
        __builtin_amdgcn_fence(__ATOMIC_RELEASE, "agent"); asm volatile("s_waitcnt vmcnt(0)" ::: "memory");
        __syncthreads();
        if (tid == 0) *flag = xb_add(cnt + (64 + rg) * 16, 1u);
        __syncthreads();
        if (*flag == 31u) {
            __builtin_amdgcn_fence(__ATOMIC_ACQUIRE, "agent"); asm volatile("s_waitcnt vmcnt(0)" ::: "memory");
            const int row = TP + rg * 32 + (tid >> 4);
            const float ssv = __hip_atomic_load(SS + row, __ATOMIC_RELAXED, __HIP_MEMORY_SCOPE_AGENT); const float rs = rsqrtf(ssv * (1.f / 1024.f) + EPS);
#pragma unroll 4
            for (int i = 0; i < 16; ++i) { const int col = ((tid & 15) + 16 * i) * 4; float* yp = Y + (size_t)row * 1024 + col; const f32x4 gg = *(const f32x4*)(g + col); *(f32x4*)yp = *(const f32x4*)yp * rs * gg; }
        }
        __syncthreads();
    }
};

#ifndef PROBE
#define PROBE 0
#endif
template <int PH> DEV void run_phase(const Params& p, char* lds) {
    unsigned char* ws = p.ws;
    if constexpr (PH == 0) { phase0(p, lds); }
    else if constexpr (PH == 1) { EpiIn e{(bf16_t*)(ws + W_Z), (bf16_t*)(ws + W_RB), (bf16_t*)(ws + W_Q), (bf16_t*)(ws + W_K), (bf16_t*)(ws + W_V), p.out};
        EpiInE ee{(bf16_t*)(ws + W_Z), (bf16_t*)(ws + W_RB), (bf16_t*)(ws + W_Q), (bf16_t*)(ws + W_K), (bf16_t*)(ws + W_V), p.out};
        sample_gemm<3>((const bf16_t*)(ws + W_RA), (const bf16_t*)(ws + W_WIN), 3072, 1024, ee, lds);
        gemm_phase((const bf16_t*)(ws + W_RA), (const bf16_t*)(ws + W_WIN), TP, 3072, 1024, e); }
    else if constexpr (PH == 2) {
        for (int u = blockIdx.x; u < 2 + 128 + 544; u += gridDim.x) {
#ifndef P2_MASK
#define P2_MASK 7
#endif
#ifndef P2_REP
#define P2_REP 0
#endif
            if (u < 544) { for (int rep = 0; rep < ((P2_REP & 4) ? 2 : 1); ++rep) ssd_chunk_unit(p, u, lds); }
            else if (u < 672) { for (int rep = 0; rep < ((P2_REP & 2) ? 2 : 1); ++rep) sample_attn_unit(p, (u - 544) >> 3, (u - 544) & 7, lds); }
            else { for (int rep = 0; rep < ((P2_REP & 1) ? 2 : 1); ++rep) cumsum_prompt_unit(p, u - 672, lds); }
        }
        weight_units_on_idle(p, 192, 608, 162, lds); }
    else if constexpr (PH == 3) {
#ifndef NO_SCAN
#if PROBE == 101
        ssd_scan(p, (float*)(ws + W_ACT + (size_t)16 * 1024 * 1024));
#endif
        ssd_scan(p);
#endif
#ifndef ATT_REP
#define ATT_REP 1
#endif
        for (int rep = 0; rep < ATT_REP; ++rep)
        for (int u = blockIdx.x; u < 256; u += gridDim.x) {
            const int x = u & 7, kk = u >> 3, bh = x + 8 * (kk / 16), j = kk % 16;
            att::attn64_unit(bh >> 3, bh & 7, j, att::NQB - 1 - j, (const bf16_t*)(ws + W_Q), (const bf16_t*)(ws + W_K), (const bf16_t*)(ws + W_V), (const float*)(ws + W_G), (bf16_t*)(ws + W_RB) + 512, lds);
            att::attn64_unit(bh >> 3, bh & 7, att::NQB - 1 - j, -1, (const bf16_t*)(ws + W_Q), (const bf16_t*)(ws + W_K), (const bf16_t*)(ws + W_V), (const float*)(ws + W_G), (bf16_t*)(ws + W_RB) + 512, lds); } }
    else if constexpr (PH == 4) { for (int u = blockIdx.x; u < 544; u += gridDim.x) ssd_final_unit(p, u, lds);
        weight_units_on_idle(p, 608, 784, 32, lds); }
    else if constexpr (PH == 5) { EpiOut e{p.x_prompt, p.x_sample, p.out + O_Y, (bf16_t*)(ws + W_RA), (float*)(ws + W_SS2)};
        EpiResE ee{p.x_sample - (size_t)TP * 1024, nullptr, nullptr, (bf16_t*)(ws + W_RA), (float*)(ws + W_SS2)};
        sample_gemm((const bf16_t*)(ws + W_RB), (const bf16_t*)(ws + W_WOUT), 1024, 1024, ee, lds);
        gemm_phase((const bf16_t*)(ws + W_RB), (const bf16_t*)(ws + W_WOUT), TP, 1024, 1024, e); }
    else if constexpr (PH == 6) { EpiUpFused e{(const float*)(ws + W_SS2), p.out, (bf16_t*)(ws + W_ACT), (bf16_t*)(ws + W_HALO), p.ffn_conv_w, p.ffn_conv_b, p.state_ffn_conv, lds};
        gemm_phase((const bf16_t*)(ws + W_RA), (const bf16_t*)(ws + W_WUP), TA, NUP, 1024, e); }
    else if constexpr (PH == 10) {
        EpiDownNorm e{(const bf16_t*)(ws + W_RA), (float*)(ws + W_DT), (unsigned*)(ws + W_CNT), (unsigned*)(ws + W_BAR) + XB_TMO, p.final_norm_g, p.out + O_Y, lds};
        EpiResE ee{nullptr, (const bf16_t*)(ws + W_RA), p.out + O_Y, nullptr, (float*)(ws + W_SS3)};
        sample_gemm((const bf16_t*)(ws + W_ACT), (const bf16_t*)(ws + W_WDN), 1024, DFF, ee, lds);
        gemm_phase((const bf16_t*)(ws + W_ACT), (const bf16_t*)(ws + W_WDN), TP, 1024, DFF, e, FfnFixup{&p}); }
    else if constexpr (PH == 11) { const int lane = threadIdx.x & 63, wid = threadIdx.x >> 6; const float* SS = (const float*)(ws + W_SS3);
        for (int row = TP + blockIdx.x * 8 + wid; row < TA; row += gridDim.x * 8) { const float rs = rsqrtf(SS[row] * (1.f / 1024.f) + EPS); float* yr = p.out + O_Y + (size_t)row * 1024;
#pragma unroll
            for (int i = 0; i < 4; ++i) { const f32x4 g = *(const f32x4*)(p.final_norm_g + i * 256 + lane * 4); f32x4 x = *(f32x4*)(yr + i * 256 + lane * 4); x = x * rs * g; *(f32x4*)(yr + i * 256 + lane * 4) = x; } } }
}
constexpr int NPH = 12;

#ifndef N_LAUNCH_SPLIT
#define N_LAUNCH_SPLIT 0
#endif
#if N_LAUNCH_SPLIT
template <int PH> __global__ void __launch_bounds__(512) ph_kernel(Params p) {
    extern __shared__ __attribute__((aligned(16))) bf16_t shm[];
    run_phase<PH>(p, (char*)shm);
}
template <int PH> static void launch_ph(const Params& p, int grid, hipStream_t stream) {
    (void)hipFuncSetAttribute((const void*)ph_kernel<PH>, hipFuncAttributeMaxDynamicSharedMemorySize, LDS_TOTAL);
    hipLaunchKernelGGL(ph_kernel<PH>, dim3(grid), dim3(512), LDS_TOTAL, stream, p);
}
#else
__global__ void __launch_bounds__(512) hymba_fwd(Params p) {
    extern __shared__ __attribute__((aligned(16))) bf16_t shm[];
    __shared__ uint4 xb_words;
    char* lds = (char*)shm;
    if (threadIdx.x == 0) xb_words = make_uint4(0u, 0u, 0u, 0u);
    __syncthreads();
    const XcdBarrier bar = xcd_barrier_post((unsigned*)(p.ws + W_BAR), (volatile LAS unsigned*)&xb_words);
#ifndef REP_PH
#define REP_PH -1
#endif
#define RUN(PH) do { run_phase<PH>(p, lds); if (REP_PH == PH) { xcd_barrier(bar); run_phase<PH>(p, lds); } } while (0)
    RUN(0); xcd_barrier(bar);
    RUN(1); xcd_barrier(bar);
    RUN(2); xcd_barrier(bar);
    RUN(3); xcd_barrier(bar);
    RUN(4); xcd_barrier(bar);
    RUN(5); xcd_barrier(bar);
    RUN(6); xcd_barrier(bar);
    RUN(10); xcd_barrier(bar);
    RUN(11);
}
#endif

extern "C" void kernel_launch(void* const* d_in, const int* in_sizes, int n_in, void* d_out, int out_size, void* d_ws, size_t ws_size, hipStream_t stream) {
    static int grid_blocks = 0;
    if (!grid_blocks) {
        if (n_in != 24 || (size_t)out_size != O_END || ws_size < W_END) { fprintf(stderr, "kernel_launch: unexpected sizes n_in %d out %d (want %zu) ws %zu (want %zu)\n", n_in, out_size, (size_t)O_END, ws_size, (size_t)W_END); }
        int dev = 0, cus = 0;
        (void)hipGetDevice(&dev);
        (void)hipDeviceGetAttribute(&cus, hipDeviceAttributeMultiprocessorCount, dev);
#if !N_LAUNCH_SPLIT
        int per_cu = 0;
        (void)hipFuncSetAttribute((const void*)hymba_fwd, hipFuncAttributeMaxDynamicSharedMemorySize, LDS_TOTAL);
        (void)hipOccupancyMaxActiveBlocksPerMultiprocessor(&per_cu, (const void*)hymba_fwd, 512, LDS_TOTAL);
        if (per_cu < 1) fprintf(stderr, "kernel_launch: occupancy query returned %d\n", per_cu);
#endif
        grid_blocks = cus > 0 ? cus : 256;
    }
    Params p{};
    const float** pp = (const float**)&p;
    for (int i = 0; i < 24; ++i) pp[i] = (const float*)d_in[i];
    p.out = (float*)d_out; p.ws = (unsigned char*)d_ws;
#if N_LAUNCH_SPLIT
    launch_ph<0>(p, grid_blocks, stream); launch_ph<1>(p, grid_blocks, stream); launch_ph<2>(p, grid_blocks, stream); launch_ph<3>(p, grid_blocks, stream);
    launch_ph<4>(p, grid_blocks, stream); launch_ph<5>(p, grid_blocks, stream); launch_ph<6>(p, grid_blocks, stream);
    launch_ph<10>(p, grid_blocks, stream);
#else
    (void)hipMemsetAsync((char*)d_ws + W_BAR, 0, 32768, stream);
    void* args[] = {&p};
    hipError_t e = hipLaunchCooperativeKernel((void*)hymba_fwd, dim3(grid_blocks), dim3(512), args, LDS_TOTAL, stream);
    if (e != hipSuccess) fprintf(stderr, "cooperative launch failed: %s (grid %d)\n", hipGetErrorString(e), grid_blocks);
#endif
}
```

```cpp
#include <hip/hip_runtime.h>
#include <hip/hip_cooperative_groups.h>
#include <cstdint>
#include <cstdio>
namespace cg = cooperative_groups;

typedef unsigned short bf16_t;
typedef __attribute__((ext_vector_type(8))) short bf16x8;
typedef __attribute__((ext_vector_type(4))) short s16x4;
typedef __attribute__((ext_vector_type(4))) float f32x4;
typedef __attribute__((ext_vector_type(16))) float f32x16;
typedef __attribute__((ext_vector_type(4))) unsigned u32x4;
typedef __attribute__((ext_vector_type(2))) unsigned u32x2;
#define DEV __device__ __forceinline__

constexpr int TP = 16384, TS = 256, TA = TP + TS;
constexpr int DM = 1024, SEQ = 8192, DFF = 2816, NUP = 5632, INC = 3088;
constexpr float EPS = 1e-6f;
constexpr float LOG2E = 1.4426950408889634f;
constexpr float QSCALE = 0.125f * LOG2E;
constexpr int LDS_TOTAL = 135168;

constexpr size_t O_Y = 0;
constexpr size_t O_PK = (size_t)TA * 1024;
constexpr size_t O_PV = O_PK + (size_t)TP * 512;
constexpr size_t O_PLF = O_PV + (size_t)TP * 512;
constexpr size_t O_PSSD = O_PLF + (size_t)TP * 8;
constexpr size_t O_PSC = O_PSSD + 2 * 8 * 64 * 128;
constexpr size_t O_PFC = O_PSC + 2 * 3 * 1024;
constexpr size_t O_SK = O_PFC + 2 * 2 * 5632;
constexpr size_t O_SV = O_SK + (size_t)TS * 512;
constexpr size_t O_SLF = O_SV + (size_t)TS * 512;
constexpr size_t O_SSSD = O_SLF + (size_t)TS * 8;
constexpr size_t O_SSC = O_SSSD + 16 * 8 * 64 * 128;
constexpr size_t O_SFC = O_SSC + 16 * 3 * 1024;
constexpr size_t O_END = O_SFC + 16 * 2 * 5632;

constexpr size_t W_WIN = 0;
constexpr size_t W_WOUT = W_WIN + (size_t)3072 * 1024 * 2;
constexpr size_t W_WUP = W_WOUT + (size_t)1024 * 1024 * 2;
constexpr size_t W_WDN = W_WUP + (size_t)5632 * 1024 * 2;
constexpr size_t W_DT = W_WDN + (size_t)1024 * 2816 * 2;
constexpr size_t W_ACS = W_DT + (size_t)TA * 8 * 4;
constexpr size_t W_DEC = W_ACS + (size_t)TA * 8 * 4;
constexpr size_t W_G = W_DEC + (size_t)272 * 8 * 4;
constexpr size_t W_SS2 = W_G + (size_t)16 * 8192 * 4;
constexpr size_t W_SS3 = W_SS2 + (size_t)TA * 4;
constexpr size_t W_CSS = W_SS3 + (size_t)TA * 4;
constexpr size_t W_BAR = W_CSS + (size_t)16 * 65536 * 4;
constexpr size_t W_CNT = W_BAR + 16384;
constexpr size_t W_SATT = W_BAR + 32768;
constexpr size_t W_RA = (W_SATT + (size_t)256 * 512 * 2 + 255) / 256 * 256;
constexpr size_t SZ_RA = (size_t)TA * 1024 * 2;
constexpr size_t W_RB = W_RA + SZ_RA;
constexpr size_t W_Z = W_RB + SZ_RA;
constexpr size_t SZ_H = (size_t)TA * 512 * 2;
constexpr size_t W_Q = W_Z + SZ_H;
constexpr size_t W_K = W_Q + SZ_H;
constexpr size_t W_V = W_K + SZ_H;
constexpr size_t W_CG = W_V + SZ_H;
constexpr size_t W_U = W_RB;
constexpr size_t W_HALO = W_RB;
constexpr size_t SZ_U = (size_t)TA * 2816 * 2;
constexpr size_t W_ACT = W_V + SZ_H;
constexpr size_t W_END = W_ACT + SZ_U;
static_assert(W_U + SZ_U <= W_ACT, "U overlaps ACT");
static_assert(W_END <= (size_t)256 * 1024 * 1024, "workspace too large");

struct Params {
    const float* x_prompt; const float* x_sample; const float* cache_k; const float* cache_v; const float* cache_logf;
    const float* state_ssd; const float* state_ssd_conv; const float* state_ffn_conv; const float* norm1_g; const float* w_in;
    const float* ssd_conv_w; const float* ssd_conv_b; const float* ssd_dt_bias; const float* ssd_a_log; const float* ssd_d;
    const float* ssd_norm_g; const float* fox_f_bias; const float* w_out; const float* norm2_g; const float* w_up;
    const float* ffn_conv_w; const float* ffn_conv_b; const float* w_down; const float* final_norm_g;
    float* out; unsigned char* ws;
};

DEV unsigned cvtpk(float lo, float hi) { unsigned r; asm("v_cvt_pk_bf16_f32 %0, %1, %2" : "=v"(r) : "v"(lo), "v"(hi)); return r; }
DEV bf16_t f2bf(float f) { return (bf16_t)(cvtpk(f, 0.f) & 0xffffu); }
DEV float bf2f(bf16_t b) { return __uint_as_float(((unsigned)b) << 16); }
DEV float bflo(unsigned u) { return __uint_as_float(u << 16); }
DEV float bfhi(unsigned u) { return __uint_as_float(u & 0xffff0000u); }
DEV float silu_f(float x) { return x * __builtin_amdgcn_rcpf(1.f + __builtin_amdgcn_exp2f(x * -LOG2E)); }
DEV float softplus_f(float x) { return x > 20.f ? x : log1pf(expf(x)); }
DEV float wave_sum(float v) {
#pragma unroll
    for (int o = 32; o > 0; o >>= 1) v += __shfl_xor(v, o);
    return v;
}
DEV float wave_max(float v) {
#pragma unroll
    for (int o = 32; o > 0; o >>= 1) v = fmaxf(v, __shfl_xor(v, o));
    return v;
}
DEV int up_natcol(int r) { const int pn = r >> 8, i = r & 255; return i < 128 ? pn * 128 + i : DFF + pn * 128 + (i - 128); }

constexpr int BM = 256, BK = 64, HALF = 128, HT = HALF * BK;
DEV int lds_byte(int r, int c) { int st = (r >> 4) * 2 + (c >> 5), rr = r & 15, cc = c & 31, ob = rr * 64 + cc * 2; return st * 1024 + (ob ^ (((ob >> 9) & 1) << 5)); }
DEV void stage_rc(int b, int& R, int& C) { int st = b / 1024, sb = b % 1024, swz = sb ^ (((sb >> 9) & 1) << 5); R = (st >> 1) * 16 + swz / 64; C = (st & 1) * 32 + (swz % 64) / 2; }

struct NoPre { DEV void operator()(int, int) const {} };
template <class Epi, class Pre = NoPre>
DEV void gemm_phase(const bf16_t* __restrict__ A, const bf16_t* __restrict__ Bt, const int M, const int N, const int K, const Epi& epi, const Pre& pre = Pre()) {
    extern __shared__ __attribute__((aligned(16))) bf16_t shm[];
#define SA(b, h) (shm + ((b) * 2 + (h)) * HT)
#define SB(b, h) (shm + (4 + (b) * 2 + (h)) * HT)
#define STAGE(P, BASE, br, kt) do { const char* _gb = (const char*)(BASE + (long)(br) * K + (long)(kt) * BK); \
      __builtin_amdgcn_global_load_lds((const unsigned*)(_gb + so0), (unsigned*)((char*)(P) + tid16), 16, 0, 0); \
      __builtin_amdgcn_global_load_lds((const unsigned*)(_gb + so1), (unsigned*)((char*)(P) + tid16 + 8192), 16, 0, 0); } while (0)
#define LDA(dst, b, h) for (int m = 0; m < 4; ++m) for (int k = 0; k < 2; ++k) \
    dst[m][k] = *reinterpret_cast<const bf16x8*>((char*)SA(b, h) + lds_byte(wr * 64 + m * 16 + fr, k * 32 + fq * 8))
#define LDB(dst, b, h) for (int n = 0; n < 2; ++n) for (int k = 0; k < 2; ++k) \
    dst[n][k] = *reinterpret_cast<const bf16x8*>((char*)SB(b, h) + lds_byte(wc * 32 + n * 16 + fr, k * 32 + fq * 8))
#define MMA(ai, bj, At_, Bt_) do { __builtin_amdgcn_s_setprio(1); \
    for (int m = 0; m < 4; ++m) for (int n = 0; n < 2; ++n) for (int k = 0; k < 2; ++k) \
      acc[ai][bj][m][n] = __builtin_amdgcn_mfma_f32_16x16x32_bf16(Bt_[n][k], At_[m][k], acc[ai][bj][m][n], 0, 0, 0); \
    __builtin_amdgcn_s_setprio(0); } while (0)
#define WAIT_V(n) asm volatile("s_waitcnt vmcnt(" #n ")" ::: "memory")
#define WAIT_L(n) asm volatile("s_waitcnt lgkmcnt(" #n ")" ::: "memory")
#define BAR __builtin_amdgcn_s_barrier()
#define SCHED __builtin_amdgcn_sched_barrier(0)
    const int nM = M / BM, nN = N / BM, nwg = nM * nN;
    int tidg = threadIdx.x; asm volatile("" : "+v"(tidg));
    const int wid = tidg >> 6, lane = tidg & 63, wr = wid >> 2, wc = wid & 3, fr = lane & 15, fq = lane >> 4;
    const int nt = K / BK;
    const int tid16 = tidg * 16;
    unsigned so0, so1; { int r_, c_; stage_rc(tid16, r_, c_); so0 = (unsigned)(r_ * K + c_) * 2u; stage_rc(tid16 + 8192, r_, c_); so1 = (unsigned)(r_ * K + c_) * 2u; }
    for (int L = blockIdx.x; L < nwg; L += gridDim.x) {
        int wgid = L;
        { int q = nwg / 8, r = nwg % 8, xcd = wgid % 8, off = wgid / 8; wgid = (xcd < r ? xcd * (q + 1) : r * (q + 1) + (xcd - r) * q) + off; }
        const int nig = 8 * nN, gid = wgid / nig, fm = gid * 8, gsz = min(nM - fm, 8);
        const int pm = fm + ((wgid % nig) % gsz), pn = (wgid % nig) / gsz, brow = pm * BM, bcol = pn * BM;
        pre(pm, pn);
        f32x4 acc[2][2][4][2];
#pragma unroll
        for (int a = 0; a < 2; ++a)
#pragma unroll
            for (int b = 0; b < 2; ++b)
#pragma unroll
                for (int m = 0; m < 4; ++m)
#pragma unroll
                    for (int n = 0; n < 2; ++n) acc[a][b][m][n] = (f32x4){0.f, 0.f, 0.f, 0.f};
        bf16x8 At[4][2], B0[2][2], B1[2][2];
        STAGE(SB(0, 0), Bt, bcol, 0); STAGE(SA(0, 0), A, brow, 0);
        STAGE(SB(0, 1), Bt, bcol + HALF, 0); STAGE(SA(0, 1), A, brow + HALF, 0);
        if (wr == 1) BAR;
        WAIT_V(4); BAR;
        STAGE(SB(1, 0), Bt, bcol, 1); STAGE(SA(1, 0), A, brow, 1); STAGE(SB(1, 1), Bt, bcol + HALF, 1);
        WAIT_V(6); BAR;
        for (int t = 0; t < nt - 2; t += 2) {
            LDB(B0, 0, 0); SCHED; LDA(At, 0, 0); STAGE(SA(1, 1), A, brow + HALF, t + 1);
            WAIT_L(8); BAR; WAIT_L(0); MMA(0, 0, At, B0); BAR; SCHED;
            LDB(B1, 0, 1); STAGE(SB(0, 0), Bt, bcol, t + 2);
            BAR; WAIT_L(0); MMA(0, 1, At, B1); BAR;
            LDA(At, 0, 1); STAGE(SA(0, 0), A, brow, t + 2);
            BAR; WAIT_L(0); MMA(1, 0, At, B0); BAR; SCHED;
            STAGE(SB(0, 1), Bt, bcol + HALF, t + 2);
            WAIT_V(6); BAR; MMA(1, 1, At, B1); BAR;
            LDB(B0, 1, 0); SCHED; LDA(At, 1, 0); STAGE(SA(0, 1), A, brow + HALF, t + 2);
            WAIT_L(8); BAR; WAIT_L(0); MMA(0, 0, At, B0); BAR; SCHED;
            LDB(B1, 1, 1); STAGE(SB(1, 0), Bt, bcol, t + 3);
            BAR; WAIT_L(0); MMA(0, 1, At, B1); BAR;
            LDA(At, 1, 1); STAGE(SA(1, 0), A, brow, t + 3);
            BAR; WAIT_L(0); MMA(1, 0, At, B0); BAR; SCHED;
            STAGE(SB(1, 1), Bt, bcol + HALF, t + 3);
            WAIT_V(6); BAR; MMA(1, 1, At, B1); BAR;
        }
        { LDB(B0, 0, 0); LDA(At, 0, 0); STAGE(SA(1, 1), A, brow + HALF, nt - 1);
          BAR; WAIT_L(0); MMA(0, 0, At, B0); BAR;
          LDB(B1, 0, 1); BAR; WAIT_L(0); MMA(0, 1, At, B1); BAR;
          LDA(At, 0, 1); WAIT_V(4); BAR; WAIT_L(0); MMA(1, 0, At, B0); MMA(1, 1, At, B1); BAR; }
        { LDB(B0, 1, 0); LDA(At, 1, 0); WAIT_V(2); BAR; WAIT_L(0); MMA(0, 0, At, B0); BAR;
          LDB(B1, 1, 1); WAIT_V(0); BAR; WAIT_L(0); MMA(0, 1, At, B1); BAR;
          LDA(At, 1, 1); BAR; WAIT_L(0); MMA(1, 0, At, B0); MMA(1, 1, At, B1); BAR; }
        if (wr == 0) BAR;
        { int t2 = threadIdx.x; asm volatile("" : "+v"(t2)); const int w2 = t2 >> 6, l2 = t2 & 63; epi(acc, pm, pn, w2 >> 2, w2 & 3, l2 & 15, l2 >> 4); }
    }
#undef SA
#undef SB
#undef STAGE
#undef LDA
#undef LDB
#undef MMA
}

#define EPI_LOOP_BEGIN \
    _Pragma("unroll") for (int ai = 0; ai < 2; ++ai) _Pragma("unroll") for (int m = 0; m < 4; ++m) { \
        const int row = pm * BM + ai * HALF + wr * 64 + m * 16 + fr;
#define EPI_COLS_BEGIN \
        _Pragma("unroll") for (int bj = 0; bj < 2; ++bj) _Pragma("unroll") for (int n = 0; n < 2; ++n) { \
            const int col = pn * BM + bj * HALF + wc * 32 + n * 16 + fq * 4; const f32x4 v = acc[ai][bj][m][n];

struct EpiIn {
    bf16_t *Z, *XBC, *Q, *K, *V; float* out;
    DEV void operator()(const f32x4 (&acc)[2][2][4][2], int pm, int pn, int wr, int wc, int fr, int fq) const {
        EPI_LOOP_BEGIN
            const bool smp = row >= TP; const int rs = row - TP;
            EPI_COLS_BEGIN
                if (pn < 2) { *(u32x2*)(Z + (size_t)row * 512 + col) = (u32x2){cvtpk(v[0], v[1]), cvtpk(v[2], v[3])}; }
                else if (pn < 6) { const int c = col - 512; *(u32x2*)(XBC + (size_t)row * 1024 + c) = (u32x2){cvtpk(v[0], v[1]), cvtpk(v[2], v[3])};
                    if (!smp) { const int t = row & 8191; if (t >= 8189) *(f32x4*)(out + O_PSC + (size_t)((row >> 13) * 3 + (t - 8189)) * 1024 + c) = v; }
                    else { const int t = rs & 15; if (t >= 13) *(f32x4*)(out + O_SSC + (size_t)((rs >> 4) * 3 + (t - 13)) * 1024 + c) = v; } }
                else if (pn < 8) { const int c = col - 1536; *(u32x2*)(Q + (size_t)row * 512 + c) = (u32x2){cvtpk(v[0] * QSCALE, v[1] * QSCALE), cvtpk(v[2] * QSCALE, v[3] * QSCALE)}; }
                else if (pn < 10) { const int c = col - 2048; *(u32x2*)(K + (size_t)row * 512 + c) = (u32x2){cvtpk(v[0], v[1]), cvtpk(v[2], v[3])};
                    if (!smp) *(f32x4*)(out + O_PK + (size_t)row * 512 + c) = v; else *(f32x4*)(out + O_SK + (size_t)rs * 512 + c) = v; }
                else { const int c = col - 2560; *(u32x2*)(V + (size_t)row * 512 + c) = (u32x2){cvtpk(v[0], v[1]), cvtpk(v[2], v[3])};
                    if (!smp) *(f32x4*)(out + O_PV + (size_t)row * 512 + c) = v; else *(f32x4*)(out + O_SV + (size_t)rs * 512 + c) = v; }
            }
        }
    }
};

struct EpiOut {
    const float* xp; const float* xs; float* H; bf16_t* Hb; float* SS;
    DEV void operator()(const f32x4 (&acc)[2][2][4][2], int pm, int pn, int wr, int wc, int fr, int fq) const {
        EPI_LOOP_BEGIN
            const float* xr = row < TP ? xp + (size_t)row * 1024 : xs + (size_t)(row - TP) * 1024; float ss = 0.f;
            EPI_COLS_BEGIN
                const f32x4 h = v + *(const f32x4*)(xr + col);
                *(u32x2*)(Hb + (size_t)row * 1024 + col) = (u32x2){cvtpk(h[0], h[1]), cvtpk(h[2], h[3])};
                ss += h[0] * h[0] + h[1] * h[1] + h[2] * h[2] + h[3] * h[3];
            }
            ss += __shfl_xor(ss, 16); ss += __shfl_xor(ss, 32);
            if (fq == 0) atomicAdd(SS + row, ss);
        }
    }
};

struct EpiUp {
    const float* SS; bf16_t* U; float* out; int hf;
    DEV void operator()(const f32x4 (&acc)[2][2][4][2], int pm, int pn, int wr, int wc, int fr, int fq) const {
        EPI_LOOP_BEGIN
            const float rs = rsqrtf(SS[row] * (1.f / 1024.f) + EPS);
            float* st = nullptr;
            if (row < TP) { const int t = row & 8191; if (t >= 8190) st = out + O_PFC + (size_t)((row >> 13) * 2 + (t - 8190)) * NUP; }
            else { const int r2 = row - TP, t = r2 & 15; if (t >= 14) st = out + O_SFC + (size_t)((r2 >> 4) * 2 + (t - 14)) * NUP; }
            EPI_COLS_BEGIN
                const f32x4 u = v * rs;
                *(u32x2*)(U + (size_t)row * DFF + col) = (u32x2){cvtpk(u[0], u[1]), cvtpk(u[2], u[3])};
                if (st) *(f32x4*)(st + up_natcol(hf * DFF + col)) = u;
            }
        }
    }
};

constexpr int TPITCH = 528;
struct EpiUpFused {
    const float* SS; float* out; bf16_t* ACT; bf16_t* HALO; const float* cw; const float* cbias; const float* stf; char* lds;
    DEV void operator()(const f32x4 (&acc)[2][2][4][2], int pm, int pn, int wr, int wc, int fr, int fq) const {
        int tid = threadIdx.x; asm volatile("" : "+v"(tid));
        const int lc = (tid & 31) * 4, run = tid >> 5, ja = pn * 128 + lc; const bool smp = pm == 64;
        float wg[3][4], wv[3][4], bg[4], bv[4];
#pragma unroll
        for (int e = 0; e < 4; ++e) { bg[e] = cbias[ja + e]; bv[e] = cbias[DFF + ja + e];
#pragma unroll
            for (int j = 0; j < 3; ++j) { wg[j][e] = cw[j * NUP + ja + e]; wv[j][e] = cw[j * NUP + DFF + ja + e]; } }
        float ssq[8];
#pragma unroll
        for (int q = 0; q < 8; ++q) ssq[q] = SS[pm * BM + (q >> 2) * HALF + wr * 64 + (q & 3) * 16 + fr];
        EPI_LOOP_BEGIN
            const float rs = rsqrtf(ssq[ai * 4 + m] * (1.f / 1024.f) + EPS);
            float* st = nullptr;
            if (row < TP) { const int t = row & 8191; if (t >= 8190) st = out + O_PFC + (size_t)((row >> 13) * 2 + (t - 8190)) * NUP; }
            else { const int r2 = row - TP, t = r2 & 15; if (t >= 14) st = out + O_SFC + (size_t)((r2 >> 4) * 2 + (t - 14)) * NUP; }
            const int rl = row - pm * BM;
            EPI_COLS_BEGIN
                const f32x4 u = v * rs;
                *(u32x2*)(lds + rl * TPITCH + (col - pn * BM) * 2) = (u32x2){cvtpk(u[0], u[1]), cvtpk(u[2], u[3])};
                if (st) *(f32x4*)(st + up_natcol(col)) = u;
            }
        }
        __syncthreads();
        if (tid < 256) { const int r4 = tid >> 6, c = (tid & 63) * 4, rowl = r4 < 2 ? r4 : 252 + r4;
            *(u32x2*)(HALO + (size_t)(pm * 4 + r4) * NUP + pn * BM + c) = *(const u32x2*)(lds + rowl * TPITCH + c * 2); }
        auto ldrow = [&](int rowl, float* g, float* vv) { const u32x2 a = *(const u32x2*)(lds + rowl * TPITCH + lc * 2), c = *(const u32x2*)(lds + rowl * TPITCH + (128 + lc) * 2);
            g[0] = bflo(a[0]); g[1] = bfhi(a[0]); g[2] = bflo(a[1]); g[3] = bfhi(a[1]); vv[0] = bflo(c[0]); vv[1] = bfhi(c[0]); vv[2] = bflo(c[1]); vv[3] = bfhi(c[1]); };
        float g2[4], g1[4], v2[4], v1[4]; int rstart = 0;
        if (smp) { const float* s0 = stf + (size_t)(run * 2) * NUP, *s1 = s0 + NUP;
#pragma unroll
            for (int e = 0; e < 4; ++e) { g2[e] = s0[ja + e]; v2[e] = s0[DFF + ja + e]; g1[e] = s1[ja + e]; v1[e] = s1[DFF + ja + e]; } }
        else if (run == 0) { ldrow(0, g2, v2); ldrow(1, g1, v1); rstart = 2; }
        else { ldrow(16 * run - 2, g2, v2); ldrow(16 * run - 1, g1, v1); }
#pragma unroll 4
        for (int r = rstart; r < 16; ++r) { const int rowl = 16 * run + r; float g0[4], v0[4]; ldrow(rowl, g0, v0);
            float a[4];
#pragma unroll
            for (int e = 0; e < 4; ++e) { const float cg = bg[e] + wg[0][e] * g2[e] + wg[1][e] * g1[e] + wg[2][e] * g0[e], cv = bv[e] + wv[0][e] * v2[e] + wv[1][e] * v1[e] + wv[2][e] * v0[e];
                a[e] = silu_f(cg) * cv; g2[e] = g1[e]; g1[e] = g0[e]; v2[e] = v1[e]; v1[e] = v0[e]; }
            *(u32x2*)(ACT + (size_t)(pm * BM + rowl) * DFF + ja) = (u32x2){cvtpk(a[0], a[1]), cvtpk(a[2], a[3])}; }
        __syncthreads();
    }
};
struct FfnFixup { const Params* pp;
    DEV void operator()(int pm, int pn) const {
        const Params& p = *pp; unsigned char* ws = p.ws; const bf16_t* HALO = (const bf16_t*)(ws + W_HALO); bf16_t* ACT = (bf16_t*)(ws + W_ACT);
        if (pm >= 64) return;
        int tid = threadIdx.x; asm volatile("" : "+v"(tid));
        for (int it = tid; it < 2 * 352; it += 512) {
            const int cg8 = it % 352, rr = it / 352; const int ja = cg8 * 8, pc = (ja >> 7) * 256 + (ja & 127);
            const bool first = (pm & 31) == 0;
            float g[3][8], v[3][8];
            auto unpack = [&](const bf16_t* rowp, float* go, float* vo) { const u32x4 a = *(const u32x4*)(rowp + pc), c = *(const u32x4*)(rowp + pc + 128);
#pragma unroll
                for (int e = 0; e < 4; ++e) { go[2 * e] = bflo(a[e]); go[2 * e + 1] = bfhi(a[e]); vo[2 * e] = bflo(c[e]); vo[2 * e + 1] = bfhi(c[e]); } };
            auto zero = [&](float* go, float* vo) {
#pragma unroll
                for (int e = 0; e < 8; ++e) { go[e] = 0.f; vo[e] = 0.f; } };
            const bf16_t* mine = HALO + (size_t)(pm * 4) * NUP; const bf16_t* prev = HALO + (size_t)((pm - 1) * 4) * NUP;
            unpack(mine + (size_t)rr * NUP, g[2], v[2]);
            if (rr == 1) { unpack(mine, g[1], v[1]); if (first) zero(g[0], v[0]); else unpack(prev + (size_t)3 * NUP, g[0], v[0]); }
            else { if (first) { zero(g[1], v[1]); zero(g[0], v[0]); } else { unpack(prev + (size_t)3 * NUP, g[1], v[1]); unpack(prev + (size_t)2 * NUP, g[0], v[0]); } }
            u32x4 o;
#pragma unroll
            for (int e = 0; e < 4; ++e) { float a[2];
#pragma unroll
                for (int q = 0; q < 2; ++q) { const int i = 2 * e + q; float cg = p.ffn_conv_b[ja + i], cv = p.ffn_conv_b[DFF + ja + i];
#pragma unroll
                    for (int j = 0; j < 3; ++j) { cg += p.ffn_conv_w[j * NUP + ja + i] * g[j][i]; cv += p.ffn_conv_w[j * NUP + DFF + ja + i] * v[j][i]; }
                    a[q] = silu_f(cg) * cv; }
                o[e] = cvtpk(a[0], a[1]); }
            *(u32x4*)(ACT + (size_t)(pm * BM + rr) * DFF + ja) = o;
        }
        asm volatile("s_waitcnt vmcnt(0)" ::: "memory");
        __syncthreads();
    }
};

struct EpiDown {
    const bf16_t* Hb; float* SS; float* Ho;
    DEV void operator()(const f32x4 (&acc)[2][2][4][2], int pm, int pn, int wr, int wc, int fr, int fq) const {
        EPI_LOOP_BEGIN
            float ss = 0.f;
            EPI_COLS_BEGIN
                const size_t hoff = (size_t)row * 1024 + col;
                const u32x2 hb = *(const u32x2*)(Hb + hoff); const f32x4 h = v + (f32x4){bflo(hb[0]), bfhi(hb[0]), bflo(hb[1]), bfhi(hb[1])};
                *(f32x4*)(Ho + hoff) = h;
                ss += h[0] * h[0] + h[1] * h[1] + h[2] * h[2] + h[3] * h[3];
            }
            ss += __shfl_xor(ss, 16); ss += __shfl_xor(ss, 32);
            if (fq == 0) atomicAdd(SS + row, ss);
        }
    }
};

struct NoPost { DEV void operator()(int) const {} };
template <int NT = 1, class EpiE, class Post = NoPost>
DEV void sample_gemm(const bf16_t* __restrict__ A, const bf16_t* __restrict__ Bt, const int N, const int K, const EpiE& epi, char* lds, const Post& post = Post()) {
    int tid = threadIdx.x; asm volatile("" : "+v"(tid));
    const int lane = tid & 63, wid = tid >> 6, fr = lane & 15, fq = lane >> 4;
    constexpr int TW = 32 * NT;
    float* red = (float*)lds;
    const int ntile = 8 * (N / TW), kw = K / 8;
    for (int mt = blockIdx.x; mt < ntile; mt += gridDim.x) {
        const int r0 = (mt & 7) * 32, c0 = (mt >> 3) * TW;
        f32x4 acc[2][2 * NT];
#pragma unroll
        for (int i = 0; i < 2; ++i)
#pragma unroll
            for (int j = 0; j < 2 * NT; ++j) acc[i][j] = (f32x4){0.f, 0.f, 0.f, 0.f};
        const bf16_t* Ap = A + (size_t)(TP + r0 + fr) * K + wid * kw + fq * 8;
        const bf16_t* Bp = Bt + (size_t)(c0 + fr) * K + wid * kw + fq * 8;
#pragma unroll
        for (int ks = 0; ks < kw; ks += 32) {
            const bf16x8 a0 = *(const bf16x8*)(Ap + ks), a1 = *(const bf16x8*)(Ap + (size_t)16 * K + ks);
#pragma unroll
            for (int j = 0; j < 2 * NT; ++j) { const bf16x8 bj = *(const bf16x8*)(Bp + (size_t)(16 * j) * K + ks);
                acc[0][j] = __builtin_amdgcn_mfma_f32_16x16x32_bf16(bj, a0, acc[0][j], 0, 0, 0); acc[1][j] = __builtin_amdgcn_mfma_f32_16x16x32_bf16(bj, a1, acc[1][j], 0, 0, 0); }
        }
#pragma unroll
        for (int i = 0; i < 2; ++i)
#pragma unroll
            for (int j = 0; j < 2 * NT; ++j) *(f32x4*)(red + wid * (32 * TW) + (16 * i + fr) * TW + 16 * j + 4 * fq) = acc[i][j];
        __syncthreads();
#pragma unroll
        for (int q = 0; q < NT; ++q) { const int idx = tid + 512 * q, row = idx / (TW / 2), col = (idx % (TW / 2)) * 2; float v0 = 0.f, v1 = 0.f;
#pragma unroll
            for (int w = 0; w < 8; ++w) { const float2 t = *(const float2*)(red + w * (32 * TW) + row * TW + col); v0 += t.x; v1 += t.y; }
            epi(TP + r0 + row, c0 + col, v0, v1, lane); }
        __syncthreads();
        post(mt);
    }
}
struct EpiInE { bf16_t *Z, *XBC, *Q, *K, *V; float* out;
    DEV void operator()(int row, int col, float v0, float v1, int lane) const { const int rs = row - TP;
        if (col < 512) *(unsigned*)(Z + (size_t)row * 512 + col) = cvtpk(v0, v1);
        else if (col < 1536) { const int c = col - 512; *(unsigned*)(XBC + (size_t)row * 1024 + c) = cvtpk(v0, v1); const int t = rs & 15;
            if (t >= 13) *(float2*)(out + O_SSC + (size_t)((rs >> 4) * 3 + (t - 13)) * 1024 + c) = make_float2(v0, v1); }
        else if (col < 2048) *(unsigned*)(Q + (size_t)row * 512 + col - 1536) = cvtpk(v0 * QSCALE, v1 * QSCALE);
        else if (col < 2560) { const int c = col - 2048; *(unsigned*)(K + (size_t)row * 512 + c) = cvtpk(v0, v1); *(float2*)(out + O_SK + (size_t)rs * 512 + c) = make_float2(v0, v1); }
        else { const int c = col - 2560; *(unsigned*)(V + (size_t)row * 512 + c) = cvtpk(v0, v1); *(float2*)(out + O_SV + (size_t)rs * 512 + c) = make_float2(v0, v1); } } };
struct EpiResE { const float* res; const bf16_t* resb; float* H; bf16_t* Hb; float* SS;
    DEV void operator()(int row, int col, float v0, float v1, int lane) const {
        float h0, h1; if (res) { const float2 r = *(const float2*)(res + (size_t)row * 1024 + col); h0 = r.x + v0; h1 = r.y + v1; } else { const unsigned r = *(const unsigned*)(resb + (size_t)row * 1024 + col); h0 = bflo(r) + v0; h1 = bfhi(r) + v1; }
        if (H) *(float2*)(H + (size_t)row * 1024 + col) = make_float2(h0, h1);
        if (Hb) *(unsigned*)(Hb + (size_t)row * 1024 + col) = cvtpk(h0, h1);
        float ss = h0 * h0 + h1 * h1; ss += __shfl_xor(ss, 1); ss += __shfl_xor(ss, 2); ss += __shfl_xor(ss, 4); ss += __shfl_xor(ss, 8);
        if ((lane & 15) == 0) atomicAdd(SS + row, ss); } };

DEV float reduce16(float (&a)[16], int lane) {
    { const bool hi = lane & 32;
#pragma unroll
      for (int i = 0; i < 8; ++i) { const float send = hi ? a[i] : a[i + 8]; const float keep = hi ? a[i + 8] : a[i]; a[i] = keep + __shfl_xor(send, 32); } }
    { const bool hi = lane & 16;
#pragma unroll
      for (int i = 0; i < 4; ++i) { const float send = hi ? a[i] : a[i + 4]; const float keep = hi ? a[i + 4] : a[i]; a[i] = keep + __shfl_xor(send, 16); } }
    { const bool hi = lane & 8;
#pragma unroll
      for (int i = 0; i < 2; ++i) { const float send = hi ? a[i] : a[i + 2]; const float keep = hi ? a[i + 2] : a[i]; a[i] = keep + __shfl_xor(send, 8); } }
    { const bool hi = lane & 4; const float send = hi ? a[0] : a[1]; const float keep = hi ? a[1] : a[0]; a[0] = keep + __shfl_xor(send, 4); }
    a[0] += __shfl_xor(a[0], 2); a[0] += __shfl_xor(a[0], 1);
    return a[0];
}

template <class CS>
DEV void transpose4(const float* __restrict__ W, int ldw, int k0, const CS& cs, bf16_t* __restrict__ WT, int ldt, int r0, const float* __restrict__ gk, float* tile) {
    int tid = threadIdx.x; asm volatile("" : "+v"(tid));
    float v[4][8];
#pragma unroll
    for (int s = 0; s < 4; ++s) { const int c0 = cs(s);
#pragma unroll
        for (int e = 0; e < 8; ++e) { const int idx = tid + e * 512, j = idx >> 6, i = idx & 63; v[s][e] = W[(size_t)(k0 + j) * ldw + c0 + i]; } }
#pragma unroll
    for (int e = 0; e < 8; ++e) { const int idx = tid + e * 512, j = idx >> 6, i = idx & 63; const float g = gk ? gk[k0 + j] : 1.f;
#pragma unroll
        for (int s = 0; s < 4; ++s) tile[s * 4160 + j * 65 + i] = v[s][e] * g; }
    __syncthreads();
#pragma unroll
    for (int s = 0; s < 4; ++s)
#pragma unroll
        for (int e = 0; e < 4; ++e) { const int idx = tid + e * 512, i = idx >> 5, j2 = (idx & 31) * 2;
            *(unsigned*)(WT + (size_t)(r0 + 64 * s + i) * ldt + k0 + j2) = cvtpk(tile[s * 4160 + j2 * 65 + i], tile[s * 4160 + (j2 + 1) * 65 + i]); }
    __syncthreads();
}

DEV void weight_unit(const Params& p, int u, float* tile) {
    unsigned char* ws = p.ws;
    if (u < 192) { const int kt = u & 15, nb = u >> 4; const int r0 = nb * 256; const int c0 = r0 < 1536 ? r0 : r0 + 8;
        transpose4(p.w_in, INC, kt * 64, [&](int s) { return c0 + 64 * s; }, (bf16_t*)(ws + W_WIN), 1024, r0, nullptr, tile); }
    else if (u < 256) { const int v = u - 192, kt = v & 15, nb = v >> 4;
        transpose4(p.w_out, 1024, kt * 64, [&](int s) { return nb * 256 + 64 * s; }, (bf16_t*)(ws + W_WOUT), 1024, nb * 256, nullptr, tile); }
    else if (u < 608) { const int v = u - 256, kt = v & 15, nb = v >> 4;
        transpose4(p.w_up, NUP, kt * 64, [&](int s) { return up_natcol(nb * 256 + 64 * s); }, (bf16_t*)(ws + W_WUP), 1024, nb * 256, p.norm2_g, tile); }
    else { const int v = u - 608, kt = v % 44, nb = v / 44;
        transpose4(p.w_down, 1024, kt * 64, [&](int s) { return nb * 256 + 64 * s; }, (bf16_t*)(ws + W_WDN), DFF, nb * 256, nullptr, tile); }
}
DEV void weight_units_on_idle(const Params& p, int u0, int u1, int lo_want, char* lds) {
    const int lo = (int)gridDim.x > lo_want + 32 ? lo_want : 0;
    if ((int)blockIdx.x >= lo) for (int u = u0 + (int)blockIdx.x - lo; u < u1; u += (int)gridDim.x - lo) weight_unit(p, u, (float*)lds);
}

DEV void phase0(const Params& p, char* lds) {
    unsigned char* ws = p.ws;
    const int tid = threadIdx.x, lane = tid & 63, wid = tid >> 6;
    float* tile = (float*)lds;
    float* thin = (float*)(lds + 32768);
    for (int u = blockIdx.x; u < 192; u += gridDim.x) weight_unit(p, u, tile);
    for (int idx = tid; idx < 4096; idx += 512) { const int k = idx >> 2, part = idx & 3; const f32x4 v = *(const f32x4*)(p.w_in + (size_t)k * INC + (part < 2 ? 1536 + 4 * part : 3080 + 4 * (part - 2)));
        thin[(4 * part) * 1024 + k] = v[0]; thin[(4 * part + 1) * 1024 + k] = v[1]; thin[(4 * part + 2) * 1024 + k] = v[2]; thin[(4 * part + 3) * 1024 + k] = v[3]; }
    for (int i = blockIdx.x * 512 + tid; i < 2 * TA; i += gridDim.x * 512) ((float*)(ws + W_SS2))[i] = 0.f;
    __syncthreads();
    bf16_t* XN = (bf16_t*)(ws + W_RA); float* DT = (float*)(ws + W_DT);
    const int rstep = gridDim.x * 8;
    f32x4 gq[4];
#pragma unroll
    for (int i = 0; i < 4; ++i) gq[i] = *(const f32x4*)(p.norm1_g + i * 256 + lane * 4);
    for (int row0 = blockIdx.x * 8 + wid; row0 < TA; row0 += 2 * rstep) {
        const bool two = row0 + rstep < TA;
        f32x4 x[2][4]; float ss[2] = {0.f, 0.f};
#pragma unroll
        for (int rr = 0; rr < 2; ++rr) { const int row = (rr == 0 || two) ? row0 + rr * rstep : row0;
            const float* xr = row < TP ? p.x_prompt + (size_t)row * 1024 : p.x_sample + (size_t)(row - TP) * 1024;
#pragma unroll
            for (int i = 0; i < 4; ++i) { x[rr][i] = *(const f32x4*)(xr + i * 256 + lane * 4); ss[rr] += x[rr][i][0] * x[rr][i][0] + x[rr][i][1] * x[rr][i][1] + x[rr][i][2] * x[rr][i][2] + x[rr][i][3] * x[rr][i][3]; } }
#pragma unroll
        for (int rr = 0; rr < 2; ++rr) { const int row = row0 + rr * rstep; ss[rr] = wave_sum(ss[rr]); const float rs = rsqrtf(ss[rr] * (1.f / 1024.f) + EPS);
#pragma unroll
            for (int i = 0; i < 4; ++i) { x[rr][i] = x[rr][i] * rs * gq[i];
                if (rr == 0 || two) *(u32x2*)(XN + (size_t)row * 1024 + i * 256 + lane * 4) = (u32x2){cvtpk(x[rr][i][0], x[rr][i][1]), cvtpk(x[rr][i][2], x[rr][i][3])}; } }
        float pa0[16], pa1[16];
#pragma unroll
        for (int j = 0; j < 16; ++j) { float a0 = 0.f, a1 = 0.f;
#pragma unroll
            for (int i = 0; i < 4; ++i) { const f32x4 w = *(const f32x4*)(thin + j * 1024 + i * 256 + lane * 4);
                a0 += x[0][i][0] * w[0] + x[0][i][1] * w[1] + x[0][i][2] * w[2] + x[0][i][3] * w[3]; a1 += x[1][i][0] * w[0] + x[1][i][1] * w[1] + x[1][i][2] * w[2] + x[1][i][3] * w[3]; }
            pa0[j] = a0; pa1[j] = a1; }
        const int jj = (lane >> 2) & 15;
        const float m0 = reduce16(pa0, lane), m1 = reduce16(pa1, lane);
#pragma unroll
        for (int rr = 0; rr < 2; ++rr) { const int row = row0 + rr * rstep; const float mine = rr ? m1 : m0;
            if ((rr == 0 || two) && (lane & 3) == 0) {
                if (jj < 8) { DT[(size_t)row * 8 + jj] = softplus_f(mine + p.ssd_dt_bias[jj]); }
                else { const int h = jj - 8; const float lf = -softplus_f(-(mine + p.fox_f_bias[h]));
                    if (row < TP) p.out[O_PLF + (size_t)row * 8 + h] = lf; else p.out[O_SLF + (size_t)(row - TP) * 8 + h] = lf; } } }
    }
}

DEV void cumsum_prompt_unit(const Params& p, int b, char* lds) {
    int tid = threadIdx.x; asm volatile("" : "+v"(tid)); const int lane = tid & 63, wid = tid >> 6;
    constexpr int PITCH = 2308;
    float* buf = (float*)lds;
    const float* lf = p.out + O_PLF + (size_t)b * SEQ * 8;
    float* G = (float*)(p.ws + W_G) + ((size_t)b * 8 + wid) * SEQ;
    float carry = 0.f;
    for (int q = 0; q < 4; ++q) { const int t0 = q * 2048;
#pragma unroll
        for (int i = 0; i < 8; ++i) { const int idx = tid + 512 * i, t = idx >> 1, hh = (idx & 1) * 4; const f32x4 v = *(const f32x4*)(lf + (size_t)(t0 + t) * 8 + hh);
            const int o = t + 4 * (t >> 5);
            buf[hh * PITCH + o] = v[0]; buf[(hh + 1) * PITCH + o] = v[1]; buf[(hh + 2) * PITCH + o] = v[2]; buf[(hh + 3) * PITCH + o] = v[3]; }
        __syncthreads();
        float* seg = buf + wid * PITCH + 36 * lane; f32x4 v[8]; float run = 0.f;
#pragma unroll
        for (int j = 0; j < 8; ++j) { v[j] = *(const f32x4*)(seg + 4 * j); v[j][0] += run; v[j][1] += v[j][0]; v[j][2] += v[j][1]; v[j][3] += v[j][2]; run = v[j][3]; }
        float sc = run;
#pragma unroll
        for (int o = 1; o < 64; o <<= 1) { const float t = __shfl_up(sc, o); if (lane >= o) sc += t; }
        const float pre = carry + sc - run;
#pragma unroll
        for (int j = 0; j < 8; ++j) { v[j] = (v[j] + pre) * (-LOG2E); *(f32x4*)(seg + 4 * j) = v[j]; }
        carry += __shfl(sc, 63);
        __syncthreads();
#pragma unroll
        for (int j = 0; j < 8; ++j) { const int t = 4 * (lane + 64 * j); *(f32x4*)(G + t0 + t) = *(const f32x4*)(buf + wid * PITCH + t + 4 * (t >> 5)); }
        __syncthreads();
    }
}

DEV void sample_attn_unit(const Params& p, int b, int h, char* lds) {
    int tid = threadIdx.x; asm volatile("" : "+v"(tid)); const int lane = tid & 63, wid = tid >> 6, fr = lane & 15, fq = lane >> 4;
    float* bl = (float*)lds;
    float* red = (float*)(lds + 8448);
    float* red2 = (float*)(lds + 8960);
    float* stat = (float*)(lds + 9472);
    float* ored = (float*)(lds + 16384);
    const bf16_t* Q = (const bf16_t*)(p.ws + W_Q);
    const float* clf = p.cache_logf + (size_t)b * 2048 * 8 + h;
    { float v4[4]; float run = 0.f;
#pragma unroll
      for (int i = 0; i < 4; ++i) { run += clf[(size_t)(tid * 4 + i) * 8]; v4[i] = run; }
      float v = run;
#pragma unroll
      for (int o = 1; o < 64; o <<= 1) { const float t = __shfl_up(v, o); if (lane >= o) v += t; }
      if (lane == 63) red[wid] = v;
      __syncthreads();
      float add = v - run; for (int w = 0; w < wid; ++w) add += red[w];
#pragma unroll
      for (int i = 0; i < 4; ++i) bl[tid * 4 + i] = -(add + v4[i]) * LOG2E;
      if (tid == 511) { float f = add + run; for (int i = 0; i < 16; ++i) { f += p.out[O_SLF + (size_t)(b * 16 + i) * 8 + h]; bl[2048 + i] = -f * LOG2E; } }
      __syncthreads(); }
    bf16x8 qf[2];
#pragma unroll
    for (int k = 0; k < 2; ++k) qf[k] = *(const bf16x8*)(Q + (size_t)(TP + b * 16 + fr) * 512 + h * 64 + k * 32 + fq * 8);
    f32x4 sc[17];
#pragma unroll
    for (int i = 0; i < 17; ++i) { const int kt = wid + 8 * i; f32x4 c = (f32x4){-INFINITY, -INFINITY, -INFINITY, -INFINITY};
        if (kt < 129) {
            const float* kr = kt < 128 ? p.cache_k + ((size_t)(b * 2048 + kt * 16 + fr) * 8 + h) * 64 : p.out + O_SK + ((size_t)(b * 16 + fr) * 8 + h) * 64;
            c = *(const f32x4*)(bl + kt * 16 + fq * 4);
#pragma unroll
            for (int k = 0; k < 2; ++k) { const f32x4 a0 = *(const f32x4*)(kr + k * 32 + fq * 8), a1 = *(const f32x4*)(kr + k * 32 + fq * 8 + 4);
                const u32x4 av = (u32x4){cvtpk(a0[0], a0[1]), cvtpk(a0[2], a0[3]), cvtpk(a1[0], a1[1]), cvtpk(a1[2], a1[3])};
                c = __builtin_amdgcn_mfma_f32_16x16x32_bf16(__builtin_bit_cast(bf16x8, av), qf[k], c, 0, 0, 0); }
            if (kt == 128) {
#pragma unroll
                for (int j = 0; j < 4; ++j) if (fq * 4 + j > fr) c[j] = -INFINITY; }
        }
        sc[i] = c; }
    float m = -INFINITY;
#pragma unroll
    for (int i = 0; i < 17; ++i) m = fmaxf(m, fmaxf(fmaxf(sc[i][0], sc[i][1]), fmaxf(sc[i][2], sc[i][3])));
    m = fmaxf(m, __shfl_xor(m, 16)); m = fmaxf(m, __shfl_xor(m, 32));
    if (fq == 0) red[wid * 16 + fr] = m;
    __syncthreads();
    m = red[fr];
#pragma unroll
    for (int w = 1; w < 8; ++w) m = fmaxf(m, red[w * 16 + fr]);
    float l = 0.f;
#pragma unroll
    for (int i = 0; i < 17; ++i) {
#pragma unroll
        for (int j = 0; j < 4; ++j) { sc[i][j] = exp2f(sc[i][j] - m); l += sc[i][j]; } }
    l += __shfl_xor(l, 16); l += __shfl_xor(l, 32);
    if (fq == 0) red2[wid * 16 + fr] = l;
    __syncthreads();
    if (tid < 16) { float a = 0.f; for (int w = 0; w < 8; ++w) a += red2[w * 16 + tid]; stat[tid] = a; }
    f32x4 oT[4];
#pragma unroll
    for (int dt = 0; dt < 4; ++dt) oT[dt] = (f32x4){0.f, 0.f, 0.f, 0.f};
#pragma unroll
    for (int ii = 0; ii < 9; ++ii) { const int ktA = wid + 16 * ii, ktB = ktA + 8;
        if (ktA < 129) {
            const f32x4 sA = sc[2 * ii]; f32x4 sB = (f32x4){0.f, 0.f, 0.f, 0.f}; if (2 * ii + 1 < 17) sB = sc[(2 * ii + 1 < 17) ? 2 * ii + 1 : 0];
            const bool vB = ktB < 129;
            const u32x4 bv = (u32x4){cvtpk(sA[0], sA[1]), cvtpk(sA[2], sA[3]), vB ? cvtpk(sB[0], sB[1]) : 0u, vB ? cvtpk(sB[2], sB[3]) : 0u};
            const int keyA = ktA * 16 + fq * 4, keyB = ktB * 16 + fq * 4;
            const float* vA = keyA < 2048 ? p.cache_v + ((size_t)(b * 2048 + keyA) * 8 + h) * 64 : p.out + O_SV + ((size_t)(b * 16 + keyA - 2048) * 8 + h) * 64;
            const float* vBp = keyB < 2048 ? p.cache_v + ((size_t)(b * 2048 + keyB) * 8 + h) * 64 : p.out + O_SV + ((size_t)(b * 16 + (keyB - 2048)) * 8 + h) * 64;
#pragma unroll
            for (int dt = 0; dt < 4; ++dt) { float va[8];
#pragma unroll
                for (int e = 0; e < 4; ++e) { va[e] = vA[(size_t)e * 512 + dt * 16 + fr]; va[4 + e] = vB ? vBp[(size_t)e * 512 + dt * 16 + fr] : 0.f; }
                const u32x4 av = (u32x4){cvtpk(va[0], va[1]), cvtpk(va[2], va[3]), cvtpk(va[4], va[5]), cvtpk(va[6], va[7])};
                oT[dt] = __builtin_amdgcn_mfma_f32_16x16x32_bf16(__builtin_bit_cast(bf16x8, av), __builtin_bit_cast(bf16x8, bv), oT[dt], 0, 0, 0); }
        } }
#pragma unroll
    for (int dt = 0; dt < 4; ++dt) *(f32x4*)(ored + (wid * 16 + fr) * 64 + dt * 16 + fq * 4) = oT[dt];
    __syncthreads();
    bf16_t* SATT = (bf16_t*)(p.ws + W_SATT);
    for (int idx = tid; idx < 1024; idx += 512) { const int qi = idx >> 6, d = idx & 63; float a = 0.f;
#pragma unroll
        for (int w = 0; w < 8; ++w) a += ored[(w * 16 + qi) * 64 + d];
        SATT[(size_t)(b * 16 + qi) * 512 + h * 64 + d] = f2bf(a / stat[qi]); }
    __syncthreads();
}

struct SsdSrc { bool smp; int b, c, g; };
DEV SsdSrc ssd_decode(int u) { SsdSrc s; if (u < 512) { s.smp = false; s.b = u >> 8; s.c = (u >> 1) & 127; s.g = u & 1; } else { const int v = u - 512; s.smp = true; s.b = v >> 1; s.c = 0; s.g = v & 1; } return s; }
DEV int ssd_token(const SsdSrc& s, int l) { if (!s.smp) return s.b * SEQ + s.c * 64 + l; return l >= 48 ? TP + s.b * 16 + (l - 48) : -1; }
typedef __attribute__((address_space(3))) char* ldsp_t;

constexpr int L_ACS = 0, L_DT = 1024, L_RDT = 2048, L_TE = 3072, L_BM = 4096, L_CM = L_BM + 17408, L_BT = L_CM + 17408, L_XT = L_BT + 18432, L_XTE = L_XT + 36864;
static_assert(L_XTE + 36864 <= LDS_TOTAL, "ssd lds");

DEV void ssd_chunk_unit(const Params& p, int u, char* lds) {
    const SsdSrc s = ssd_decode(u);
    int tid = threadIdx.x; asm volatile("" : "+v"(tid)); const int lane = tid & 63, wid = tid >> 6, fr = lane & 15, fq = lane >> 4;
    unsigned char* ws = p.ws;
    const bf16_t* XBC = (const bf16_t*)(ws + W_RB); const float* DT = (const float*)(ws + W_DT);
    float* acs_l = (float*)(lds + L_ACS); float* dt_l = (float*)(lds + L_DT); float* rdt_l = (float*)(lds + L_RDT); float* te_l = (float*)(lds + L_TE);
    bf16_t* Bm = (bf16_t*)(lds + L_BM); bf16_t* Cm = (bf16_t*)(lds + L_CM); bf16_t* BTl = (bf16_t*)(lds + L_BT); bf16_t* XT = (bf16_t*)(lds + L_XT); bf16_t* XTE = (bf16_t*)(lds + L_XTE);
    const int uidx = s.smp ? 256 + s.b : s.b * 128 + s.c;
    int col, role, li; if (tid < 256) { role = 0; li = tid; col = s.g * 256 + tid; } else if (tid < 384) { role = 1; li = tid - 256; col = 512 + s.g * 128 + li; } else { role = 2; li = tid - 384; col = 768 + s.g * 128 + li; }
    const bf16_t* xcol = XBC + (size_t)(s.smp ? TP + s.b * 16 - 48 : s.b * SEQ + s.c * 64) * 1024 + col;
    const float* scol = p.state_ssd_conv + (size_t)(s.b * 3) * 1024 + col;
    auto ldb = [&](int lb, float* o) {
        if (!s.smp) {
#pragma unroll
            for (int i = 0; i < 16; ++i) o[i] = bf2f(xcol[(size_t)(lb + i) * 1024]); }
        else {
#pragma unroll
            for (int i = 0; i < 16; ++i) { const int l = lb + i; o[i] = l >= 48 ? bf2f(xcol[(size_t)l * 1024]) : (l >= 45 ? scol[(size_t)(l - 45) * 1024] : 0.f); } } };
    float x3, x2, x1;
    if (!s.smp) { const bool has = s.c > 0; const bf16_t* xh = has ? xcol : xcol + 3 * 1024;
        const float a = bf2f(xh[-3 * 1024]), bb = bf2f(xh[-2 * 1024]), cc = bf2f(xh[-1 * 1024]); x3 = has ? a : 0.f; x2 = has ? bb : 0.f; x1 = has ? cc : 0.f; }
    else { x3 = 0.f; x2 = 0.f; x1 = 0.f; }
    float xv[16]; ldb(0, xv);
    const float w0 = p.ssd_conv_w[col], w1 = p.ssd_conv_w[1024 + col], w2 = p.ssd_conv_w[2048 + col], w3 = p.ssd_conv_w[3072 + col], cb = p.ssd_conv_b[col];
    if (wid < 4) { const int h = s.g * 4 + wid; const int tok = ssd_token(s, lane);
        const float dt = tok >= 0 ? DT[(size_t)tok * 8 + h] : 0.f; const float a = -expf(p.ssd_a_log[h]);
        float v = dt * a;
#pragma unroll
        for (int o = 1; o < 64; o <<= 1) { const float t = __shfl_up(v, o); if (lane >= o) v += t; }
        const float tot = __shfl(v, 63);
        acs_l[wid * 64 + lane] = v; dt_l[wid * 64 + lane] = dt; rdt_l[wid * 64 + lane] = dt > 0.f ? 1.f / dt : 0.f; te_l[wid * 64 + lane] = expf(tot - v);
        if (tok >= 0) ((float*)(ws + W_ACS))[(size_t)tok * 8 + h] = v;
        if (lane == 63) ((float*)(ws + W_DEC))[uidx * 8 + h] = expf(tot); }
    __syncthreads();
    { const int hl = li >> 6, pp = li & 63;
      bf16_t* CG = (bf16_t*)(ws + W_CG);
#pragma unroll
      for (int lb = 0; lb < 64; lb += 16) { float xn[16];
        if (lb + 16 < 64) ldb(lb + 16, xn);
        float vv[16];
#pragma unroll
        for (int i = 0; i < 16; ++i) { const float x0 = xv[i]; const float y = cb + w0 * x3 + w1 * x2 + w2 * x1 + w3 * x0; x3 = x2; x2 = x1; x1 = x0; vv[i] = silu_f(y); }
        if (role == 0) {
#pragma unroll
            for (int i8 = 0; i8 < 16; i8 += 8) { u32x4 a, b;
#pragma unroll
                for (int q = 0; q < 4; ++q) { const int i = i8 + 2 * q, l = lb + i; const float xd0 = vv[i] * dt_l[hl * 64 + l], xd1 = vv[i + 1] * dt_l[hl * 64 + l + 1];
                    a[q] = cvtpk(xd0, xd1); b[q] = cvtpk(xd0 * te_l[hl * 64 + l], xd1 * te_l[hl * 64 + l + 1]); }
                *(u32x4*)(XT + (hl * 64 + pp) * 72 + lb + i8) = a; *(u32x4*)(XTE + (hl * 64 + pp) * 72 + lb + i8) = b; } }
        else if (role == 1) {
#pragma unroll
            for (int i8 = 0; i8 < 16; i8 += 8) { u32x4 a;
#pragma unroll
                for (int q = 0; q < 4; ++q) { const int i = i8 + 2 * q, l = lb + i; const unsigned pk = cvtpk(vv[i], vv[i + 1]); a[q] = pk;
                    Bm[l * 136 + li] = (bf16_t)(pk & 0xffffu); Bm[(l + 1) * 136 + li] = (bf16_t)(pk >> 16); }
                *(u32x4*)(BTl + li * 72 + lb + i8) = a; } }
        else {
#pragma unroll
            for (int i = 0; i < 16; ++i) { const int l = lb + i; const bf16_t bv = f2bf(vv[i]); Cm[l * 136 + li] = bv; const int tok = ssd_token(s, l); if (tok >= 0) CG[(size_t)tok * 256 + s.g * 128 + li] = bv; } }
        if (lb + 16 < 64) {
#pragma unroll
            for (int i = 0; i < 16; ++i) xv[i] = xn[i]; } } }
    __syncthreads();
    const int hl = wid >> 1, half = wid & 1, h = s.g * 4 + hl; const float dsk = p.ssd_d[h];
    bf16_t* YD = (bf16_t*)(ws + W_RA);
    const bf16_t* XTh = XT + hl * 64 * 72; const bf16_t* XTEh = XTE + hl * 64 * 72;
#pragma unroll
    for (int lti = 0; lti < 2; ++lti) { const int lt = half * 2 + lti; const int l = lt * 16 + fr; const float acl = acs_l[hl * 64 + l];
        u32x2 pk[4];
#pragma unroll
        for (int st = 0; st < 4; ++st) { pk[st] = (u32x2){0u, 0u};
            if (st <= lt) { f32x4 c = (f32x4){0.f, 0.f, 0.f, 0.f};
#pragma unroll
                for (int k = 0; k < 4; ++k) { const bf16x8 a = *(const bf16x8*)(Bm + (st * 16 + fr) * 136 + k * 32 + fq * 8), bb = *(const bf16x8*)(Cm + l * 136 + k * 32 + fq * 8);
                    c = __builtin_amdgcn_mfma_f32_16x16x32_bf16(a, bb, c, 0, 0, 0); }
                float e[4];
#pragma unroll
                for (int j = 0; j < 4; ++j) { const int sp = st * 16 + fq * 4 + j; e[j] = (l >= sp) ? c[j] * __expf(acl - acs_l[hl * 64 + sp]) : 0.f; }
                pk[st] = (u32x2){cvtpk(e[0], e[1]), cvtpk(e[2], e[3])}; } }
        const int tok = ssd_token(s, l);
#pragma unroll
        for (int pt = 0; pt < 4; ++pt) { f32x4 y = (f32x4){0.f, 0.f, 0.f, 0.f};
#pragma unroll
            for (int i = 0; i < 2; ++i) { if (2 * i <= lt) {
                const u32x2 x0 = *(const u32x2*)(XTh + (pt * 16 + fr) * 72 + i * 32 + fq * 4), x1 = *(const u32x2*)(XTh + (pt * 16 + fr) * 72 + i * 32 + 16 + fq * 4);
                const u32x4 av = (u32x4){x0[0], x0[1], x1[0], x1[1]}, bv = (u32x4){pk[2 * i][0], pk[2 * i][1], pk[2 * i + 1][0], pk[2 * i + 1][1]};
                y = __builtin_amdgcn_mfma_f32_16x16x32_bf16(__builtin_bit_cast(bf16x8, av), __builtin_bit_cast(bf16x8, bv), y, 0, 0, 0); } }
            if (tok >= 0) { const float rd = rdt_l[hl * 64 + l] * dsk; f32x4 o;
#pragma unroll
                for (int j = 0; j < 4; ++j) o[j] = y[j] + bf2f(XTh[(pt * 16 + fq * 4 + j) * 72 + l]) * rd;
                *(u32x2*)(YD + (size_t)tok * 512 + h * 64 + pt * 16 + fq * 4) = (u32x2){cvtpk(o[0], o[1]), cvtpk(o[2], o[3])}; } } }
    float* CS = s.smp ? (float*)(ws + W_CSS) + ((size_t)s.b * 8 + h) * 8192 : p.out + O_Y + ((size_t)(s.b * 128 + s.c) * 8 + h) * 8192;
#pragma unroll
    for (int nti = 0; nti < 4; ++nti) { const int nt = half * 4 + nti;
#pragma unroll
        for (int pt = 0; pt < 4; ++pt) { f32x4 c = (f32x4){0.f, 0.f, 0.f, 0.f};
#pragma unroll
            for (int i = 0; i < 2; ++i) { const bf16x8 a = *(const bf16x8*)(BTl + (nt * 16 + fr) * 72 + i * 32 + fq * 8), bb = *(const bf16x8*)(XTEh + (pt * 16 + fr) * 72 + i * 32 + fq * 8);
                c = __builtin_amdgcn_mfma_f32_16x16x32_bf16(a, bb, c, 0, 0, 0); }
            *(f32x4*)(CS + (size_t)(pt * 16 + fr) * 128 + nt * 16 + fq * 4) = c; } }
    __syncthreads();
}

DEV void ssd_scan(const Params& p, float* dummy = nullptr) {
    unsigned char* ws = p.ws; const float* DEC = (const float*)(ws + W_DEC);
    if (threadIdx.x < 256) {
        typedef __attribute__((ext_vector_type(2))) float f32x2v;
        for (int e2 = blockIdx.x * 256 + threadIdx.x; e2 < 2 * 32768; e2 += gridDim.x * 256) { const int e = e2 * 2, b = e >> 16, rest = e & 65535, h = rest >> 13;
            float* cs = p.out + O_Y + (size_t)b * 128 * 65536 + rest; float* cd = dummy ? dummy + (size_t)b * 128 * 65536 + rest : cs; f32x2v sv = (f32x2v){0.f, 0.f};
#pragma unroll 32
            for (int c = 0; c < 128; ++c) { const f32x2v t = *(const f32x2v*)(cs + (size_t)c * 65536); *(f32x2v*)(cd + (size_t)c * 65536) = sv; sv = sv * DEC[(b * 128 + c) * 8 + h] + t; }
            *(f32x2v*)((dummy ? dummy : p.out + O_PSSD) + e) = sv; }
    } else {
        for (int e4 = blockIdx.x * 256 + (threadIdx.x - 256); e4 < 16 * 16384; e4 += gridDim.x * 256) { const int e = e4 * 4, b = e >> 16, h = (e >> 13) & 7;
            const f32x4 s0 = *(const f32x4*)(p.state_ssd + e), c0 = *(const f32x4*)((const float*)(ws + W_CSS) + e);
            *(f32x4*)((dummy ? dummy : p.out + O_SSSD) + e) = s0 * DEC[(256 + b) * 8 + h] + c0; }
    }
}

DEV void ssd_final_unit(const Params& p, int u, char* lds) {
    const SsdSrc s = ssd_decode(u);
    int tid = threadIdx.x; asm volatile("" : "+v"(tid)); const int lane = tid & 63, wid = tid >> 6, fr = lane & 15, fq = lane >> 4;
    unsigned char* ws = p.ws;
    const int hl = wid >> 1, half = wid & 1, h = s.g * 4 + hl;
    float* ssl = (float*)lds;
    const float* sp = s.smp ? p.state_ssd + ((size_t)s.b * 8 + h) * 8192 : p.out + O_Y + ((size_t)(s.b * 128 + s.c) * 8 + h) * 8192;
    const bf16_t* CG = (const bf16_t*)(ws + W_CG); const bf16_t* YD = (const bf16_t*)(ws + W_RA); const float* ACS = (const float*)(ws + W_ACS);
    const bf16_t* Z = (const bf16_t*)(ws + W_Z); bf16_t* MIX = (bf16_t*)(ws + W_RB);
    if (s.smp) { const int r = tid >> 5, c8 = (tid & 31) * 8;
        *(u32x4*)(MIX + (size_t)(TP + s.b * 16 + r) * 1024 + 512 + s.g * 256 + c8) = *(const u32x4*)((const bf16_t*)(ws + W_SATT) + (size_t)(s.b * 16 + r) * 512 + s.g * 256 + c8); }
    f32x4 acc[2][4]; int tok[2]; bool tv[2];
#pragma unroll
    for (int lti = 0; lti < 2; ++lti) { tok[lti] = ssd_token(s, (half * 2 + lti) * 16 + fr); tv[lti] = !s.smp || (half * 2 + lti == 3);
#pragma unroll
        for (int pt = 0; pt < 4; ++pt) acc[lti][pt] = (f32x4){0.f, 0.f, 0.f, 0.f}; }
    f32x4 yd[2][4]; u32x2 zz[2][4]; float ea[2] = {0.f, 0.f}; f32x4 ng[4];
#pragma unroll
    for (int pt = 0; pt < 4; ++pt) ng[pt] = *(const f32x4*)(p.ssd_norm_g + h * 64 + pt * 16 + fq * 4);
#pragma unroll
    for (int lti = 0; lti < 2; ++lti) if (tv[lti]) { ea[lti] = ACS[(size_t)tok[lti] * 8 + h];
#pragma unroll
        for (int pt = 0; pt < 4; ++pt) { const int ch = h * 64 + pt * 16 + fq * 4; { const u32x2 yb = *(const u32x2*)(YD + (size_t)tok[lti] * 512 + ch); yd[lti][pt] = (f32x4){bflo(yb[0]), bfhi(yb[0]), bflo(yb[1]), bfhi(yb[1])}; } zz[lti][pt] = *(const u32x2*)(Z + (size_t)tok[lti] * 512 + ch); } }
    if (tv[0] || tv[1]) {
#pragma unroll
        for (int k = 0; k < 4; ++k) { bf16x8 cb[2];
#pragma unroll
            for (int lti = 0; lti < 2; ++lti) { u32x4 t = (u32x4){0u, 0u, 0u, 0u}; if (tv[lti]) t = *(const u32x4*)(CG + (size_t)tok[lti] * 256 + s.g * 128 + k * 32 + fq * 8); cb[lti] = __builtin_bit_cast(bf16x8, t); }
#pragma unroll
            for (int pt = 0; pt < 4; ++pt) { const float* r = sp + (size_t)(pt * 16 + fr) * 128 + k * 32 + fq * 8; const f32x4 a0 = *(const f32x4*)r, a1 = *(const f32x4*)(r + 4);
                const u32x4 av = (u32x4){cvtpk(a0[0], a0[1]), cvtpk(a0[2], a0[3]), cvtpk(a1[0], a1[1]), cvtpk(a1[2], a1[3])};
#pragma unroll
                for (int lti = 0; lti < 2; ++lti) if (tv[lti]) acc[lti][pt] = __builtin_amdgcn_mfma_f32_16x16x32_bf16(__builtin_bit_cast(bf16x8, av), cb[lti], acc[lti][pt], 0, 0, 0); } } }
#pragma unroll
    for (int lti = 0; lti < 2; ++lti) { const int l = (half * 2 + lti) * 16 + fr; float ss = 0.f;
        if (tv[lti]) { const float eav = __expf(ea[lti]);
#pragma unroll
            for (int pt = 0; pt < 4; ++pt) { const u32x2 z2 = zz[lti][pt];
                const float z0 = bflo(z2[0]), z1 = bfhi(z2[0]), z2f = bflo(z2[1]), z3 = bfhi(z2[1]);
                f32x4 y = yd[lti][pt] + acc[lti][pt] * eav; y[0] *= silu_f(z0); y[1] *= silu_f(z1); y[2] *= silu_f(z2f); y[3] *= silu_f(z3);
                acc[lti][pt] = y; ss += y[0] * y[0] + y[1] * y[1] + y[2] * y[2] + y[3] * y[3]; }
            ss += __shfl_xor(ss, 16); ss += __shfl_xor(ss, 32);
            if (fq == 0) ssl[l * 4 + hl] = ss; } }
    __syncthreads();
#pragma unroll
    for (int lti = 0; lti < 2; ++lti) { const int l = (half * 2 + lti) * 16 + fr;
        if (tv[lti]) { const f32x4 q = *(const f32x4*)(ssl + l * 4); const float rs = rsqrtf((q[0] + q[1] + q[2] + q[3]) * (1.f / 256.f) + EPS);
#pragma unroll
            for (int pt = 0; pt < 4; ++pt) { const int ch = h * 64 + pt * 16 + fq * 4; const f32x4 y = acc[lti][pt] * rs * ng[pt];
                *(u32x2*)(MIX + (size_t)tok[lti] * 1024 + ch) = (u32x2){cvtpk(y[0], y[1]), cvtpk(y[2], y[3])}; } } }
    __syncthreads();
}

namespace att {
constexpr int D = 64, QDM = 512, NW = 8, QBLK = 32, QB = QBLK * NW, KVBLK = 64, NQB = SEQ / QB, OPITCH = 1024;
constexpr float C2 = 1.0f;
constexpr int THR = 48;
constexpr int SLOTB = 8192, LDS_K = 0, LDS_V = 3 * SLOTB, LDS_WS = 6 * SLOTB, LDS_OST = LDS_WS + NW * 256, LDS_BYTES = LDS_OST + NW * 4096, LDS_GB = LDS_BYTES;
static_assert(LDS_GB + SEQ * 4 <= LDS_TOTAL, "attention lds");
#define SBAR() __builtin_amdgcn_sched_barrier(0)
#define PIN(x) asm volatile("" : "+v"(x))
#define MFMA(a, b, c) __builtin_amdgcn_mfma_f32_32x32x16_bf16(a, b, c, 0, 0, 0)
#define WAIT_BAR(N) asm volatile("s_waitcnt vmcnt(" #N ") lgkmcnt(0)\n\ts_barrier" ::: "memory")
DEV int crow(int r, int hi) { return (r & 3) + 8 * (r >> 2) + 4 * hi; }
DEV void glds16(const void* g, unsigned lds_base) {
    unsigned sv; asm volatile("s_mov_b32 %0, m0\n\ts_mov_b32 m0, %2\n\ts_nop 0\n\tglobal_load_lds_dwordx4 %1, off\n\ts_mov_b32 m0, %0" : "=&s"(sv) : "v"(g), "s"(lds_base) : "memory"); }
typedef __attribute__((address_space(3))) const char* lds_cptr;
typedef short v4i16_t __attribute__((ext_vector_type(4)));
DEV void kload2(bf16x8* kf, lds_cptr kp, int d0) { kf[2 * d0] = *(const __attribute__((address_space(3))) bf16x8*)(kp + d0 * 2048); kf[2 * d0 + 1] = *(const __attribute__((address_space(3))) bf16x8*)(kp + d0 * 2048 + 512); }
DEV s16x4 vtr(lds_cptr p) { return __builtin_bit_cast(s16x4, __builtin_amdgcn_ds_read_tr16_b64_v4i16((__attribute__((address_space(3))) v4i16_t*)p)); }
#define MX3(a, b, c) __builtin_fmaxf(__builtin_fmaxf((a), (b)), (c))
DEV float rowmax(const f32x16& p0, const f32x16& p1) {
    float a = MX3(p0[0], p0[1], p1[0]), b = MX3(p0[2], p0[3], p1[1]); a = MX3(a, p1[2], p1[3]);
#pragma unroll
    for (int r = 4; r < 16; r += 4) { a = MX3(a, p0[r], p0[r + 1]); b = MX3(b, p0[r + 2], p0[r + 3]); a = MX3(a, p1[r], p1[r + 1]); b = MX3(b, p1[r + 2], p1[r + 3]); }
    float m = __builtin_fmaxf(a, b); auto rr = __builtin_amdgcn_permlane32_swap(__float_as_uint(m), __float_as_uint(m), false, false);
    return __builtin_fmaxf(__uint_as_float(rr[0]), __uint_as_float(rr[1])); }
DEV void cmask(f32x16& p0, f32x16& p1, int jb, int qrel, int hi) {
    const int kb = 64 * jb + 4 * hi;
#pragma unroll
    for (int r = 0; r < 16; ++r) { const int kv = kb + (r & 3) + 8 * (r >> 2); if (kv > qrel) p0[r] = -INFINITY; if (kv + 32 > qrel) p1[r] = -INFINITY; } }
typedef __attribute__((address_space(3))) const f32x4* lds_f4p;
DEV void loadbias(f32x16& c0, f32x16& c1, lds_f4p gb, int t, int hi) {
#pragma unroll
    for (int i = 0; i < 4; ++i) { const f32x4 a = gb[16 * t + hi + 2 * i], b = gb[16 * t + 8 + hi + 2 * i];
        c0[4 * i] = a[0]; c0[4 * i + 1] = a[1]; c0[4 * i + 2] = a[2]; c0[4 * i + 3] = a[3]; c1[4 * i] = b[0]; c1[4 * i + 1] = b[1]; c1[4 * i + 2] = b[2]; c1[4 * i + 3] = b[3]; } }

DEV void attn64_unit(int b, int h, int qb, int bias_qb, const bf16_t* Q, const bf16_t* __restrict__ K, const bf16_t* __restrict__ V, const float* __restrict__ G, bf16_t* O, char* lds) {
    int tid = threadIdx.x; asm volatile("" : "+v"(tid));
    const int lane = tid & 63, r32 = lane & 31, hi = lane >> 5; const int wid = __builtin_amdgcn_readfirstlane(tid >> 6);
    const long rowbase = (long)b * SEQ; const int q0 = qb * QB, NT = (q0 + QB) / KVBLK;
    const bf16_t* Qw = Q + (rowbase + q0 + wid * QBLK) * QDM + h * D;
    const unsigned lds0 = (unsigned)(uintptr_t)lds; float* wsf = (float*)(lds + LDS_WS) + wid * 64;
    if (bias_qb >= 0) { const f32x4* src = (const f32x4*)(G + ((size_t)b * 8 + h) * SEQ); f32x4* dst = (f32x4*)(lds + LDS_GB); const int n4 = (bias_qb * QB + QB) / 4;
      for (int i = tid; i < n4; i += 512) dst[i] = src[i];
      asm volatile("s_waitcnt vmcnt(0) lgkmcnt(0)" ::: "memory"); }
    const lds_f4p gb = (lds_f4p)((lds_cptr)lds + LDS_GB);
    const bf16_t* ksrc = K + rowbase * QDM + h * D + (long)lane * QDM + wid * 8;
    const bf16_t* vsrc = V + rowbase * QDM + h * D + (long)(16 * (wid & 3) + (lane >> 2)) * QDM + (wid >> 2) * 32 + (lane & 3) * 8;
    const unsigned kdst = lds0 + LDS_K + wid * 1024, vdst = lds0 + LDS_V + wid * 1024;
#define DMA_K(t, slot) glds16(ksrc + (long)(t) * KVBLK * QDM, (unsigned)__builtin_amdgcn_readfirstlane(kdst + (slot)))
#define DMA_V(t, slot) glds16(vsrc + (long)(t) * KVBLK * QDM, (unsigned)__builtin_amdgcn_readfirstlane(vdst + (slot)))
    const lds_cptr vp0 = (lds_cptr)lds + LDS_V + ((lane >> 4) & 1) * 32 + (lane & 3) * 8 + (4 * hi + ((lane & 15) >> 2)) * 64;
    const lds_cptr kp0 = (lds_cptr)lds + LDS_K + hi * 1024 + r32 * 16;
    DMA_K(0, 0); DMA_V(0, 0); DMA_K(1, SLOTB);
    bf16x8 qr[4];
#pragma unroll
    for (int d0 = 0; d0 < 4; ++d0) qr[d0] = *reinterpret_cast<const bf16x8*>(&Qw[(long)r32 * QDM + d0 * 16 + hi * 8]);
    float mhat = 0.f, l_reg = 0.f; f32x16 o[2]; o[0] = f32x16{}; o[1] = f32x16{};
    const int qrel = wid * QBLK + r32; bool resc = false;
    f32x16 pA0, pA1, pB0, pB1; bf16x8 kf[8]; s16x4 vlo[8], vhi[8]; u32x4 pw0, pw1, pw2, pw3;
    int sl_prev = 0, sl_cur = 0, sl_next = SLOTB;
#define ROT() do { sl_prev = sl_cur; sl_cur = sl_next; sl_next = (sl_next == 2 * SLOTB) ? 0 : sl_next + SLOTB; } while (0)
#define EX(v) __builtin_amdgcn_exp2f(__builtin_fmaf((v), C2, nmh))
#define RESC() do { if (resc) { _Pragma("unroll") for (int d_ = 0; d_ < 2; ++d_) _Pragma("unroll") for (int r = 0; r < 16; ++r) o[d_][r] *= wsf[crow(r, hi)]; } } while (0)
    DMA_K(2, 2 * SLOTB);
    WAIT_BAR(3);
    _Pragma("unroll") for (int d0 = 0; d0 < 4; ++d0) kload2(kf, kp0, d0);
    loadbias(pA0, pA1, gb, 0, hi);
    pA0 = MFMA(kf[0], qr[0], pA0); pA1 = MFMA(kf[1], qr[0], pA1); pA0 = MFMA(kf[2], qr[1], pA0); pA1 = MFMA(kf[3], qr[1], pA1);
    pA0 = MFMA(kf[4], qr[2], pA0); pA1 = MFMA(kf[5], qr[2], pA1); pA0 = MFMA(kf[6], qr[3], pA0); pA1 = MFMA(kf[7], qr[3], pA1);
    if (NT == 4) cmask(pA0, pA1, 0, qrel, hi);
    { const float rm = rowmax(pA0, pA1); mhat = rm * C2; const float nmh = -mhat;
#pragma unroll
      for (int r = 0; r < 16; ++r) { pA0[r] = EX(pA0[r]); pA1[r] = EX(pA1[r]); } }
    WAIT_BAR(0);
    DMA_K(3, 0); DMA_V(1, SLOTB); ROT();
    _Pragma("unroll") for (int d0 = 0; d0 < 4; ++d0) kload2(kf, kp0 + sl_cur, d0);
    WAIT_BAR(2);
#define PKW(P, i) cvtpk(P[i], P[i + 1])
#define PAF(k) __builtin_bit_cast(bf16x8, pw##k)
#define VFR(i) (bf16x8){vlo[i][0], vlo[i][1], vlo[i][2], vlo[i][3], vhi[i][0], vhi[i][1], vhi[i][2], vhi[i][3]}
#define VRD(i) do { vlo[i] = vtr(vp_ + (((i) >> 2) * 4096 + ((i) & 3) * 1024)); vhi[i] = vtr(vp_ + (((i) >> 2) * 4096 + ((i) & 3) * 1024 + 512)); } while (0)
#define KRD(G_, d0) do { if (G_) { kload2(kf, kp0 + sl_next, d0); SBAR(); } } while (0)
#define GAPA(MF, a0, a1, a2, a3, W0, W1, PW) do { MF; sacc += a0; sacc += a1; sacc += a2; sacc += a3; W0; W1; PIN(PW); PIN(sacc); SBAR(); } while (0)
#define GAPB(MF, X, i) do { MF; X[i] = EX(X[i]); X[i + 1] = EX(X[i + 1]); X[i + 2] = EX(X[i + 2]); X[i + 3] = EX(X[i + 3]); PIN(X); SBAR(); } while (0)
#define STEP(C0, C1, P0, P1, t, MASK, GK, GV, GL) do { SBAR(); \
    const lds_cptr vp_ = vp0 + sl_prev; \
    VRD(0); SBAR(); float sacc = P0[0] + P0[1]; \
                    GAPA(C0 = MFMA(kf[0], qr[0], C0), P0[2], P0[3], P0[4], P0[5],     pw0[0] = PKW(P0, 0),  pw0[1] = PKW(P0, 2),  pw0); \
    VRD(4); SBAR(); GAPA(C1 = MFMA(kf[1], qr[0], C1), P0[6], P0[7], P0[8], P0[9],     pw0[2] = PKW(P0, 4),  pw0[3] = PKW(P0, 6),  pw0); \
    VRD(1); SBAR(); GAPA(C0 = MFMA(kf[2], qr[1], C0),    P0[10], P0[11], P0[12], P0[13], pw1[0] = PKW(P0, 8),  pw1[1] = PKW(P0, 10), pw1); \
    VRD(5); SBAR(); GAPA(C1 = MFMA(kf[3], qr[1], C1),    P0[14], P0[15], P1[0], P1[1],   pw1[2] = PKW(P0, 12), pw1[3] = PKW(P0, 14), pw1); \
    VRD(2); SBAR(); GAPA(C0 = MFMA(kf[4], qr[2], C0),    P1[2], P1[3], P1[4], P1[5],     pw2[0] = PKW(P1, 0),  pw2[1] = PKW(P1, 2),  pw2); \
    VRD(6); SBAR(); GAPA(C1 = MFMA(kf[5], qr[2], C1),    P1[6], P1[7], P1[8], P1[9],     pw2[2] = PKW(P1, 4),  pw2[3] = PKW(P1, 6),  pw2); \
    VRD(3); SBAR(); GAPA(C0 = MFMA(kf[6], qr[3], C0),    P1[10], P1[11], P1[12], P1[13], pw3[0] = PKW(P1, 8),  pw3[1] = PKW(P1, 10), pw3); \
    VRD(7); SBAR(); GAPA(C1 = MFMA(kf[7], qr[3], C1),    P1[14], P1[15], 0.f, 0.f,       pw3[2] = PKW(P1, 12), pw3[3] = PKW(P1, 14), pw3); \
    l_reg += sacc; \
    if (GK) DMA_K((t) + 3, sl_cur); if (GV) DMA_V((t) + 1, sl_next); \
    if (MASK) cmask(C0, C1, (t) - (NT - 4), qrel, hi); \
    { const float rm = __builtin_fmaf(rowmax(C0, C1), C2, -mhat); resc = false; \
      if (__any(rm > (float)THR)) { const float dl = __builtin_fmaxf(rm, 0.f); mhat += dl; \
          const float f = __builtin_amdgcn_exp2f(-dl); l_reg *= f; if (hi == 0) wsf[r32] = f; resc = true; } } \
    const float nmh = -mhat; SBAR(); \
    if (GL) { loadbias(P0, P1, gb, (t) + 1, hi); SBAR(); }            \
    GAPB(o[0] = MFMA(PAF(0), VFR(0), o[0]), C0, 0);              GAPB(o[1] = MFMA(PAF(0), VFR(4), o[1]), C0, 4); \
    KRD(GL, 0); GAPB(o[0] = MFMA(PAF(1), VFR(1), o[0]), C0, 8);  KRD(GL, 1); GAPB(o[1] = MFMA(PAF(1), VFR(5), o[1]), C0, 12); \
    KRD(GL, 2); GAPB(o[0] = MFMA(PAF(2), VFR(2), o[0]), C1, 0);  KRD(GL, 3); GAPB(o[1] = MFMA(PAF(2), VFR(6), o[1]), C1, 4); \
    GAPB(o[0] = MFMA(PAF(3), VFR(3), o[0]), C1, 8);              GAPB(o[1] = MFMA(PAF(3), VFR(7), o[1]), C1, 12); \
    } while (0)
    loadbias(pB0, pB1, gb, 1, hi);
    int t = 1;
    for (; t + 5 < NT; t += 2) {
        STEP(pB0, pB1, pA0, pA1, t, false, true, true, true);     WAIT_BAR(2); RESC(); ROT();
        STEP(pA0, pA1, pB0, pB1, t + 1, false, true, true, true); WAIT_BAR(2); RESC(); ROT();
    }
#define ENDW(tt) do { if ((tt) + 3 < NT) { WAIT_BAR(2); } else if ((tt) + 2 < NT) { WAIT_BAR(1); } else { WAIT_BAR(0); } } while (0)
    for (; t + 1 < NT; t += 2) {
        STEP(pB0, pB1, pA0, pA1, t, true, (t + 3 < NT), (t + 1 < NT), (t + 1 < NT));         ENDW(t);     RESC(); ROT();
        STEP(pA0, pA1, pB0, pB1, t + 1, true, (t + 4 < NT), (t + 2 < NT), (t + 2 < NT));     ENDW(t + 1); RESC(); ROT();
    }
    STEP(pB0, pB1, pA0, pA1, NT - 1, true, false, false, false); RESC();
    { float sacc = pB0[0] + pB0[1];
#pragma unroll
      for (int r = 2; r < 16; ++r) sacc += pB0[r];
#pragma unroll
      for (int r = 0; r < 16; ++r) sacc += pB1[r];
      l_reg += sacc;
      pw0 = (u32x4){PKW(pB0, 0), PKW(pB0, 2), PKW(pB0, 4), PKW(pB0, 6)}; pw1 = (u32x4){PKW(pB0, 8), PKW(pB0, 10), PKW(pB0, 12), PKW(pB0, 14)};
      pw2 = (u32x4){PKW(pB1, 0), PKW(pB1, 2), PKW(pB1, 4), PKW(pB1, 6)}; pw3 = (u32x4){PKW(pB1, 8), PKW(pB1, 10), PKW(pB1, 12), PKW(pB1, 14)};
      const lds_cptr vp_ = vp0 + sl_cur; _Pragma("unroll") for (int i = 0; i < 8; ++i) VRD(i);
      o[0] = MFMA(PAF(0), VFR(0), o[0]); o[1] = MFMA(PAF(0), VFR(4), o[1]); o[0] = MFMA(PAF(1), VFR(1), o[0]); o[1] = MFMA(PAF(1), VFR(5), o[1]);
      o[0] = MFMA(PAF(2), VFR(2), o[0]); o[1] = MFMA(PAF(2), VFR(6), o[1]); o[0] = MFMA(PAF(3), VFR(3), o[0]); o[1] = MFMA(PAF(3), VFR(7), o[1]); }
    { auto rr = __builtin_amdgcn_permlane32_swap(__float_as_uint(l_reg), __float_as_uint(l_reg), false, false); l_reg = __uint_as_float(rr[0]) + __uint_as_float(rr[1]); }
    if (hi == 0) wsf[32 + r32] = l_reg; asm volatile("s_waitcnt lgkmcnt(0)" ::: "memory");
    float rli[16];
#pragma unroll
    for (int r = 0; r < 16; ++r) rli[r] = __builtin_amdgcn_rcpf(wsf[32 + crow(r, hi)]);
    bf16_t* Ow = O + (rowbase + q0 + wid * QBLK) * OPITCH + h * D; bf16_t* stg = (bf16_t*)(lds + LDS_OST) + wid * 2048;
#pragma unroll
    for (int r = 0; r < 16; ++r) { const int orow = crow(r, hi);
#pragma unroll
        for (int d0 = 0; d0 < 2; ++d0) stg[orow * 64 + d0 * 32 + r32] = f2bf(o[d0][r] * rli[r]); }
    asm volatile("s_waitcnt lgkmcnt(0)" ::: "memory");
#pragma unroll
    for (int i = 0; i < 4; ++i) { const int row = i * 8 + (lane >> 3), ch = lane & 7; *(u32x4*)(Ow + (long)row * OPITCH + ch * 8) = *(const u32x4*)(stg + row * 64 + ch * 8); }
    asm volatile("s_waitcnt lgkmcnt(0)\n\ts_barrier" ::: "memory");
#undef DMA_K
#undef DMA_V
#undef ROT
#undef EX
#undef RESC
#undef PKW
#undef PAF
#undef VFR
#undef VRD
#undef KRD
#undef ENDW
#undef GAPA
#undef GAPB
#undef STEP
}
}

DEV void ffn_conv_gate(const Params& p, int hf) {
    unsigned char* ws = p.ws; const bf16_t* U = (const bf16_t*)(ws + W_U); bf16_t* ACT = (bf16_t*)(ws + W_ACT);
    const int nitems = (TA / 32) * 176;
    for (int it = blockIdx.x * 512 + threadIdx.x; it < nitems; it += gridDim.x * 512) {
        const int run = it / 176, cg8 = it % 176, row0 = run * 32; const int ja = hf * 1408 + cg8 * 8;
        const int lc = cg8 * 8, ug = (lc >> 7) * 256 + (lc & 127), uv = ug + 128;
        const bool smp = row0 >= TP;
        float wg[3][8], wv[3][8], bg[8], bv[8];
#pragma unroll
        for (int e = 0; e < 8; ++e) { bg[e] = p.ffn_conv_b[ja + e]; bv[e] = p.ffn_conv_b[DFF + ja + e];
#pragma unroll
            for (int j = 0; j < 3; ++j) { wg[j][e] = p.ffn_conv_w[j * NUP + ja + e]; wv[j][e] = p.ffn_conv_w[j * NUP + DFF + ja + e]; } }
        float g2[8], g1[8], v2[8], v1[8];
        auto unpack = [](const u32x4& a, float* o) {
#pragma unroll
            for (int e = 0; e < 4; ++e) { o[2 * e] = bflo(a[e]); o[2 * e + 1] = bfhi(a[e]); } };
        auto init_window = [&](int row) {
            if (smp) { const int b = (row - TP) >> 4; const float* s0 = p.state_ffn_conv + (size_t)(b * 2) * NUP, *s1 = s0 + NUP;
#pragma unroll
                for (int e = 0; e < 8; ++e) { g2[e] = s0[ja + e]; v2[e] = s0[DFF + ja + e]; g1[e] = s1[ja + e]; v1[e] = s1[DFF + ja + e]; } }
            else if ((row & 8191) == 0) {
#pragma unroll
                for (int e = 0; e < 8; ++e) { g2[e] = 0.f; v2[e] = 0.f; g1[e] = 0.f; v1[e] = 0.f; } }
            else { unpack(*(const u32x4*)(U + (size_t)(row - 2) * DFF + ug), g2); unpack(*(const u32x4*)(U + (size_t)(row - 2) * DFF + uv), v2);
                   unpack(*(const u32x4*)(U + (size_t)(row - 1) * DFF + ug), g1); unpack(*(const u32x4*)(U + (size_t)(row - 1) * DFF + uv), v1); } };
        init_window(row0);
#pragma unroll 4
        for (int r = 0; r < 32; ++r) { const int row = row0 + r;
            if (smp && r == 16) init_window(row);
            float g0[8], v0[8]; unpack(*(const u32x4*)(U + (size_t)row * DFF + ug), g0); unpack(*(const u32x4*)(U + (size_t)row * DFF + uv), v0);
            u32x4 o;
#pragma unroll
            for (int e = 0; e < 4; ++e) { float a[2];
#pragma unroll
                for (int q = 0; q < 2; ++q) { const int i = 2 * e + q; const float cg = bg[i] + wg[0][i] * g2[i] + wg[1][i] * g1[i] + wg[2][i] * g0[i], cv = bv[i] + wv[0][i] * v2[i] + wv[1][i] * v1[i] + wv[2][i] * v0[i];
                    a[q] = silu_f(cg) * cv; }
                o[e] = cvtpk(a[0], a[1]); }
            *(u32x4*)(ACT + (size_t)row * DFF + ja) = o;
#pragma unroll
            for (int e = 0; e < 8; ++e) { g2[e] = g1[e]; g1[e] = g0[e]; v2[e] = v1[e]; v1[e] = v0[e]; }
        }
    }
}

#define XB_TMO      128
#define XB_XCNT(j)  (256  + 64 * (j))
#define XB_XSUB(j)  (1280 + 64 * (j))
#define XB_XGEN(j)  (2304 + 64 * (j))
#define XB_TOP      3328
#define XB_TOPGEN   3392
#define XCD_BAR_WORDS 3456
#define XB_SPIN_CAP (1u << 18)
#define LAS __attribute__((address_space(3)))
DEV unsigned xb_ld(unsigned* p)              { return __hip_atomic_load(p, __ATOMIC_RELAXED, __HIP_MEMORY_SCOPE_AGENT); }
DEV unsigned xb_add(unsigned* p, unsigned v) { return __hip_atomic_fetch_add(p, v, __ATOMIC_RELAXED, __HIP_MEMORY_SCOPE_AGENT); }
DEV unsigned xb_xcc_id() { return (unsigned)__builtin_amdgcn_s_getreg((3 << 11) | 20) & 0xFu; }
#define XB_SPIN(cond, bar) do { unsigned _sp = 0; while (cond) { __builtin_amdgcn_s_sleep(1); \
    if ((++_sp & 255u) == 0u) { if (xb_ld(&(bar)[XB_TMO])) break; if (_sp > XB_SPIN_CAP) { atomicAdd(&(bar)[XB_TMO], 1u); break; } } } } while (0)
struct XcdBarrier { unsigned* bar; unsigned x; volatile LAS unsigned* st; };
DEV XcdBarrier xcd_barrier_post(unsigned* bar, volatile LAS unsigned* st) {
    XcdBarrier b; b.bar = bar; b.x = xb_xcc_id(); b.st = st;
    if (threadIdx.x == 0) (void)xb_add(&bar[XB_XCNT(b.x)], 1u);
    return b;
}
DEV void xcd_barrier_complete(unsigned* bar, unsigned x, unsigned& nloc, unsigned& nx) {
    const unsigned G = gridDim.x * gridDim.y * gridDim.z;
    unsigned sum, cnt, mine, sp = 0u;
    for (;;) {
        sum = 0u; cnt = 0u; mine = 0u;
#pragma unroll
        for (unsigned j = 0; j < 16; ++j) { const unsigned c = xb_ld(&bar[XB_XCNT(j)]); sum += c; cnt += (c > 0u) ? 1u : 0u; mine = (j == x) ? c : mine; }
        if (sum == G) break;
        __builtin_amdgcn_s_sleep(1);
        if ((++sp & 255u) == 0u) { if (xb_ld(&bar[XB_TMO])) break; if (sp > XB_SPIN_CAP) { atomicAdd(&bar[XB_TMO], 1u); break; } }
    }
    nloc = mine > 0u ? mine : 1u; nx = cnt > 0u ? cnt : 1u;
}
DEV void xcd_barrier(const XcdBarrier& b) {
    asm volatile("s_waitcnt vmcnt(0)" ::: "memory");
    __syncthreads();
    if (threadIdx.x == 0) {
        unsigned* bar = b.bar;
        __builtin_amdgcn_s_waitcnt(0);
        unsigned nloc = b.st[0], nx = b.st[1];
        if (nloc == 0u) { xcd_barrier_complete(bar, b.x, nloc, nx); b.st[0] = nloc; b.st[1] = nx; }
        const unsigned old = xb_add(&bar[XB_XSUB(b.x)], 1u);
        const unsigned gen = old / nloc;
        if (old + 1u == (gen + 1u) * nloc) {
            __builtin_amdgcn_fence(__ATOMIC_RELEASE, "agent");
            asm volatile("s_waitcnt vmcnt(0)" ::: "memory");
            const unsigned og = xb_add(&bar[XB_TOP], 1u);
            const unsigned tg = og / nx;
            if (og + 1u == (tg + 1u) * nx) xb_add(&bar[XB_TOPGEN], 1u);
            else XB_SPIN(xb_ld(&bar[XB_TOPGEN]) == tg, bar);
            __builtin_amdgcn_fence(__ATOMIC_ACQUIRE, "agent");
            xb_add(&bar[XB_XGEN(b.x)], 1u);
            asm volatile("s_waitcnt vmcnt(0)" ::: "memory");
        } else {
            XB_SPIN(xb_ld(&bar[XB_XGEN(b.x)]) == gen, bar);
            __builtin_amdgcn_fence(__ATOMIC_ACQUIRE, "agent");
            asm volatile("s_waitcnt vmcnt(0)" ::: "memory");
        }
    }
    __syncthreads();
}

struct EpiDownNorm {
    const bf16_t* Hb; float* X; unsigned* cnt; unsigned* tmo; const float* g; float* Y; char* lds;
    DEV void operator()(f32x4 (&acc)[2][2][4][2], int pm, int pn, int wr, int wc, int fr, int fq) const {
        float* Pl = (float*)lds; float* Sl = (float*)(lds + 4096);
        EPI_LOOP_BEGIN
            float ss = 0.f;
            EPI_COLS_BEGIN
                const u32x2 hb = *(const u32x2*)(Hb + (size_t)row * 1024 + col); const f32x4 h = v + (f32x4){bflo(hb[0]), bfhi(hb[0]), bflo(hb[1]), bfhi(hb[1])};
                acc[ai][bj][m][n] = h; ss += h[0] * h[0] + h[1] * h[1] + h[2] * h[2] + h[3] * h[3];
            }
            ss += __shfl_xor(ss, 16); ss += __shfl_xor(ss, 32);
            if (fq == 0) Pl[(row - pm * BM) * 4 + wc] = ss;
        }
        __syncthreads();
        int tid = threadIdx.x; asm volatile("" : "+v"(tid));
        if (tid < 256) { const f32x4 q = *(const f32x4*)(Pl + tid * 4); __hip_atomic_store(X + ((size_t)pm * 256 + tid) * 4 + pn, (q[0] + q[1]) + (q[2] + q[3]), __ATOMIC_RELAXED, __HIP_MEMORY_SCOPE_AGENT); }
        asm volatile("s_waitcnt vmcnt(0)" ::: "memory");
        __syncthreads();
        if (tid == 0) { (void)xb_add(cnt + pm * 16, 1u); unsigned sp = 0u;
            while (xb_ld(cnt + pm * 16) < 4u) { __builtin_amdgcn_s_sleep(1); if (++sp > (1u << 20)) { atomicAdd(tmo, 1u); break; } } }
        __syncthreads();
        if (tid < 256) { const float* xs = X + ((size_t)pm * 256 + tid) * 4; float q[4];
#pragma unroll
            for (int i = 0; i < 4; ++i) q[i] = __hip_atomic_load(xs + i, __ATOMIC_RELAXED, __HIP_MEMORY_SCOPE_AGENT);
            Sl[tid] = rsqrtf(((q[0] + q[1]) + (q[2] + q[3])) * (1.f / 1024.f) + EPS); }
        __syncthreads();
        EPI_LOOP_BEGIN
            const float rs = Sl[row - pm * BM];
            EPI_COLS_BEGIN
                const f32x4 gg = *(const f32x4*)(g + col);
                *(f32x4*)(Y + (size_t)row * 1024 + col) = v * rs * gg;
            }
        }
        __syncthreads();
    }
};
struct SampleNormPost {
    float* Y; float* SS; const float* g; unsigned* cnt; char* lds;
    DEV void operator()(int mt) const {
        int tid = threadIdx.x; asm volatile("" : "+v"(tid)); const int rg = mt & 7;
        unsigned* flag = (unsigned*)(lds + 36864);
        __builtin_amdgcn_fence(__ATOMIC_RELEASE, "agent"); asm volatile("s_waitcnt vmcnt(0)" ::: "memory");
        __syncthreads();
        if (tid == 0) *flag = xb_add(cnt + (64 + rg) * 16, 1u);
        __syncthreads();
        if (*flag == 31u) {
            __builtin_amdgcn_fence(__ATOMIC_ACQUIRE, "agent"); asm volatile("s_waitcnt vmcnt(0)" ::: "memory");
            const int row = TP + rg * 32 + (tid >> 4);
            const float ssv = __hip_atomic_load(SS + row, __ATOMIC_RELAXED, __HIP_MEMORY_SCOPE_AGENT); const float rs = rsqrtf(ssv * (1.f / 1024.f) + EPS);
#pragma unroll 4
            for (int i = 0; i < 16; ++i) { const int col = ((tid & 15) + 16 * i) * 4; float* yp = Y + (size_t)row * 1024 + col; const f32x4 gg = *(const f32x4*)(g + col); *(f32x4*)yp = *(const f32x4*)yp * rs * gg; }
        }
        __syncthreads();
    }
};

#ifndef PROBE
#define PROBE 0
#endif
template <int PH> DEV void run_phase(const Params& p, char* lds) {
    unsigned char* ws = p.ws;
    if constexpr (PH == 0) { phase0(p, lds); }
    else if constexpr (PH == 1) { EpiIn e{(bf16_t*)(ws + W_Z), (bf16_t*)(ws + W_RB), (bf16_t*)(ws + W_Q), (bf16_t*)(ws + W_K), (bf16_t*)(ws + W_V), p.out};
        EpiInE ee{(bf16_t*)(ws + W_Z), (bf16_t*)(ws + W_RB), (bf16_t*)(ws + W_Q), (bf16_t*)(ws + W_K), (bf16_t*)(ws + W_V), p.out};
        sample_gemm<3>((const bf16_t*)(ws + W_RA), (const bf16_t*)(ws + W_WIN), 3072, 1024, ee, lds);
        gemm_phase((const bf16_t*)(ws + W_RA), (const bf16_t*)(ws + W_WIN), TP, 3072, 1024, e); }
    else if constexpr (PH == 2) {
        for (int u = (int)blockIdx.x + ((2 + 128 + 544 - 1 - (int)blockIdx.x) / (int)gridDim.x) * (int)gridDim.x; u >= 0; u -= (int)gridDim.x) {
#ifndef P2_MASK
#define P2_MASK 7
#endif
#ifndef P2_REP
#define P2_REP 0
#endif
            if (u < 544) { for (int rep = 0; rep < ((P2_REP & 4) ? 2 : 1); ++rep) ssd_chunk_unit(p, u, lds); }
            else if (u < 672) { for (int rep = 0; rep < ((P2_REP & 2) ? 2 : 1); ++rep) sample_attn_unit(p, (u - 544) >> 3, (u - 544) & 7, lds); }
            else { for (int rep = 0; rep < ((P2_REP & 1) ? 2 : 1); ++rep) cumsum_prompt_unit(p, u - 672, lds); }
        }
        weight_units_on_idle(p, 192, 608, 162, lds); }
    else if constexpr (PH == 3) {
#ifndef NO_SCAN
#if PROBE == 101
        ssd_scan(p, (float*)(ws + W_ACT + (size_t)16 * 1024 * 1024));
#endif
        ssd_scan(p);
#endif
#ifndef ATT_REP
#define ATT_REP 1
#endif
        for (int rep = 0; rep < ATT_REP; ++rep)
        for (int u = blockIdx.x; u < 256; u += gridDim.x) {
            const int x = u & 7, kk = u >> 3, bh = x + 8 * (kk / 16), j = kk % 16;
            att::attn64_unit(bh >> 3, bh & 7, j, att::NQB - 1 - j, (const bf16_t*)(ws + W_Q), (const bf16_t*)(ws + W_K), (const bf16_t*)(ws + W_V), (const float*)(ws + W_G), (bf16_t*)(ws + W_RB) + 512, lds);
            att::attn64_unit(bh >> 3, bh & 7, att::NQB - 1 - j, -1, (const bf16_t*)(ws + W_Q), (const bf16_t*)(ws + W_K), (const bf16_t*)(ws + W_V), (const float*)(ws + W_G), (bf16_t*)(ws + W_RB) + 512, lds); } }
    else if constexpr (PH == 4) { for (int u = blockIdx.x; u < 544; u += gridDim.x) ssd_final_unit(p, u, lds);
        weight_units_on_idle(p, 608, 784, 32, lds); }
    else if constexpr (PH == 5) { EpiOut e{p.x_prompt, p.x_sample, p.out + O_Y, (bf16_t*)(ws + W_RA), (float*)(ws + W_SS2)};
        EpiResE ee{p.x_sample - (size_t)TP * 1024, nullptr, nullptr, (bf16_t*)(ws + W_RA), (float*)(ws + W_SS2)};
        sample_gemm((const bf16_t*)(ws + W_RB), (const bf16_t*)(ws + W_WOUT), 1024, 1024, ee, lds);
        gemm_phase((const bf16_t*)(ws + W_RB), (const bf16_t*)(ws + W_WOUT), TP, 1024, 1024, e); }
    else if constexpr (PH == 6) { EpiUpFused e{(const float*)(ws + W_SS2), p.out, (bf16_t*)(ws + W_ACT), (bf16_t*)(ws + W_HALO), p.ffn_conv_w, p.ffn_conv_b, p.state_ffn_conv, lds};
        gemm_phase((const bf16_t*)(ws + W_RA), (const bf16_t*)(ws + W_WUP), TA, NUP, 1024, e); }
    else if constexpr (PH == 10) {
        EpiDownNorm e{(const bf16_t*)(ws + W_RA), (float*)(ws + W_DT), (unsigned*)(ws + W_CNT), (unsigned*)(ws + W_BAR) + XB_TMO, p.final_norm_g, p.out + O_Y, lds};
        EpiResE ee{nullptr, (const bf16_t*)(ws + W_RA), p.out + O_Y, nullptr, (float*)(ws + W_SS3)};
        sample_gemm((const bf16_t*)(ws + W_ACT), (const bf16_t*)(ws + W_WDN), 1024, DFF, ee, lds);
        gemm_phase((const bf16_t*)(ws + W_ACT), (const bf16_t*)(ws + W_WDN), TP, 1024, DFF, e, FfnFixup{&p}); }
    else if constexpr (PH == 11) { const int lane = threadIdx.x & 63, wid = threadIdx.x >> 6; const float* SS = (const float*)(ws + W_SS3);
        for (int row = TP + blockIdx.x * 8 + wid; row < TA; row += gridDim.x * 8) { const float rs = rsqrtf(SS[row] * (1.f / 1024.f) + EPS); float* yr = p.out + O_Y + (size_t)row * 1024;
#pragma unroll
            for (int i = 0; i < 4; ++i) { const f32x4 g = *(const f32x4*)(p.final_norm_g + i * 256 + lane * 4); f32x4 x = *(f32x4*)(yr + i * 256 + lane * 4); x = x * rs * g; *(f32x4*)(yr + i * 256 + lane * 4) = x; } } }
}
constexpr int NPH = 12;

#ifndef N_LAUNCH_SPLIT
#define N_LAUNCH_SPLIT 0
#endif
#if N_LAUNCH_SPLIT
template <int PH> __global__ void __launch_bounds__(512) ph_kernel(Params p) {
    extern __shared__ __attribute__((aligned(16))) bf16_t shm[];
    run_phase<PH>(p, (char*)shm);
}
template <int PH> static void launch_ph(const Params& p, int grid, hipStream_t stream) {
    (void)hipFuncSetAttribute((const void*)ph_kernel<PH>, hipFuncAttributeMaxDynamicSharedMemorySize, LDS_TOTAL);
    hipLaunchKernelGGL(ph_kernel<PH>, dim3(grid), dim3(512), LDS_TOTAL, stream, p);
}
#else
__global__ void __launch_bounds__(512) hymba_fwd(Params p) {
    extern __shared__ __attribute__((aligned(16))) bf16_t shm[];
    __shared__ uint4 xb_words;
    char* lds = (char*)shm;
    if (threadIdx.x == 0) xb_words = make_uint4(0u, 0u, 0u, 0u);
    __syncthreads();
    const XcdBarrier bar = xcd_barrier_post((unsigned*)(p.ws + W_BAR), (volatile LAS unsigned*)&xb_words);
#ifndef REP_PH
#define REP_PH -1
#endif
#define RUN(PH) do { run_phase<PH>(p, lds); if (REP_PH == PH) { xcd_barrier(bar); run_phase<PH>(p, lds); } } while (0)
    RUN(0); xcd_barrier(bar);
    RUN(1); xcd_barrier(bar);
    RUN(2); xcd_barrier(bar);
    RUN(3); xcd_barrier(bar);
    RUN(4); xcd_barrier(bar);
    RUN(5); xcd_barrier(bar);
    RUN(6); xcd_barrier(bar);
    RUN(10); xcd_barrier(bar);
    RUN(11);
}
#endif

extern "C" void kernel_launch(void* const* d_in, const int* in_sizes, int n_in, void* d_out, int out_size, void* d_ws, size_t ws_size, hipStream_t stream) {
    static int grid_blocks = 0;
    if (!grid_blocks) {
        if (n_in != 24 || (size_t)out_size != O_END || ws_size < W_END) { fprintf(stderr, "kernel_launch: unexpected sizes n_in %d out %d (want %zu) ws %zu (want %zu)\n", n_in, out_size, (size_t)O_END, ws_size, (size_t)W_END); }
        int dev = 0, cus = 0;
        (void)hipGetDevice(&dev);
        (void)hipDeviceGetAttribute(&cus, hipDeviceAttributeMultiprocessorCount, dev);
#if !N_LAUNCH_SPLIT
        int per_cu = 0;
        (void)hipFuncSetAttribute((const void*)hymba_fwd, hipFuncAttributeMaxDynamicSharedMemorySize, LDS_TOTAL);
        (void)hipOccupancyMaxActiveBlocksPerMultiprocessor(&per_cu, (const void*)hymba_fwd, 512, LDS_TOTAL);
        if (per_cu < 1) fprintf(stderr, "kernel_launch: occupancy query returned %d\n", per_cu);
#endif
        grid_blocks = cus > 0 ? cus : 256;
    }
    Params p{};
    const float** pp = (const float**)&p;
    for (int i = 0; i < 24; ++i) pp[i] = (const float*)d_in[i];
    p.out = (float*)d_out; p.ws = (unsigned char*)d_ws;
#if N_LAUNCH_SPLIT
    launch_ph<0>(p, grid_blocks, stream); launch_ph<1>(p, grid_blocks, stream); launch_ph<2>(p, grid_blocks, stream); launch_ph<3>(p, grid_blocks, stream);
    launch_ph<4>(p, grid_blocks, stream); launch_ph<5>(p, grid_blocks, stream); launch_ph<6>(p, grid_blocks, stream);
    launch_ph<10>(p, grid_blocks, stream);
#else
    (void)hipMemsetAsync((char*)d_ws + W_BAR, 0, 32768, stream);
    void* args[] = {&p};
    hipError_t e = hipLaunchCooperativeKernel((void*)hymba_fwd, dim3(grid_blocks), dim3(512), args, LDS_TOTAL, stream);
    if (e != hipSuccess) fprintf(stderr, "cooperative launch failed: %s (grid %d)\n", hipGetErrorString(e), grid_blocks);
#endif
}
```

```cpp
#include <hip/hip_runtime.h>
#include <hip/hip_cooperative_groups.h>
#include <cstdint>
#include <cstdio>
namespace cg = cooperative_groups;

typedef unsigned short bf16_t;
typedef __attribute__((ext_vector_type(8))) short bf16x8;
typedef __attribute__((ext_vector_type(4))) short s16x4;
typedef __attribute__((ext_vector_type(4))) float f32x4;
typedef __attribute__((ext_vector_type(16))) float f32x16;
typedef __attribute__((ext_vector_type(4))) unsigned u32x4;
typedef __attribute__((ext_vector_type(2))) unsigned u32x2;
#define DEV __device__ __forceinline__

constexpr int TP = 16384, TS = 256, TA = TP + TS;
constexpr int DM = 1024, SEQ = 8192, DFF = 2816, NUP = 5632, INC = 3088;
constexpr float EPS = 1e-6f;
constexpr float LOG2E = 1.4426950408889634f;
constexpr float QSCALE = 0.125f * LOG2E;
constexpr int LDS_TOTAL = 135168;

constexpr size_t O_Y = 0;
constexpr size_t O_PK = (size_t)TA * 1024;
constexpr size_t O_PV = O_PK + (size_t)TP * 512;
constexpr size_t O_PLF = O_PV + (size_t)TP * 512;
constexpr size_t O_PSSD = O_PLF + (size_t)TP * 8;
constexpr size_t O_PSC = O_PSSD + 2 * 8 * 64 * 128;
constexpr size_t O_PFC = O_PSC + 2 * 3 * 1024;
constexpr size_t O_SK = O_PFC + 2 * 2 * 5632;
constexpr size_t O_SV = O_SK + (size_t)TS * 512;
constexpr size_t O_SLF = O_SV + (size_t)TS * 512;
constexpr size_t O_SSSD = O_SLF + (size_t)TS * 8;
constexpr size_t O_SSC = O_SSSD + 16 * 8 * 64 * 128;
constexpr size_t O_SFC = O_SSC + 16 * 3 * 1024;
constexpr size_t O_END = O_SFC + 16 * 2 * 5632;

constexpr size_t W_WIN = 0;
constexpr size_t W_WOUT = W_WIN + (size_t)3072 * 1024 * 2;
constexpr size_t W_WUP = W_WOUT + (size_t)1024 * 1024 * 2;
constexpr size_t W_WDN = W_WUP + (size_t)5632 * 1024 * 2;
constexpr size_t W_DT = W_WDN + (size_t)1024 * 2816 * 2;
constexpr size_t W_ACS = W_DT + (size_t)TA * 8 * 4;
constexpr size_t W_DEC = W_ACS + (size_t)TA * 8 * 4;
constexpr size_t W_G = W_DEC + (size_t)272 * 8 * 4;
constexpr size_t W_SS2 = W_G + (size_t)16 * 8192 * 4;
constexpr size_t W_SS3 = W_SS2 + (size_t)TA * 4;
constexpr size_t W_CSS = W_SS3 + (size_t)TA * 4;
constexpr size_t W_BAR = W_CSS + (size_t)16 * 65536 * 4;
constexpr size_t W_CNT = W_BAR + 16384;
constexpr size_t W_SATT = W_BAR + 32768;
constexpr size_t W_RA = (W_SATT + (size_t)256 * 512 * 2 + 255) / 256 * 256;
constexpr size_t SZ_RA = (size_t)TA * 1024 * 2;
constexpr size_t W_RB = W_RA + SZ_RA;
constexpr size_t W_Z = W_RB + SZ_RA;
constexpr size_t SZ_H = (size_t)TA * 512 * 2;
constexpr size_t W_Q = W_Z + SZ_H;
constexpr size_t W_K = W_Q + SZ_H;
constexpr size_t W_V = W_K + SZ_H;
constexpr size_t W_CG = W_V + SZ_H;
constexpr size_t W_U = W_RB;
constexpr size_t W_HALO = W_RB;
constexpr size_t SZ_U = (size_t)TA * 2816 * 2;
constexpr size_t W_ACT = W_V + SZ_H;
constexpr size_t W_END = W_ACT + SZ_U;
static_assert(W_U + SZ_U <= W_ACT, "U overlaps ACT");
static_assert(W_END <= (size_t)256 * 1024 * 1024, "workspace too large");

struct Params {
    const float* x_prompt; const float* x_sample; const float* cache_k; const float* cache_v; const float* cache_logf;
    const float* state_ssd; const float* state_ssd_conv; const float* state_ffn_conv; const float* norm1_g; const float* w_in;
    const float* ssd_conv_w; const float* ssd_conv_b; const float* ssd_dt_bias; const float* ssd_a_log; const float* ssd_d;
    const float* ssd_norm_g; const float* fox_f_bias; const float* w_out; const float* norm2_g; const float* w_up;
    const float* ffn_conv_w; const float* ffn_conv_b; const float* w_down; const float* final_norm_g;
    float* out; unsigned char* ws;
};

DEV unsigned cvtpk(float lo, float hi) { unsigned r; asm("v_cvt_pk_bf16_f32 %0, %1, %2" : "=v"(r) : "v"(lo), "v"(hi)); return r; }
DEV bf16_t f2bf(float f) { return (bf16_t)(cvtpk(f, 0.f) & 0xffffu); }
DEV float bf2f(bf16_t b) { return __uint_as_float(((unsigned)b) << 16); }
DEV float bflo(unsigned u) { return __uint_as_float(u << 16); }
DEV float bfhi(unsigned u) { return __uint_as_float(u & 0xffff0000u); }
DEV float silu_f(float x) { return x * __builtin_amdgcn_rcpf(1.f + __builtin_amdgcn_exp2f(x * -LOG2E)); }
DEV float softplus_f(float x) { return x > 20.f ? x : log1pf(expf(x)); }
DEV float wave_sum(float v) {
#pragma unroll
    for (int o = 32; o > 0; o >>= 1) v += __shfl_xor(v, o);
    return v;
}
DEV float wave_max(float v) {
#pragma unroll
    for (int o = 32; o > 0; o >>= 1) v = fmaxf(v, __shfl_xor(v, o));
    return v;
}
DEV int up_natcol(int r) { const int pn = r >> 8, i = r & 255; return i < 128 ? pn * 128 + i : DFF + pn * 128 + (i - 128); }

constexpr int BM = 256, BK = 64, HALF = 128, HT = HALF * BK;
DEV int lds_byte(int r, int c) { int st = (r >> 4) * 2 + (c >> 5), rr = r & 15, cc = c & 31, ob = rr * 64 + cc * 2; return st * 1024 + (ob ^ (((ob >> 9) & 1) << 5)); }
DEV void stage_rc(int b, int& R, int& C) { int st = b / 1024, sb = b % 1024, swz = sb ^ (((sb >> 9) & 1) << 5); R = (st >> 1) * 16 + swz / 64; C = (st & 1) * 32 + (swz % 64) / 2; }

struct NoPre { DEV void operator()(int, int) const {} };
template <class Epi, class Pre = NoPre>
DEV void gemm_phase(const bf16_t* __restrict__ A, const bf16_t* __restrict__ Bt, const int M, const int N, const int K, const Epi& epi, const Pre& pre = Pre()) {
    extern __shared__ __attribute__((aligned(16))) bf16_t shm[];
#define SA(b, h) (shm + ((b) * 2 + (h)) * HT)
#define SB(b, h) (shm + (4 + (b) * 2 + (h)) * HT)
#define STAGE(P, BASE, br, kt) do { const char* _gb = (const char*)(BASE + (long)(br) * K + (long)(kt) * BK); \
      __builtin_amdgcn_global_load_lds((const unsigned*)(_gb + so0), (unsigned*)((char*)(P) + tid16), 16, 0, 0); \
      __builtin_amdgcn_global_load_lds((const unsigned*)(_gb + so1), (unsigned*)((char*)(P) + tid16 + 8192), 16, 0, 0); } while (0)
#define LDA(dst, b, h) for (int m = 0; m < 4; ++m) for (int k = 0; k < 2; ++k) \
    dst[m][k] = *reinterpret_cast<const bf16x8*>((char*)SA(b, h) + lds_byte(wr * 64 + m * 16 + fr, k * 32 + fq * 8))
#define LDB(dst, b, h) for (int n = 0; n < 2; ++n) for (int k = 0; k < 2; ++k) \
    dst[n][k] = *reinterpret_cast<const bf16x8*>((char*)SB(b, h) + lds_byte(wc * 32 + n * 16 + fr, k * 32 + fq * 8))
#define MMA(ai, bj, At_, Bt_) do { __builtin_amdgcn_s_setprio(1); \
    for (int m = 0; m < 4; ++m) for (int n = 0; n < 2; ++n) for (int k = 0; k < 2; ++k) \
      acc[ai][bj][m][n] = __builtin_amdgcn_mfma_f32_16x16x32_bf16(Bt_[n][k], At_[m][k], acc[ai][bj][m][n], 0, 0, 0); \
    __builtin_amdgcn_s_setprio(0); } while (0)
#define WAIT_V(n) asm volatile("s_waitcnt vmcnt(" #n ")" ::: "memory")
#define WAIT_L(n) asm volatile("s_waitcnt lgkmcnt(" #n ")" ::: "memory")
#define BAR __builtin_amdgcn_s_barrier()
#define SCHED __builtin_amdgcn_sched_barrier(0)
    const int nM = M / BM, nN = N / BM, nwg = nM * nN;
    int tidg = threadIdx.x; asm volatile("" : "+v"(tidg));
    const int wid = tidg >> 6, lane = tidg & 63, wr = wid >> 2, wc = wid & 3, fr = lane & 15, fq = lane >> 4;
    const int nt = K / BK;
    const int tid16 = tidg * 16;
    unsigned so0, so1; { int r_, c_; stage_rc(tid16, r_, c_); so0 = (unsigned)(r_ * K + c_) * 2u; stage_rc(tid16 + 8192, r_, c_); so1 = (unsigned)(r_ * K + c_) * 2u; }
    for (int L = blockIdx.x; L < nwg; L += gridDim.x) {
        int wgid = L;
        { int q = nwg / 8, r = nwg % 8, xcd = wgid % 8, off = wgid / 8; wgid = (xcd < r ? xcd * (q + 1) : r * (q + 1) + (xcd - r) * q) + off; }
        const int nig = 8 * nN, gid = wgid / nig, fm = gid * 8, gsz = min(nM - fm, 8);
        const int pm = fm + ((wgid % nig) % gsz), pn = (wgid % nig) / gsz, brow = pm * BM, bcol = pn * BM;
        pre(pm, pn);
        f32x4 acc[2][2][4][2];
#pragma unroll
        for (int a = 0; a < 2; ++a)
#pragma unroll
            for (int b = 0; b < 2; ++b)
#pragma unroll
                for (int m = 0; m < 4; ++m)
#pragma unroll
                    for (int n = 0; n < 2; ++n) acc[a][b][m][n] = (f32x4){0.f, 0.f, 0.f, 0.f};
        bf16x8 At[4][2], B0[2][2], B1[2][2];
        STAGE(SB(0, 0), Bt, bcol, 0); STAGE(SA(0, 0), A, brow, 0);
        STAGE(SB(0, 1), Bt, bcol + HALF, 0); STAGE(SA(0, 1), A, brow + HALF, 0);
        if (wr == 1) BAR;
        WAIT_V(4); BAR;
        STAGE(SB(1, 0), Bt, bcol, 1); STAGE(SA(1, 0), A, brow, 1); STAGE(SB(1, 1), Bt, bcol + HALF, 1);
        WAIT_V(6); BAR;
        for (int t = 0; t < nt - 2; t += 2) {
            LDB(B0, 0, 0); SCHED; LDA(At, 0, 0); STAGE(SA(1, 1), A, brow + HALF, t + 1);
            WAIT_L(8); BAR; WAIT_L(0); MMA(0, 0, At, B0); BAR; SCHED;
            LDB(B1, 0, 1); STAGE(SB(0, 0), Bt, bcol, t + 2);
            BAR; WAIT_L(0); MMA(0, 1, At, B1); BAR;
            LDA(At, 0, 1); STAGE(SA(0, 0), A, brow, t + 2);
            BAR; WAIT_L(0); MMA(1, 0, At, B0); BAR; SCHED;
            STAGE(SB(0, 1), Bt, bcol + HALF, t + 2);
            WAIT_V(6); BAR; MMA(1, 1, At, B1); BAR;
            LDB(B0, 1, 0); SCHED; LDA(At, 1, 0); STAGE(SA(0, 1), A, brow + HALF, t + 2);
            WAIT_L(8); BAR; WAIT_L(0); MMA(0, 0, At, B0); BAR; SCHED;
            LDB(B1, 1, 1); STAGE(SB(1, 0), Bt, bcol, t + 3);
            BAR; WAIT_L(0); MMA(0, 1, At, B1); BAR;
            LDA(At, 1, 1); STAGE(SA(1, 0), A, brow, t + 3);
            BAR; WAIT_L(0); MMA(1, 0, At, B0); BAR; SCHED;
            STAGE(SB(1, 1), Bt, bcol + HALF, t + 3);
            WAIT_V(6); BAR; MMA(1, 1, At, B1); BAR;
        }
        { LDB(B0, 0, 0); LDA(At, 0, 0); STAGE(SA(1, 1), A, brow + HALF, nt - 1);
          BAR; WAIT_L(0); MMA(0, 0, At, B0); BAR;
          LDB(B1, 0, 1); BAR; WAIT_L(0); MMA(0, 1, At, B1); BAR;
          LDA(At, 0, 1); WAIT_V(4); BAR; WAIT_L(0); MMA(1, 0, At, B0); MMA(1, 1, At, B1); BAR; }
        { LDB(B0, 1, 0); LDA(At, 1, 0); WAIT_V(2); BAR; WAIT_L(0); MMA(0, 0, At, B0); BAR;
          LDB(B1, 1, 1); WAIT_V(0); BAR; WAIT_L(0); MMA(0, 1, At, B1); BAR;
          LDA(At, 1, 1); BAR; WAIT_L(0); MMA(1, 0, At, B0); MMA(1, 1, At, B1); BAR; }
        if (wr == 0) BAR;
        { int t2 = threadIdx.x; asm volatile("" : "+v"(t2)); const int w2 = t2 >> 6, l2 = t2 & 63; epi(acc, pm, pn, w2 >> 2, w2 & 3, l2 & 15, l2 >> 4); }
    }
#undef SA
#undef SB
#undef STAGE
#undef LDA
#undef LDB
#undef MMA
}

#define EPI_LOOP_BEGIN \
    _Pragma("unroll") for (int ai = 0; ai < 2; ++ai) _Pragma("unroll") for (int m = 0; m < 4; ++m) { \
        const int row = pm * BM + ai * HALF + wr * 64 + m * 16 + fr;
#define EPI_COLS_BEGIN \
        _Pragma("unroll") for (int bj = 0; bj < 2; ++bj) _Pragma("unroll") for (int n = 0; n < 2; ++n) { \
            const int col = pn * BM + bj * HALF + wc * 32 + n * 16 + fq * 4; const f32x4 v = acc[ai][bj][m][n];

struct EpiIn {
    bf16_t *Z, *XBC, *Q, *K, *V; float* out;
    DEV void operator()(const f32x4 (&acc)[2][2][4][2], int pm, int pn, int wr, int wc, int fr, int fq) const {
        EPI_LOOP_BEGIN
            const bool smp = row >= TP; const int rs = row - TP;
            EPI_COLS_BEGIN
                if (pn < 2) { *(u32x2*)(Z + (size_t)row * 512 + col) = (u32x2){cvtpk(v[0], v[1]), cvtpk(v[2], v[3])}; }
                else if (pn < 6) { const int c = col - 512; *(u32x2*)(XBC + (size_t)row * 1024 + c) = (u32x2){cvtpk(v[0], v[1]), cvtpk(v[2], v[3])};
                    if (!smp) { const int t = row & 8191; if (t >= 8189) *(f32x4*)(out + O_PSC + (size_t)((row >> 13) * 3 + (t - 8189)) * 1024 + c) = v; }
                    else { const int t = rs & 15; if (t >= 13) *(f32x4*)(out + O_SSC + (size_t)((rs >> 4) * 3 + (t - 13)) * 1024 + c) = v; } }
                else if (pn < 8) { const int c = col - 1536; *(u32x2*)(Q + (size_t)row * 512 + c) = (u32x2){cvtpk(v[0] * QSCALE, v[1] * QSCALE), cvtpk(v[2] * QSCALE, v[3] * QSCALE)}; }
                else if (pn < 10) { const int c = col - 2048; *(u32x2*)(K + (size_t)row * 512 + c) = (u32x2){cvtpk(v[0], v[1]), cvtpk(v[2], v[3])};
                    if (!smp) *(f32x4*)(out + O_PK + (size_t)row * 512 + c) = v; else *(f32x4*)(out + O_SK + (size_t)rs * 512 + c) = v; }
                else { const int c = col - 2560; *(u32x2*)(V + (size_t)row * 512 + c) = (u32x2){cvtpk(v[0], v[1]), cvtpk(v[2], v[3])};
                    if (!smp) *(f32x4*)(out + O_PV + (size_t)row * 512 + c) = v; else *(f32x4*)(out + O_SV + (size_t)rs * 512 + c) = v; }
            }
        }
    }
};

struct EpiOut {
    const float* xp; const float* xs; float* H; bf16_t* Hb; float* SS;
    DEV void operator()(const f32x4 (&acc)[2][2][4][2], int pm, int pn, int wr, int wc, int fr, int fq) const {
        EPI_LOOP_BEGIN
            const float* xr = row < TP ? xp + (size_t)row * 1024 : xs + (size_t)(row - TP) * 1024; float ss = 0.f;
            EPI_COLS_BEGIN
                const f32x4 h = v + *(const f32x4*)(xr + col);
                *(u32x2*)(Hb + (size_t)row * 1024 + col) = (u32x2){cvtpk(h[0], h[1]), cvtpk(h[2], h[3])};
                ss += h[0] * h[0] + h[1] * h[1] + h[2] * h[2] + h[3] * h[3];
            }
            ss += __shfl_xor(ss, 16); ss += __shfl_xor(ss, 32);
            if (fq == 0) atomicAdd(SS + row, ss);
        }
    }
};

struct EpiUp {
    const float* SS; bf16_t* U; float* out; int hf;
    DEV void operator()(const f32x4 (&acc)[2][2][4][2], int pm, int pn, int wr, int wc, int fr, int fq) const {
        EPI_LOOP_BEGIN
            const float rs = rsqrtf(SS[row] * (1.f / 1024.f) + EPS);
            float* st = nullptr;
            if (row < TP) { const int t = row & 8191; if (t >= 8190) st = out + O_PFC + (size_t)((row >> 13) * 2 + (t - 8190)) * NUP; }
            else { const int r2 = row - TP, t = r2 & 15; if (t >= 14) st = out + O_SFC + (size_t)((r2 >> 4) * 2 + (t - 14)) * NUP; }
            EPI_COLS_BEGIN
                const f32x4 u = v * rs;
                *(u32x2*)(U + (size_t)row * DFF + col) = (u32x2){cvtpk(u[0], u[1]), cvtpk(u[2], u[3])};
                if (st) *(f32x4*)(st + up_natcol(hf * DFF + col)) = u;
            }
        }
    }
};

constexpr int TPITCH = 528;
struct EpiUpFused {
    const float* SS; float* out; bf16_t* ACT; bf16_t* HALO; const float* cw; const float* cbias; const float* stf; char* lds;
    DEV void operator()(const f32x4 (&acc)[2][2][4][2], int pm, int pn, int wr, int wc, int fr, int fq) const {
        int tid = threadIdx.x; asm volatile("" : "+v"(tid));
        const int lc = (tid & 31) * 4, run = tid >> 5, ja = pn * 128 + lc; const bool smp = pm == 64;
        float wg[3][4], wv[3][4], bg[4], bv[4];
#pragma unroll
        for (int e = 0; e < 4; ++e) { bg[e] = cbias[ja + e]; bv[e] = cbias[DFF + ja + e];
#pragma unroll
            for (int j = 0; j < 3; ++j) { wg[j][e] = cw[j * NUP + ja + e]; wv[j][e] = cw[j * NUP + DFF + ja + e]; } }
        float ssq[8];
#pragma unroll
        for (int q = 0; q < 8; ++q) ssq[q] = SS[pm * BM + (q >> 2) * HALF + wr * 64 + (q & 3) * 16 + fr];
        EPI_LOOP_BEGIN
            const float rs = rsqrtf(ssq[ai * 4 + m] * (1.f / 1024.f) + EPS);
            float* st = nullptr;
            if (row < TP) { const int t = row & 8191; if (t >= 8190) st = out + O_PFC + (size_t)((row >> 13) * 2 + (t - 8190)) * NUP; }
            else { const int r2 = row - TP, t = r2 & 15; if (t >= 14) st = out + O_SFC + (size_t)((r2 >> 4) * 2 + (t - 14)) * NUP; }
            const int rl = row - pm * BM;
            EPI_COLS_BEGIN
                const f32x4 u = v * rs;
                *(u32x2*)(lds + rl * TPITCH + (col - pn * BM) * 2) = (u32x2){cvtpk(u[0], u[1]), cvtpk(u[2], u[3])};
                if (st) *(f32x4*)(st + up_natcol(col)) = u;
            }
        }
        __syncthreads();
        if (tid < 256) { const int r4 = tid >> 6, c = (tid & 63) * 4, rowl = r4 < 2 ? r4 : 252 + r4;
            *(u32x2*)(HALO + (size_t)(pm * 4 + r4) * NUP + pn * BM + c) = *(const u32x2*)(lds + rowl * TPITCH + c * 2); }
        auto ldrow = [&](int rowl, float* g, float* vv) { const u32x2 a = *(const u32x2*)(lds + rowl * TPITCH + lc * 2), c = *(const u32x2*)(lds + rowl * TPITCH + (128 + lc) * 2);
            g[0] = bflo(a[0]); g[1] = bfhi(a[0]); g[2] = bflo(a[1]); g[3] = bfhi(a[1]); vv[0] = bflo(c[0]); vv[1] = bfhi(c[0]); vv[2] = bflo(c[1]); vv[3] = bfhi(c[1]); };
        float g2[4], g1[4], v2[4], v1[4]; int rstart = 0;
        if (smp) { const float* s0 = stf + (size_t)(run * 2) * NUP, *s1 = s0 + NUP;
#pragma unroll
            for (int e = 0; e < 4; ++e) { g2[e] = s0[ja + e]; v2[e] = s0[DFF + ja + e]; g1[e] = s1[ja + e]; v1[e] = s1[DFF + ja + e]; } }
        else if (run == 0) { ldrow(0, g2, v2); ldrow(1, g1, v1); rstart = 2; }
        else { ldrow(16 * run - 2, g2, v2); ldrow(16 * run - 1, g1, v1); }
#pragma unroll 4
        for (int r = rstart; r < 16; ++r) { const int rowl = 16 * run + r; float g0[4], v0[4]; ldrow(rowl, g0, v0);
            float a[4];
#pragma unroll
            for (int e = 0; e < 4; ++e) { const float cg = bg[e] + wg[0][e] * g2[e] + wg[1][e] * g1[e] + wg[2][e] * g0[e], cv = bv[e] + wv[0][e] * v2[e] + wv[1][e] * v1[e] + wv[2][e] * v0[e];
                a[e] = silu_f(cg) * cv; g2[e] = g1[e]; g1[e] = g0[e]; v2[e] = v1[e]; v1[e] = v0[e]; }
            *(u32x2*)(ACT + (size_t)(pm * BM + rowl) * DFF + ja) = (u32x2){cvtpk(a[0], a[1]), cvtpk(a[2], a[3])}; }
        __syncthreads();
    }
};
struct FfnFixup { const Params* pp;
    DEV void operator()(int pm, int pn) const {
        const Params& p = *pp; unsigned char* ws = p.ws; const bf16_t* HALO = (const bf16_t*)(ws + W_HALO); bf16_t* ACT = (bf16_t*)(ws + W_ACT);
        if (pm >= 64) return;
        int tid = threadIdx.x; asm volatile("" : "+v"(tid));
        for (int it = tid; it < 2 * 352; it += 512) {
            const int cg8 = it % 352, rr = it / 352; const int ja = cg8 * 8, pc = (ja >> 7) * 256 + (ja & 127);
            const bool first = (pm & 31) == 0;
            float g[3][8], v[3][8];
            auto unpack = [&](const bf16_t* rowp, float* go, float* vo) { const u32x4 a = *(const u32x4*)(rowp + pc), c = *(const u32x4*)(rowp + pc + 128);
#pragma unroll
                for (int e = 0; e < 4; ++e) { go[2 * e] = bflo(a[e]); go[2 * e + 1] = bfhi(a[e]); vo[2 * e] = bflo(c[e]); vo[2 * e + 1] = bfhi(c[e]); } };
            auto zero = [&](float* go, float* vo) {
#pragma unroll
                for (int e = 0; e < 8; ++e) { go[e] = 0.f; vo[e] = 0.f; } };
            const bf16_t* mine = HALO + (size_t)(pm * 4) * NUP; const bf16_t* prev = HALO + (size_t)((pm - 1) * 4) * NUP;
            unpack(mine + (size_t)rr * NUP, g[2], v[2]);
            if (rr == 1) { unpack(mine, g[1], v[1]); if (first) zero(g[0], v[0]); else unpack(prev + (size_t)3 * NUP, g[0], v[0]); }
            else { if (first) { zero(g[1], v[1]); zero(g[0], v[0]); } else { unpack(prev + (size_t)3 * NUP, g[1], v[1]); unpack(prev + (size_t)2 * NUP, g[0], v[0]); } }
            u32x4 o;
#pragma unroll
            for (int e = 0; e < 4; ++e) { float a[2];
#pragma unroll
                for (int q = 0; q < 2; ++q) { const int i = 2 * e + q; float cg = p.ffn_conv_b[ja + i], cv = p.ffn_conv_b[DFF + ja + i];
#pragma unroll
                    for (int j = 0; j < 3; ++j) { cg += p.ffn_conv_w[j * NUP + ja + i] * g[j][i]; cv += p.ffn_conv_w[j * NUP + DFF + ja + i] * v[j][i]; }
                    a[q] = silu_f(cg) * cv; }
                o[e] = cvtpk(a[0], a[1]); }
            *(u32x4*)(ACT + (size_t)(pm * BM + rr) * DFF + ja) = o;
        }
        asm volatile("s_waitcnt vmcnt(0)" ::: "memory");
        __syncthreads();
    }
};

struct EpiDown {
    const bf16_t* Hb; float* SS; float* Ho;
    DEV void operator()(const f32x4 (&acc)[2][2][4][2], int pm, int pn, int wr, int wc, int fr, int fq) const {
        EPI_LOOP_BEGIN
            float ss = 0.f;
            EPI_COLS_BEGIN
                const size_t hoff = (size_t)row * 1024 + col;
                const u32x2 hb = *(const u32x2*)(Hb + hoff); const f32x4 h = v + (f32x4){bflo(hb[0]), bfhi(hb[0]), bflo(hb[1]), bfhi(hb[1])};
                *(f32x4*)(Ho + hoff) = h;
                ss += h[0] * h[0] + h[1] * h[1] + h[2] * h[2] + h[3] * h[3];
            }
            ss += __shfl_xor(ss, 16); ss += __shfl_xor(ss, 32);
            if (fq == 0) atomicAdd(SS + row, ss);
        }
    }
};

struct NoPost { DEV void operator()(int) const {} };
template <int NT = 1, class EpiE, class Post = NoPost>
DEV void sample_gemm(const bf16_t* __restrict__ A, const bf16_t* __restrict__ Bt, const int N, const int K, const EpiE& epi, char* lds, const Post& post = Post()) {
    int tid = threadIdx.x; asm volatile("" : "+v"(tid));
    const int lane = tid & 63, wid = tid >> 6, fr = lane & 15, fq = lane >> 4;
    constexpr int TW = 32 * NT;
    float* red = (float*)lds;
    const int ntile = 8 * (N / TW), kw = K / 8;
    for (int mt = blockIdx.x; mt < ntile; mt += gridDim.x) {
        const int r0 = (mt & 7) * 32, c0 = (mt >> 3) * TW;
        f32x4 acc[2][2 * NT];
#pragma unroll
        for (int i = 0; i < 2; ++i)
#pragma unroll
            for (int j = 0; j < 2 * NT; ++j) acc[i][j] = (f32x4){0.f, 0.f, 0.f, 0.f};
        const bf16_t* Ap = A + (size_t)(TP + r0 + fr) * K + wid * kw + fq * 8;
        const bf16_t* Bp = Bt + (size_t)(c0 + fr) * K + wid * kw + fq * 8;
#pragma unroll
        for (int ks = 0; ks < kw; ks += 32) {
            const bf16x8 a0 = *(const bf16x8*)(Ap + ks), a1 = *(const bf16x8*)(Ap + (size_t)16 * K + ks);
#pragma unroll
            for (int j = 0; j < 2 * NT; ++j) { const bf16x8 bj = *(const bf16x8*)(Bp + (size_t)(16 * j) * K + ks);
                acc[0][j] = __builtin_amdgcn_mfma_f32_16x16x32_bf16(bj, a0, acc[0][j], 0, 0, 0); acc[1][j] = __builtin_amdgcn_mfma_f32_16x16x32_bf16(bj, a1, acc[1][j], 0, 0, 0); }
        }
#pragma unroll
        for (int i = 0; i < 2; ++i)
#pragma unroll
            for (int j = 0; j < 2 * NT; ++j) *(f32x4*)(red + wid * (32 * TW) + (16 * i + fr) * TW + 16 * j + 4 * fq) = acc[i][j];
        __syncthreads();
#pragma unroll
        for (int q = 0; q < NT; ++q) { const int idx = tid + 512 * q, row = idx / (TW / 2), col = (idx % (TW / 2)) * 2; float v0 = 0.f, v1 = 0.f;
#pragma unroll
            for (int w = 0; w < 8; ++w) { const float2 t = *(const float2*)(red + w * (32 * TW) + row * TW + col); v0 += t.x; v1 += t.y; }
            epi(TP + r0 + row, c0 + col, v0, v1, lane); }
        __syncthreads();
        post(mt);
    }
}
struct EpiInE { bf16_t *Z, *XBC, *Q, *K, *V; float* out;
    DEV void operator()(int row, int col, float v0, float v1, int lane) const { const int rs = row - TP;
        if (col < 512) *(unsigned*)(Z + (size_t)row * 512 + col) = cvtpk(v0, v1);
        else if (col < 1536) { const int c = col - 512; *(unsigned*)(XBC + (size_t)row * 1024 + c) = cvtpk(v0, v1); const int t = rs & 15;
            if (t >= 13) *(float2*)(out + O_SSC + (size_t)((rs >> 4) * 3 + (t - 13)) * 1024 + c) = make_float2(v0, v1); }
        else if (col < 2048) *(unsigned*)(Q + (size_t)row * 512 + col - 1536) = cvtpk(v0 * QSCALE, v1 * QSCALE);
        else if (col < 2560) { const int c = col - 2048; *(unsigned*)(K + (size_t)row * 512 + c) = cvtpk(v0, v1); *(float2*)(out + O_SK + (size_t)rs * 512 + c) = make_float2(v0, v1); }
        else { const int c = col - 2560; *(unsigned*)(V + (size_t)row * 512 + c) = cvtpk(v0, v1); *(float2*)(out + O_SV + (size_t)rs * 512 + c) = make_float2(v0, v1); } } };
struct EpiResE { const float* res; const bf16_t* resb; float* H; bf16_t* Hb; float* SS;
    DEV void operator()(int row, int col, float v0, float v1, int lane) const {
        float h0, h1; if (res) { const float2 r = *(const float2*)(res + (size_t)row * 1024 + col); h0 = r.x + v0; h1 = r.y + v1; } else { const unsigned r = *(const unsigned*)(resb + (size_t)row * 1024 + col); h0 = bflo(r) + v0; h1 = bfhi(r) + v1; }
        if (H) *(float2*)(H + (size_t)row * 1024 + col) = make_float2(h0, h1);
        if (Hb) *(unsigned*)(Hb + (size_t)row * 1024 + col) = cvtpk(h0, h1);
        float ss = h0 * h0 + h1 * h1; ss += __shfl_xor(ss, 1); ss += __shfl_xor(ss, 2); ss += __shfl_xor(ss, 4); ss += __shfl_xor(ss, 8);
        if ((lane & 15) == 0) atomicAdd(SS + row, ss); } };

DEV float reduce16(float (&a)[16], int lane) {
    { const bool hi = lane & 32;
#pragma unroll
      for (int i = 0; i < 8; ++i) { const float send = hi ? a[i] : a[i + 8]; const float keep = hi ? a[i + 8] : a[i]; a[i] = keep + __shfl_xor(send, 32); } }
    { const bool hi = lane & 16;
#pragma unroll
      for (int i = 0; i < 4; ++i) { const float send = hi ? a[i] : a[i + 4]; const float keep = hi ? a[i + 4] : a[i]; a[i] = keep + __shfl_xor(send, 16); } }
    { const bool hi = lane & 8;
#pragma unroll
      for (int i = 0; i < 2; ++i) { const float send = hi ? a[i] : a[i + 2]; const float keep = hi ? a[i + 2] : a[i]; a[i] = keep + __shfl_xor(send, 8); } }
    { const bool hi = lane & 4; const float send = hi ? a[0] : a[1]; const float keep = hi ? a[1] : a[0]; a[0] = keep + __shfl_xor(send, 4); }
    a[0] += __shfl_xor(a[0], 2); a[0] += __shfl_xor(a[0], 1);
    return a[0];
}

template <class CS>
DEV void transpose4(const float* __restrict__ W, int ldw, int k0, const CS& cs, bf16_t* __restrict__ WT, int ldt, int r0, const float* __restrict__ gk, float* tile) {
    int tid = threadIdx.x; asm volatile("" : "+v"(tid));
    float v[4][8];
#pragma unroll
    for (int s = 0; s < 4; ++s) { const int c0 = cs(s);
#pragma unroll
        for (int e = 0; e < 8; ++e) { const int idx = tid + e * 512, j = idx >> 6, i = idx & 63; v[s][e] = W[(size_t)(k0 + j) * ldw + c0 + i]; } }
#pragma unroll
    for (int e = 0; e < 8; ++e) { const int idx = tid + e * 512, j = idx >> 6, i = idx & 63; const float g = gk ? gk[k0 + j] : 1.f;
#pragma unroll
        for (int s = 0; s < 4; ++s) tile[s * 4160 + j * 65 + i] = v[s][e] * g; }
    __syncthreads();
#pragma unroll
    for (int s = 0; s < 4; ++s)
#pragma unroll
        for (int e = 0; e < 4; ++e) { const int idx = tid + e * 512, i = idx >> 5, j2 = (idx & 31) * 2;
            *(unsigned*)(WT + (size_t)(r0 + 64 * s + i) * ldt + k0 + j2) = cvtpk(tile[s * 4160 + j2 * 65 + i], tile[s * 4160 + (j2 + 1) * 65 + i]); }
    __syncthreads();
}

DEV void weight_unit(const Params& p, int u, float* tile) {
    unsigned char* ws = p.ws;
    if (u < 192) { const int kt = u & 15, nb = u >> 4; const int r0 = nb * 256; const int c0 = r0 < 1536 ? r0 : r0 + 8;
        transpose4(p.w_in, INC, kt * 64, [&](int s) { return c0 + 64 * s; }, (bf16_t*)(ws + W_WIN), 1024, r0, nullptr, tile); }
    else if (u < 256) { const int v = u - 192, kt = v & 15, nb = v >> 4;
        transpose4(p.w_out, 1024, kt * 64, [&](int s) { return nb * 256 + 64 * s; }, (bf16_t*)(ws + W_WOUT), 1024, nb * 256, nullptr, tile); }
    else if (u < 608) { const int v = u - 256, kt = v & 15, nb = v >> 4;
        transpose4(p.w_up, NUP, kt * 64, [&](int s) { return up_natcol(nb * 256 + 64 * s); }, (bf16_t*)(ws + W_WUP), 1024, nb * 256, p.norm2_g, tile); }
    else { const int v = u - 608, kt = v % 44, nb = v / 44;
        transpose4(p.w_down, 1024, kt * 64, [&](int s) { return nb * 256 + 64 * s; }, (bf16_t*)(ws + W_WDN), DFF, nb * 256, nullptr, tile); }
}
DEV void weight_units_on_idle(const Params& p, int u0, int u1, int lo_want, char* lds) {
    const int lo = (int)gridDim.x > lo_want + 32 ? lo_want : 0;
    if ((int)blockIdx.x >= lo) for (int u = u0 + (int)blockIdx.x - lo; u < u1; u += (int)gridDim.x - lo) weight_unit(p, u, (float*)lds);
}

DEV void phase0(const Params& p, char* lds) {
    unsigned char* ws = p.ws;
    const int tid = threadIdx.x, lane = tid & 63, wid = tid >> 6;
    float* tile = (float*)lds;
    float* thin = (float*)(lds + 32768);
    for (int u = blockIdx.x; u < 192; u += gridDim.x) weight_unit(p, u, tile);
    for (int idx = tid; idx < 4096; idx += 512) { const int k = idx >> 2, part = idx & 3; const f32x4 v = *(const f32x4*)(p.w_in + (size_t)k * INC + (part < 2 ? 1536 + 4 * part : 3080 + 4 * (part - 2)));
        thin[(4 * part) * 1024 + k] = v[0]; thin[(4 * part + 1) * 1024 + k] = v[1]; thin[(4 * part + 2) * 1024 + k] = v[2]; thin[(4 * part + 3) * 1024 + k] = v[3]; }
    for (int i = blockIdx.x * 512 + tid; i < 2 * TA; i += gridDim.x * 512) ((float*)(ws + W_SS2))[i] = 0.f;
    __syncthreads();
    bf16_t* XN = (bf16_t*)(ws + W_RA); float* DT = (float*)(ws + W_DT);
    const int rstep = gridDim.x * 8;
    f32x4 gq[4];
#pragma unroll
    for (int i = 0; i < 4; ++i) gq[i] = *(const f32x4*)(p.norm1_g + i * 256 + lane * 4);
    for (int row0 = blockIdx.x * 8 + wid; row0 < TA; row0 += 2 * rstep) {
        const bool two = row0 + rstep < TA;
        f32x4 x[2][4]; float ss[2] = {0.f, 0.f};
#pragma unroll
        for (int rr = 0; rr < 2; ++rr) { const int row = (rr == 0 || two) ? row0 + rr * rstep : row0;
            const float* xr = row < TP ? p.x_prompt + (size_t)row * 1024 : p.x_sample + (size_t)(row - TP) * 1024;
#pragma unroll
            for (int i = 0; i < 4; ++i) { x[rr][i] = *(const f32x4*)(xr + i * 256 + lane * 4); ss[rr] += x[rr][i][0] * x[rr][i][0] + x[rr][i][1] * x[rr][i][1] + x[rr][i][2] * x[rr][i][2] + x[rr][i][3] * x[rr][i][3]; } }
#pragma unroll
        for (int rr = 0; rr < 2; ++rr) { const int row = row0 + rr * rstep; ss[rr] = wave_sum(ss[rr]); const float rs = rsqrtf(ss[rr] * (1.f / 1024.f) + EPS);
#pragma unroll
            for (int i = 0; i < 4; ++i) { x[rr][i] = x[rr][i] * rs * gq[i];
                if (rr == 0 || two) *(u32x2*)(XN + (size_t)row * 1024 + i * 256 + lane * 4) = (u32x2){cvtpk(x[rr][i][0], x[rr][i][1]), cvtpk(x[rr][i][2], x[rr][i][3])}; } }
        float pa0[16], pa1[16];
#pragma unroll
        for (int j = 0; j < 16; ++j) { float a0 = 0.f, a1 = 0.f;
#pragma unroll
            for (int i = 0; i < 4; ++i) { const f32x4 w = *(const f32x4*)(thin + j * 1024 + i * 256 + lane * 4);
                a0 += x[0][i][0] * w[0] + x[0][i][1] * w[1] + x[0][i][2] * w[2] + x[0][i][3] * w[3]; a1 += x[1][i][0] * w[0] + x[1][i][1] * w[1] + x[1][i][2] * w[2] + x[1][i][3] * w[3]; }
            pa0[j] = a0; pa1[j] = a1; }
        const int jj = (lane >> 2) & 15;
        const float m0 = reduce16(pa0, lane), m1 = reduce16(pa1, lane);
#pragma unroll
        for (int rr = 0; rr < 2; ++rr) { const int row = row0 + rr * rstep; const float mine = rr ? m1 : m0;
            if ((rr == 0 || two) && (lane & 3) == 0) {
                if (jj < 8) { DT[(size_t)row * 8 + jj] = softplus_f(mine + p.ssd_dt_bias[jj]); }
                else { const int h = jj - 8; const float lf = -softplus_f(-(mine + p.fox_f_bias[h]));
                    if (row < TP) p.out[O_PLF + (size_t)row * 8 + h] = lf; else p.out[O_SLF + (size_t)(row - TP) * 8 + h] = lf; } } }
    }
}

DEV void cumsum_prompt_unit(const Params& p, int b, char* lds) {
    int tid = threadIdx.x; asm volatile("" : "+v"(tid)); const int lane = tid & 63, wid = tid >> 6;
    constexpr int PITCH = 2308;
    float* buf = (float*)lds;
    const float* lf = p.out + O_PLF + (size_t)b * SEQ * 8;
    float* G = (float*)(p.ws + W_G) + ((size_t)b * 8 + wid) * SEQ;
    float carry = 0.f;
    for (int q = 0; q < 4; ++q) { const int t0 = q * 2048;
#pragma unroll
        for (int i = 0; i < 8; ++i) { const int idx = tid + 512 * i, t = idx >> 1, hh = (idx & 1) * 4; const f32x4 v = *(const f32x4*)(lf + (size_t)(t0 + t) * 8 + hh);
            const int o = t + 4 * (t >> 5);
            buf[hh * PITCH + o] = v[0]; buf[(hh + 1) * PITCH + o] = v[1]; buf[(hh + 2) * PITCH + o] = v[2]; buf[(hh + 3) * PITCH + o] = v[3]; }
        __syncthreads();
        float* seg = buf + wid * PITCH + 36 * lane; f32x4 v[8]; float run = 0.f;
#pragma unroll
        for (int j = 0; j < 8; ++j) { v[j] = *(const f32x4*)(seg + 4 * j); v[j][0] += run; v[j][1] += v[j][0]; v[j][2] += v[j][1]; v[j][3] += v[j][2]; run = v[j][3]; }
        float sc = run;
#pragma unroll
        for (int o = 1; o < 64; o <<= 1) { const float t = __shfl_up(sc, o); if (lane >= o) sc += t; }
        const float pre = carry + sc - run;
#pragma unroll
        for (int j = 0; j < 8; ++j) { v[j] = (v[j] + pre) * (-LOG2E); *(f32x4*)(seg + 4 * j) = v[j]; }
        carry += __shfl(sc, 63);
        __syncthreads();
#pragma unroll
        for (int j = 0; j < 8; ++j) { const int t = 4 * (lane + 64 * j); *(f32x4*)(G + t0 + t) = *(const f32x4*)(buf + wid * PITCH + t + 4 * (t >> 5)); }
        __syncthreads();
    }
}

DEV void sample_attn_unit(const Params& p, int b, int h, char* lds) {
    int tid = threadIdx.x; asm volatile("" : "+v"(tid)); const int lane = tid & 63, wid = tid >> 6, fr = lane & 15, fq = lane >> 4;
    float* bl = (float*)lds;
    float* red = (float*)(lds + 8448);
    float* red2 = (float*)(lds + 8960);
    float* stat = (float*)(lds + 9472);
    float* ored = (float*)(lds + 16384);
    const bf16_t* Q = (const bf16_t*)(p.ws + W_Q);
    const float* clf = p.cache_logf + (size_t)b * 2048 * 8 + h;
    { float v4[4]; float run = 0.f;
#pragma unroll
      for (int i = 0; i < 4; ++i) { run += clf[(size_t)(tid * 4 + i) * 8]; v4[i] = run; }
      float v = run;
#pragma unroll
      for (int o = 1; o < 64; o <<= 1) { const float t = __shfl_up(v, o); if (lane >= o) v += t; }
      if (lane == 63) red[wid] = v;
      __syncthreads();
      float add = v - run; for (int w = 0; w < wid; ++w) add += red[w];
#pragma unroll
      for (int i = 0; i < 4; ++i) bl[tid * 4 + i] = -(add + v4[i]) * LOG2E;
      if (tid == 511) { float f = add + run; for (int i = 0; i < 16; ++i) { f += p.out[O_SLF + (size_t)(b * 16 + i) * 8 + h]; bl[2048 + i] = -f * LOG2E; } }
      __syncthreads(); }
    bf16x8 qf[2];
#pragma unroll
    for (int k = 0; k < 2; ++k) qf[k] = *(const bf16x8*)(Q + (size_t)(TP + b * 16 + fr) * 512 + h * 64 + k * 32 + fq * 8);
    f32x4 sc[17];
#pragma unroll
    for (int i = 0; i < 17; ++i) { const int kt = wid + 8 * i; f32x4 c = (f32x4){-INFINITY, -INFINITY, -INFINITY, -INFINITY};
        if (kt < 129) {
            const float* kr = kt < 128 ? p.cache_k + ((size_t)(b * 2048 + kt * 16 + fr) * 8 + h) * 64 : p.out + O_SK + ((size_t)(b * 16 + fr) * 8 + h) * 64;
            c = *(const f32x4*)(bl + kt * 16 + fq * 4);
#pragma unroll
            for (int k = 0; k < 2; ++k) { const f32x4 a0 = *(const f32x4*)(kr + k * 32 + fq * 8), a1 = *(const f32x4*)(kr + k * 32 + fq * 8 + 4);
                const u32x4 av = (u32x4){cvtpk(a0[0], a0[1]), cvtpk(a0[2], a0[3]), cvtpk(a1[0], a1[1]), cvtpk(a1[2], a1[3])};
                c = __builtin_amdgcn_mfma_f32_16x16x32_bf16(__builtin_bit_cast(bf16x8, av), qf[k], c, 0, 0, 0); }
            if (kt == 128) {
#pragma unroll
                for (int j = 0; j < 4; ++j) if (fq * 4 + j > fr) c[j] = -INFINITY; }
        }
        sc[i] = c; }
    float m = -INFINITY;
#pragma unroll
    for (int i = 0; i < 17; ++i) m = fmaxf(m, fmaxf(fmaxf(sc[i][0], sc[i][1]), fmaxf(sc[i][2], sc[i][3])));
    m = fmaxf(m, __shfl_xor(m, 16)); m = fmaxf(m, __shfl_xor(m, 32));
    if (fq == 0) red[wid * 16 + fr] = m;
    __syncthreads();
    m = red[fr];
#pragma unroll
    for (int w = 1; w < 8; ++w) m = fmaxf(m, red[w * 16 + fr]);
    float l = 0.f;
#pragma unroll
    for (int i = 0; i < 17; ++i) {
#pragma unroll
        for (int j = 0; j < 4; ++j) { sc[i][j] = exp2f(sc[i][j] - m); l += sc[i][j]; } }
    l += __shfl_xor(l, 16); l += __shfl_xor(l, 32);
    if (fq == 0) red2[wid * 16 + fr] = l;
    __syncthreads();
    if (tid < 16) { float a = 0.f; for (int w = 0; w < 8; ++w) a += red2[w * 16 + tid]; stat[tid] = a; }
    f32x4 oT[4];
#pragma unroll
    for (int dt = 0; dt < 4; ++dt) oT[dt] = (f32x4){0.f, 0.f, 0.f, 0.f};
#pragma unroll
    for (int ii = 0; ii < 9; ++ii) { const int ktA = wid + 16 * ii, ktB = ktA + 8;
        if (ktA < 129) {
            const f32x4 sA = sc[2 * ii]; f32x4 sB = (f32x4){0.f, 0.f, 0.f, 0.f}; if (2 * ii + 1 < 17) sB = sc[(2 * ii + 1 < 17) ? 2 * ii + 1 : 0];
            const bool vB = ktB < 129;
            const u32x4 bv = (u32x4){cvtpk(sA[0], sA[1]), cvtpk(sA[2], sA[3]), vB ? cvtpk(sB[0], sB[1]) : 0u, vB ? cvtpk(sB[2], sB[3]) : 0u};
            const int keyA = ktA * 16 + fq * 4, keyB = ktB * 16 + fq * 4;
            const float* vA = keyA < 2048 ? p.cache_v + ((size_t)(b * 2048 + keyA) * 8 + h) * 64 : p.out + O_SV + ((size_t)(b * 16 + keyA - 2048) * 8 + h) * 64;
            const float* vBp = keyB < 2048 ? p.cache_v + ((size_t)(b * 2048 + keyB) * 8 + h) * 64 : p.out + O_SV + ((size_t)(b * 16 + (keyB - 2048)) * 8 + h) * 64;
#pragma unroll
            for (int dt = 0; dt < 4; ++dt) { float va[8];
#pragma unroll
                for (int e = 0; e < 4; ++e) { va[e] = vA[(size_t)e * 512 + dt * 16 + fr]; va[4 + e] = vB ? vBp[(size_t)e * 512 + dt * 16 + fr] : 0.f; }
                const u32x4 av = (u32x4){cvtpk(va[0], va[1]), cvtpk(va[2], va[3]), cvtpk(va[4], va[5]), cvtpk(va[6], va[7])};
                oT[dt] = __builtin_amdgcn_mfma_f32_16x16x32_bf16(__builtin_bit_cast(bf16x8, av), __builtin_bit_cast(bf16x8, bv), oT[dt], 0, 0, 0); }
        } }
#pragma unroll
    for (int dt = 0; dt < 4; ++dt) *(f32x4*)(ored + (wid * 16 + fr) * 64 + dt * 16 + fq * 4) = oT[dt];
    __syncthreads();
    bf16_t* SATT = (bf16_t*)(p.ws + W_SATT);
    for (int idx = tid; idx < 1024; idx += 512) { const int qi = idx >> 6, d = idx & 63; float a = 0.f;
#pragma unroll
        for (int w = 0; w < 8; ++w) a += ored[(w * 16 + qi) * 64 + d];
        SATT[(size_t)(b * 16 + qi) * 512 + h * 64 + d] = f2bf(a / stat[qi]); }
    __syncthreads();
}

struct SsdSrc { bool smp; int b, c, g; };
DEV SsdSrc ssd_decode(int u) { SsdSrc s; if (u < 512) { s.smp = false; s.b = u >> 8; s.c = (u >> 1) & 127; s.g = u & 1; } else { const int v = u - 512; s.smp = true; s.b = v >> 1; s.c = 0; s.g = v & 1; } return s; }
DEV int ssd_token(const SsdSrc& s, int l) { if (!s.smp) return s.b * SEQ + s.c * 64 + l; return l >= 48 ? TP + s.b * 16 + (l - 48) : -1; }
typedef __attribute__((address_space(3))) char* ldsp_t;

constexpr int L_ACS = 0, L_DT = 1024, L_RDT = 2048, L_TE = 3072, L_BM = 4096, L_CM = L_BM + 17408, L_BT = L_CM + 17408, L_XT = L_BT + 18432, L_XTE = L_XT + 36864;
static_assert(L_XTE + 36864 <= LDS_TOTAL, "ssd lds");

DEV void ssd_chunk_unit(const Params& p, int u, char* lds) {
    const SsdSrc s = ssd_decode(u);
    int tid = threadIdx.x; asm volatile("" : "+v"(tid)); const int lane = tid & 63, wid = tid >> 6, fr = lane & 15, fq = lane >> 4;
    unsigned char* ws = p.ws;
    const bf16_t* XBC = (const bf16_t*)(ws + W_RB); const float* DT = (const float*)(ws + W_DT);
    float* acs_l = (float*)(lds + L_ACS); float* dt_l = (float*)(lds + L_DT); float* rdt_l = (float*)(lds + L_RDT); float* te_l = (float*)(lds + L_TE);
    bf16_t* Bm = (bf16_t*)(lds + L_BM); bf16_t* Cm = (bf16_t*)(lds + L_CM); bf16_t* BTl = (bf16_t*)(lds + L_BT); bf16_t* XT = (bf16_t*)(lds + L_XT); bf16_t* XTE = (bf16_t*)(lds + L_XTE);
    const int uidx = s.smp ? 256 + s.b : s.b * 128 + s.c;
    int col, role, li; if (tid < 256) { role = 0; li = tid; col = s.g * 256 + tid; } else if (tid < 384) { role = 1; li = tid - 256; col = 512 + s.g * 128 + li; } else { role = 2; li = tid - 384; col = 768 + s.g * 128 + li; }
    const bf16_t* xcol = XBC + (size_t)(s.smp ? TP + s.b * 16 - 48 : s.b * SEQ + s.c * 64) * 1024 + col;
    const float* scol = p.state_ssd_conv + (size_t)(s.b * 3) * 1024 + col;
    auto ldb = [&](int lb, float* o) {
        if (!s.smp) {
#pragma unroll
            for (int i = 0; i < 16; ++i) o[i] = bf2f(xcol[(size_t)(lb + i) * 1024]); }
        else {
#pragma unroll
            for (int i = 0; i < 16; ++i) { const int l = lb + i; o[i] = l >= 48 ? bf2f(xcol[(size_t)l * 1024]) : (l >= 45 ? scol[(size_t)(l - 45) * 1024] : 0.f); } } };
    float x3, x2, x1;
    if (!s.smp) { const bool has = s.c > 0; const bf16_t* xh = has ? xcol : xcol + 3 * 1024;
        const float a = bf2f(xh[-3 * 1024]), bb = bf2f(xh[-2 * 1024]), cc = bf2f(xh[-1 * 1024]); x3 = has ? a : 0.f; x2 = has ? bb : 0.f; x1 = has ? cc : 0.f; }
    else { x3 = 0.f; x2 = 0.f; x1 = 0.f; }
    float xv[16]; ldb(0, xv);
    const float w0 = p.ssd_conv_w[col], w1 = p.ssd_conv_w[1024 + col], w2 = p.ssd_conv_w[2048 + col], w3 = p.ssd_conv_w[3072 + col], cb = p.ssd_conv_b[col];
    if (wid < 4) { const int h = s.g * 4 + wid; const int tok = ssd_token(s, lane);
        const float dt = tok >= 0 ? DT[(size_t)tok * 8 + h] : 0.f; const float a = -expf(p.ssd_a_log[h]);
        float v = dt * a;
#pragma unroll
        for (int o = 1; o < 64; o <<= 1) { const float t = __shfl_up(v, o); if (lane >= o) v += t; }
        const float tot = __shfl(v, 63);
        acs_l[wid * 64 + lane] = v; dt_l[wid * 64 + lane] = dt; rdt_l[wid * 64 + lane] = dt > 0.f ? 1.f / dt : 0.f; te_l[wid * 64 + lane] = expf(tot - v);
        if (tok >= 0) ((float*)(ws + W_ACS))[(size_t)tok * 8 + h] = v;
        if (lane == 63) ((float*)(ws + W_DEC))[uidx * 8 + h] = expf(tot); }
    __syncthreads();
    { const int hl = li >> 6, pp = li & 63;
      bf16_t* CG = (bf16_t*)(ws + W_CG);
#pragma unroll
      for (int lb = 0; lb < 64; lb += 16) { float xn[16];
        if (lb + 16 < 64) ldb(lb + 16, xn);
        float vv[16];
#pragma unroll
        for (int i = 0; i < 16; ++i) { const float x0 = xv[i]; const float y = cb + w0 * x3 + w1 * x2 + w2 * x1 + w3 * x0; x3 = x2; x2 = x1; x1 = x0; vv[i] = silu_f(y); }
        if (role == 0) {
#pragma unroll
            for (int i8 = 0; i8 < 16; i8 += 8) { u32x4 a, b;
#pragma unroll
                for (int q = 0; q < 4; ++q) { const int i = i8 + 2 * q, l = lb + i; const float xd0 = vv[i] * dt_l[hl * 64 + l], xd1 = vv[i + 1] * dt_l[hl * 64 + l + 1];
                    a[q] = cvtpk(xd0, xd1); b[q] = cvtpk(xd0 * te_l[hl * 64 + l], xd1 * te_l[hl * 64 + l + 1]); }
                *(u32x4*)(XT + (hl * 64 + pp) * 72 + lb + i8) = a; *(u32x4*)(XTE + (hl * 64 + pp) * 72 + lb + i8) = b; } }
        else if (role == 1) {
#pragma unroll
            for (int i8 = 0; i8 < 16; i8 += 8) { u32x4 a;
#pragma unroll
                for (int q = 0; q < 4; ++q) { const int i = i8 + 2 * q, l = lb + i; const unsigned pk = cvtpk(vv[i], vv[i + 1]); a[q] = pk;
                    Bm[l * 136 + li] = (bf16_t)(pk & 0xffffu); Bm[(l + 1) * 136 + li] = (bf16_t)(pk >> 16); }
                *(u32x4*)(BTl + li * 72 + lb + i8) = a; } }
        else {
#pragma unroll
            for (int i = 0; i < 16; ++i) { const int l = lb + i; const bf16_t bv = f2bf(vv[i]); Cm[l * 136 + li] = bv; const int tok = ssd_token(s, l); if (tok >= 0) CG[(size_t)tok * 256 + s.g * 128 + li] = bv; } }
        if (lb + 16 < 64) {
#pragma unroll
            for (int i = 0; i < 16; ++i) xv[i] = xn[i]; } } }
    __syncthreads();
    const int hl = wid >> 1, half = wid & 1, h = s.g * 4 + hl; const float dsk = p.ssd_d[h];
    bf16_t* YD = (bf16_t*)(ws + W_RA);
    const bf16_t* XTh = XT + hl * 64 * 72; const bf16_t* XTEh = XTE + hl * 64 * 72;
#pragma unroll
    for (int lti = 0; lti < 2; ++lti) { const int lt = half * 2 + lti; const int l = lt * 16 + fr; const float acl = acs_l[hl * 64 + l];
        u32x2 pk[4];
#pragma unroll
        for (int st = 0; st < 4; ++st) { pk[st] = (u32x2){0u, 0u};
            if (st <= lt) { f32x4 c = (f32x4){0.f, 0.f, 0.f, 0.f};
#pragma unroll
                for (int k = 0; k < 4; ++k) { const bf16x8 a = *(const bf16x8*)(Bm + (st * 16 + fr) * 136 + k * 32 + fq * 8), bb = *(const bf16x8*)(Cm + l * 136 + k * 32 + fq * 8);
                    c = __builtin_amdgcn_mfma_f32_16x16x32_bf16(a, bb, c, 0, 0, 0); }
                float e[4];
#pragma unroll
                for (int j = 0; j < 4; ++j) { const int sp = st * 16 + fq * 4 + j; e[j] = (l >= sp) ? c[j] * __expf(acl - acs_l[hl * 64 + sp]) : 0.f; }
                pk[st] = (u32x2){cvtpk(e[0], e[1]), cvtpk(e[2], e[3])}; } }
        const int tok = ssd_token(s, l);
#pragma unroll
        for (int pt = 0; pt < 4; ++pt) { f32x4 y = (f32x4){0.f, 0.f, 0.f, 0.f};
#pragma unroll
            for (int i = 0; i < 2; ++i) { if (2 * i <= lt) {
                const u32x2 x0 = *(const u32x2*)(XTh + (pt * 16 + fr) * 72 + i * 32 + fq * 4), x1 = *(const u32x2*)(XTh + (pt * 16 + fr) * 72 + i * 32 + 16 + fq * 4);
                const u32x4 av = (u32x4){x0[0], x0[1], x1[0], x1[1]}, bv = (u32x4){pk[2 * i][0], pk[2 * i][1], pk[2 * i + 1][0], pk[2 * i + 1][1]};
                y = __builtin_amdgcn_mfma_f32_16x16x32_bf16(__builtin_bit_cast(bf16x8, av), __builtin_bit_cast(bf16x8, bv), y, 0, 0, 0); } }
            if (tok >= 0) { const float rd = rdt_l[hl * 64 + l] * dsk; f32x4 o;
#pragma unroll
                for (int j = 0; j < 4; ++j) o[j] = y[j] + bf2f(XTh[(pt * 16 + fq * 4 + j) * 72 + l]) * rd;
                *(u32x2*)(YD + (size_t)tok * 512 + h * 64 + pt * 16 + fq * 4) = (u32x2){cvtpk(o[0], o[1]), cvtpk(o[2], o[3])}; } } }
    float* CS = s.smp ? (float*)(ws + W_CSS) + ((size_t)s.b * 8 + h) * 8192 : p.out + O_Y + ((size_t)(s.b * 128 + s.c) * 8 + h) * 8192;
#pragma unroll
    for (int nti = 0; nti < 4; ++nti) { const int nt = half * 4 + nti;
#pragma unroll
        for (int pt = 0; pt < 4; ++pt) { f32x4 c = (f32x4){0.f, 0.f, 0.f, 0.f};
#pragma unroll
            for (int i = 0; i < 2; ++i) { const bf16x8 a = *(const bf16x8*)(BTl + (nt * 16 + fr) * 72 + i * 32 + fq * 8), bb = *(const bf16x8*)(XTEh + (pt * 16 + fr) * 72 + i * 32 + fq * 8);
                c = __builtin_amdgcn_mfma_f32_16x16x32_bf16(a, bb, c, 0, 0, 0); }
            *(f32x4*)(CS + (size_t)(pt * 16 + fr) * 128 + nt * 16 + fq * 4) = c; } }
    __syncthreads();
}

DEV void ssd_scan(const Params& p, float* dummy = nullptr) {
    unsigned char* ws = p.ws; const float* DEC = (const float*)(ws + W_DEC);
    if (threadIdx.x < 256) {
        typedef __attribute__((ext_vector_type(2))) float f32x2v;
        for (int e2 = blockIdx.x * 256 + threadIdx.x; e2 < 2 * 32768; e2 += gridDim.x * 256) { const int e = e2 * 2, b = e >> 16, rest = e & 65535, h = rest >> 13;
            float* cs = p.out + O_Y + (size_t)b * 128 * 65536 + rest; float* cd = dummy ? dummy + (size_t)b * 128 * 65536 + rest : cs; f32x2v sv = (f32x2v){0.f, 0.f};
#pragma unroll 32
            for (int c = 0; c < 128; ++c) { const f32x2v t = *(const f32x2v*)(cs + (size_t)c * 65536); *(f32x2v*)(cd + (size_t)c * 65536) = sv; sv = sv * DEC[(b * 128 + c) * 8 + h] + t; }
            *(f32x2v*)((dummy ? dummy : p.out + O_PSSD) + e) = sv; }
    } else {
        for (int e4 = blockIdx.x * 256 + (threadIdx.x - 256); e4 < 16 * 16384; e4 += gridDim.x * 256) { const int e = e4 * 4, b = e >> 16, h = (e >> 13) & 7;
            const f32x4 s0 = *(const f32x4*)(p.state_ssd + e), c0 = *(const f32x4*)((const float*)(ws + W_CSS) + e);
            *(f32x4*)((dummy ? dummy : p.out + O_SSSD) + e) = s0 * DEC[(256 + b) * 8 + h] + c0; }
    }
}

DEV void ssd_final_unit(const Params& p, int u, char* lds) {
    const SsdSrc s = ssd_decode(u);
    int tid = threadIdx.x; asm volatile("" : "+v"(tid)); const int lane = tid & 63, wid = tid >> 6, fr = lane & 15, fq = lane >> 4;
    unsigned char* ws = p.ws;
    const int hl = wid >> 1, half = wid & 1, h = s.g * 4 + hl;
    float* ssl = (float*)lds;
    const float* sp = s.smp ? p.state_ssd + ((size_t)s.b * 8 + h) * 8192 : p.out + O_Y + ((size_t)(s.b * 128 + s.c) * 8 + h) * 8192;
    const bf16_t* CG = (const bf16_t*)(ws + W_CG); const bf16_t* YD = (const bf16_t*)(ws + W_RA); const float* ACS = (const float*)(ws + W_ACS);
    const bf16_t* Z = (const bf16_t*)(ws + W_Z); bf16_t* MIX = (bf16_t*)(ws + W_RB);
    if (s.smp) { const int r = tid >> 5, c8 = (tid & 31) * 8;
        *(u32x4*)(MIX + (size_t)(TP + s.b * 16 + r) * 1024 + 512 + s.g * 256 + c8) = *(const u32x4*)((const bf16_t*)(ws + W_SATT) + (size_t)(s.b * 16 + r) * 512 + s.g * 256 + c8); }
    f32x4 acc[2][4]; int tok[2]; bool tv[2];
#pragma unroll
    for (int lti = 0; lti < 2; ++lti) { tok[lti] = ssd_token(s, (half * 2 + lti) * 16 + fr); tv[lti] = !s.smp || (half * 2 + lti == 3);
#pragma unroll
        for (int pt = 0; pt < 4; ++pt) acc[lti][pt] = (f32x4){0.f, 0.f, 0.f, 0.f}; }
    f32x4 yd[2][4]; u32x2 zz[2][4]; float ea[2] = {0.f, 0.f}; f32x4 ng[4];
#pragma unroll
    for (int pt = 0; pt < 4; ++pt) ng[pt] = *(const f32x4*)(p.ssd_norm_g + h * 64 + pt * 16 + fq * 4);
#pragma unroll
    for (int lti = 0; lti < 2; ++lti) if (tv[lti]) { ea[lti] = ACS[(size_t)tok[lti] * 8 + h];
#pragma unroll
        for (int pt = 0; pt < 4; ++pt) { const int ch = h * 64 + pt * 16 + fq * 4; { const u32x2 yb = *(const u32x2*)(YD + (size_t)tok[lti] * 512 + ch); yd[lti][pt] = (f32x4){bflo(yb[0]), bfhi(yb[0]), bflo(yb[1]), bfhi(yb[1])}; } zz[lti][pt] = *(const u32x2*)(Z + (size_t)tok[lti] * 512 + ch); } }
    if (tv[0] || tv[1]) {
#pragma unroll
        for (int k = 0; k < 4; ++k) { bf16x8 cb[2];
#pragma unroll
            for (int lti = 0; lti < 2; ++lti) { u32x4 t = (u32x4){0u, 0u, 0u, 0u}; if (tv[lti]) t = *(const u32x4*)(CG + (size_t)tok[lti] * 256 + s.g * 128 + k * 32 + fq * 8); cb[lti] = __builtin_bit_cast(bf16x8, t); }
#pragma unroll
            for (int pt = 0; pt < 4; ++pt) { const float* r = sp + (size_t)(pt * 16 + fr) * 128 + k * 32 + fq * 8; const f32x4 a0 = *(const f32x4*)r, a1 = *(const f32x4*)(r + 4);
                const u32x4 av = (u32x4){cvtpk(a0[0], a0[1]), cvtpk(a0[2], a0[3]), cvtpk(a1[0], a1[1]), cvtpk(a1[2], a1[3])};
#pragma unroll
                for (int lti = 0; lti < 2; ++lti) if (tv[lti]) acc[lti][pt] = __builtin_amdgcn_mfma_f32_16x16x32_bf16(__builtin_bit_cast(bf16x8, av), cb[lti], acc[lti][pt], 0, 0, 0); } } }
#pragma unroll
    for (int lti = 0; lti < 2; ++lti) { const int l = (half * 2 + lti) * 16 + fr; float ss = 0.f;
        if (tv[lti]) { const float eav = __expf(ea[lti]);
#pragma unroll
            for (int pt = 0; pt < 4; ++pt) { const u32x2 z2 = zz[lti][pt];
                const float z0 = bflo(z2[0]), z1 = bfhi(z2[0]), z2f = bflo(z2[1]), z3 = bfhi(z2[1]);
                f32x4 y = yd[lti][pt] + acc[lti][pt] * eav; y[0] *= silu_f(z0); y[1] *= silu_f(z1); y[2] *= silu_f(z2f); y[3] *= silu_f(z3);
                acc[lti][pt] = y; ss += y[0] * y[0] + y[1] * y[1] + y[2] * y[2] + y[3] * y[3]; }
            ss += __shfl_xor(ss, 16); ss += __shfl_xor(ss, 32);
            if (fq == 0) ssl[l * 4 + hl] = ss; } }
    __syncthreads();
#pragma unroll
    for (int lti = 0; lti < 2; ++lti) { const int l = (half * 2 + lti) * 16 + fr;
        if (tv[lti]) { const f32x4 q = *(const f32x4*)(ssl + l * 4); const float rs = rsqrtf((q[0] + q[1] + q[2] + q[3]) * (1.f / 256.f) + EPS);
#pragma unroll
            for (int pt = 0; pt < 4; ++pt) { const int ch = h * 64 + pt * 16 + fq * 4; const f32x4 y = acc[lti][pt] * rs * ng[pt];
                *(u32x2*)(MIX + (size_t)tok[lti] * 1024 + ch) = (u32x2){cvtpk(y[0], y[1]), cvtpk(y[2], y[3])}; } } }
    __syncthreads();
}

namespace att {
constexpr int D = 64, QDM = 512, NW = 8, QBLK = 32, QB = QBLK * NW, KVBLK = 64, NQB = SEQ / QB, OPITCH = 1024;
constexpr float C2 = 1.0f;
constexpr int THR = 48;
constexpr int SLOTB = 8192, LDS_K = 0, LDS_V = 3 * SLOTB, LDS_WS = 6 * SLOTB, LDS_OST = LDS_WS + NW * 256, LDS_BYTES = LDS_OST + NW * 4096, LDS_GB = LDS_BYTES;
static_assert(LDS_GB + SEQ * 4 <= LDS_TOTAL, "attention lds");
#define SBAR() __builtin_amdgcn_sched_barrier(0)
#define PIN(x) asm volatile("" : "+v"(x))
#define MFMA(a, b, c) __builtin_amdgcn_mfma_f32_32x32x16_bf16(a, b, c, 0, 0, 0)
#define WAIT_BAR(N) asm volatile("s_waitcnt vmcnt(" #N ") lgkmcnt(0)\n\ts_barrier" ::: "memory")
DEV int crow(int r, int hi) { return (r & 3) + 8 * (r >> 2) + 4 * hi; }
DEV void glds16(const void* g, unsigned lds_base) {
    unsigned sv; asm volatile("s_mov_b32 %0, m0\n\ts_mov_b32 m0, %2\n\ts_nop 0\n\tglobal_load_lds_dwordx4 %1, off\n\ts_mov_b32 m0, %0" : "=&s"(sv) : "v"(g), "s"(lds_base) : "memory"); }
typedef __attribute__((address_space(3))) const char* lds_cptr;
typedef short v4i16_t __attribute__((ext_vector_type(4)));
DEV void kload2(bf16x8* kf, lds_cptr kp, int d0) { kf[2 * d0] = *(const __attribute__((address_space(3))) bf16x8*)(kp + d0 * 2048); kf[2 * d0 + 1] = *(const __attribute__((address_space(3))) bf16x8*)(kp + d0 * 2048 + 512); }
DEV s16x4 vtr(lds_cptr p) { return __builtin_bit_cast(s16x4, __builtin_amdgcn_ds_read_tr16_b64_v4i16((__attribute__((address_space(3))) v4i16_t*)p)); }
#define MX3(a, b, c) __builtin_fmaxf(__builtin_fmaxf((a), (b)), (c))
DEV float rowmax(const f32x16& p0, const f32x16& p1) {
    float a = MX3(p0[0], p0[1], p1[0]), b = MX3(p0[2], p0[3], p1[1]); a = MX3(a, p1[2], p1[3]);
#pragma unroll
    for (int r = 4; r < 16; r += 4) { a = MX3(a, p0[r], p0[r + 1]); b = MX3(b, p0[r + 2], p0[r + 3]); a = MX3(a, p1[r], p1[r + 1]); b = MX3(b, p1[r + 2], p1[r + 3]); }
    float m = __builtin_fmaxf(a, b); auto rr = __builtin_amdgcn_permlane32_swap(__float_as_uint(m), __float_as_uint(m), false, false);
    return __builtin_fmaxf(__uint_as_float(rr[0]), __uint_as_float(rr[1])); }
DEV void cmask(f32x16& p0, f32x16& p1, int jb, int qrel, int hi) {
    const int kb = 64 * jb + 4 * hi;
#pragma unroll
    for (int r = 0; r < 16; ++r) { const int kv = kb + (r & 3) + 8 * (r >> 2); if (kv > qrel) p0[r] = -INFINITY; if (kv + 32 > qrel) p1[r] = -INFINITY; } }
typedef __attribute__((address_space(3))) const f32x4* lds_f4p;
DEV void loadbias(f32x16& c0, f32x16& c1, lds_f4p gb, int t, int hi) {
#pragma unroll
    for (int i = 0; i < 4; ++i) { const f32x4 a = gb[16 * t + hi + 2 * i], b = gb[16 * t + 8 + hi + 2 * i];
        c0[4 * i] = a[0]; c0[4 * i + 1] = a[1]; c0[4 * i + 2] = a[2]; c0[4 * i + 3] = a[3]; c1[4 * i] = b[0]; c1[4 * i + 1] = b[1]; c1[4 * i + 2] = b[2]; c1[4 * i + 3] = b[3]; } }

DEV void attn64_unit(int b, int h, int qb, int bias_qb, const bf16_t* Q, const bf16_t* __restrict__ K, const bf16_t* __restrict__ V, const float* __restrict__ G, bf16_t* O, char* lds) {
    int tid = threadIdx.x; asm volatile("" : "+v"(tid));
    const int lane = tid & 63, r32 = lane & 31, hi = lane >> 5; const int wid = __builtin_amdgcn_readfirstlane(tid >> 6);
    const long rowbase = (long)b * SEQ; const int q0 = qb * QB, NT = (q0 + QB) / KVBLK;
    const bf16_t* Qw = Q + (rowbase + q0 + wid * QBLK) * QDM + h * D;
    const unsigned lds0 = (unsigned)(uintptr_t)lds; float* wsf = (float*)(lds + LDS_WS) + wid * 64;
    if (bias_qb >= 0) { const f32x4* src = (const f32x4*)(G + ((size_t)b * 8 + h) * SEQ); f32x4* dst = (f32x4*)(lds + LDS_GB); const int n4 = (bias_qb * QB + QB) / 4;
      for (int i = tid; i < n4; i += 512) dst[i] = src[i];
      asm volatile("s_waitcnt vmcnt(0) lgkmcnt(0)" ::: "memory"); }
    const lds_f4p gb = (lds_f4p)((lds_cptr)lds + LDS_GB);
    const bf16_t* ksrc = K + rowbase * QDM + h * D + (long)lane * QDM + wid * 8;
    const bf16_t* vsrc = V + rowbase * QDM + h * D + (long)(16 * (wid & 3) + (lane >> 2)) * QDM + (wid >> 2) * 32 + (lane & 3) * 8;
    const unsigned kdst = lds0 + LDS_K + wid * 1024, vdst = lds0 + LDS_V + wid * 1024;
#define DMA_K(t, slot) glds16(ksrc + (long)(t) * KVBLK * QDM, (unsigned)__builtin_amdgcn_readfirstlane(kdst + (slot)))
#define DMA_V(t, slot) glds16(vsrc + (long)(t) * KVBLK * QDM, (unsigned)__builtin_amdgcn_readfirstlane(vdst + (slot)))
    const lds_cptr vp0 = (lds_cptr)lds + LDS_V + ((lane >> 4) & 1) * 32 + (lane & 3) * 8 + (4 * hi + ((lane & 15) >> 2)) * 64;
    const lds_cptr kp0 = (lds_cptr)lds + LDS_K + hi * 1024 + r32 * 16;
    DMA_K(0, 0); DMA_V(0, 0); DMA_K(1, SLOTB);
    bf16x8 qr[4];
#pragma unroll
    for (int d0 = 0; d0 < 4; ++d0) qr[d0] = *reinterpret_cast<const bf16x8*>(&Qw[(long)r32 * QDM + d0 * 16 + hi * 8]);
    float mhat = 0.f, l_reg = 0.f; f32x16 o[2]; o[0] = f32x16{}; o[1] = f32x16{};
    const int qrel = wid * QBLK + r32; bool resc = false;
    f32x16 pA0, pA1, pB0, pB1; bf16x8 kf[8]; s16x4 vlo[8], vhi[8]; u32x4 pw0, pw1, pw2, pw3;
    int sl_prev = 0, sl_cur = 0, sl_next = SLOTB;
#define ROT() do { sl_prev = sl_cur; sl_cur = sl_next; sl_next = (sl_next == 2 * SLOTB) ? 0 : sl_next + SLOTB; } while (0)
#define EX(v) __builtin_amdgcn_exp2f(__builtin_fmaf((v), C2, nmh))
#define RESC() do { if (resc) { _Pragma("unroll") for (int d_ = 0; d_ < 2; ++d_) _Pragma("unroll") for (int r = 0; r < 16; ++r) o[d_][r] *= wsf[crow(r, hi)]; } } while (0)
    DMA_K(2, 2 * SLOTB);
    WAIT_BAR(3);
    _Pragma("unroll") for (int d0 = 0; d0 < 4; ++d0) kload2(kf, kp0, d0);
    loadbias(pA0, pA1, gb, 0, hi);
    pA0 = MFMA(kf[0], qr[0], pA0); pA1 = MFMA(kf[1], qr[0], pA1); pA0 = MFMA(kf[2], qr[1], pA0); pA1 = MFMA(kf[3], qr[1], pA1);
    pA0 = MFMA(kf[4], qr[2], pA0); pA1 = MFMA(kf[5], qr[2], pA1); pA0 = MFMA(kf[6], qr[3], pA0); pA1 = MFMA(kf[7], qr[3], pA1);
    if (NT == 4) cmask(pA0, pA1, 0, qrel, hi);
    { const float rm = rowmax(pA0, pA1); mhat = rm * C2; const float nmh = -mhat;
#pragma unroll
      for (int r = 0; r < 16; ++r) { pA0[r] = EX(pA0[r]); pA1[r] = EX(pA1[r]); } }
    WAIT_BAR(0);
    DMA_K(3, 0); DMA_V(1, SLOTB); ROT();
    _Pragma("unroll") for (int d0 = 0; d0 < 4; ++d0) kload2(kf, kp0 + sl_cur, d0);
    WAIT_BAR(2);
#define PKW(P, i) cvtpk(P[i], P[i + 1])
#define PAF(k) __builtin_bit_cast(bf16x8, pw##k)
#define VFR(i) (bf16x8){vlo[i][0], vlo[i][1], vlo[i][2], vlo[i][3], vhi[i][0], vhi[i][1], vhi[i][2], vhi[i][3]}
#define VRD(i) do { vlo[i] = vtr(vp_ + (((i) >> 2) * 4096 + ((i) & 3) * 1024)); vhi[i] = vtr(vp_ + (((i) >> 2) * 4096 + ((i) & 3) * 1024 + 512)); } while (0)
#define KRD(G_, d0) do { if (G_) { kload2(kf, kp0 + sl_next, d0); SBAR(); } } while (0)
#define GAPA(MF, a0, a1, a2, a3, W0, W1, PW) do { MF; sacc += a0; sacc += a1; sacc += a2; sacc += a3; W0; W1; PIN(PW); PIN(sacc); SBAR(); } while (0)
#define GAPB(MF, X, i) do { MF; X[i] = EX(X[i]); X[i + 1] = EX(X[i + 1]); X[i + 2] = EX(X[i + 2]); X[i + 3] = EX(X[i + 3]); PIN(X); SBAR(); } while (0)
#define STEP(C0, C1, P0, P1, t, MASK, GK, GV, GL) do { SBAR(); \
    const lds_cptr vp_ = vp0 + sl_prev; \
    VRD(0); SBAR(); float sacc = P0[0] + P0[1]; \
                    GAPA(C0 = MFMA(kf[0], qr[0], C0), P0[2], P0[3], P0[4], P0[5],     pw0[0] = PKW(P0, 0),  pw0[1] = PKW(P0, 2),  pw0); \
    VRD(4); SBAR(); GAPA(C1 = MFMA(kf[1], qr[0], C1), P0[6], P0[7], P0[8], P0[9],     pw0[2] = PKW(P0, 4),  pw0[3] = PKW(P0, 6),  pw0); \
    VRD(1); SBAR(); GAPA(C0 = MFMA(kf[2], qr[1], C0),    P0[10], P0[11], P0[12], P0[13], pw1[0] = PKW(P0, 8),  pw1[1] = PKW(P0, 10), pw1); \
    VRD(5); SBAR(); GAPA(C1 = MFMA(kf[3], qr[1], C1),    P0[14], P0[15], P1[0], P1[1],   pw1[2] = PKW(P0, 12), pw1[3] = PKW(P0, 14), pw1); \
    VRD(2); SBAR(); GAPA(C0 = MFMA(kf[4], qr[2], C0),    P1[2], P1[3], P1[4], P1[5],     pw2[0] = PKW(P1, 0),  pw2[1] = PKW(P1, 2),  pw2); \
    VRD(6); SBAR(); GAPA(C1 = MFMA(kf[5], qr[2], C1),    P1[6], P1[7], P1[8], P1[9],     pw2[2] = PKW(P1, 4),  pw2[3] = PKW(P1, 6),  pw2); \
    VRD(3); SBAR(); GAPA(C0 = MFMA(kf[6], qr[3], C0),    P1[10], P1[11], P1[12], P1[13], pw3[0] = PKW(P1, 8),  pw3[1] = PKW(P1, 10), pw3); \
    VRD(7); SBAR(); GAPA(C1 = MFMA(kf[7], qr[3], C1),    P1[14], P1[15], 0.f, 0.f,       pw3[2] = PKW(P1, 12), pw3[3] = PKW(P1, 14), pw3); \
    l_reg += sacc; \
    if (GK) DMA_K((t) + 3, sl_cur); if (GV) DMA_V((t) + 1, sl_next); \
    if (MASK) cmask(C0, C1, (t) - (NT - 4), qrel, hi); \
    { const float rm = __builtin_fmaf(rowmax(C0, C1), C2, -mhat); resc = false; \
      if (__any(rm > (float)THR)) { const float dl = __builtin_fmaxf(rm, 0.f); mhat += dl; \
          const float f = __builtin_amdgcn_exp2f(-dl); l_reg *= f; if (hi == 0) wsf[r32] = f; resc = true; } } \
    const float nmh = -mhat; SBAR(); \
    if (GL) { loadbias(P0, P1, gb, (t) + 1, hi); SBAR(); }            \
    GAPB(o[0] = MFMA(PAF(0), VFR(0), o[0]), C0, 0);              GAPB(o[1] = MFMA(PAF(0), VFR(4), o[1]), C0, 4); \
    KRD(GL, 0); GAPB(o[0] = MFMA(PAF(1), VFR(1), o[0]), C0, 8);  KRD(GL, 1); GAPB(o[1] = MFMA(PAF(1), VFR(5), o[1]), C0, 12); \
    KRD(GL, 2); GAPB(o[0] = MFMA(PAF(2), VFR(2), o[0]), C1, 0);  KRD(GL, 3); GAPB(o[1] = MFMA(PAF(2), VFR(6), o[1]), C1, 4); \
    GAPB(o[0] = MFMA(PAF(3), VFR(3), o[0]), C1, 8);              GAPB(o[1] = MFMA(PAF(3), VFR(7), o[1]), C1, 12); \
    } while (0)
    loadbias(pB0, pB1, gb, 1, hi);
    int t = 1;
    for (; t + 5 < NT; t += 2) {
        STEP(pB0, pB1, pA0, pA1, t, false, true, true, true);     WAIT_BAR(2); RESC(); ROT();
        STEP(pA0, pA1, pB0, pB1, t + 1, false, true, true, true); WAIT_BAR(2); RESC(); ROT();
    }
#define ENDW(tt) do { if ((tt) + 3 < NT) { WAIT_BAR(2); } else if ((tt) + 2 < NT) { WAIT_BAR(1); } else { WAIT_BAR(0); } } while (0)
    for (; t + 1 < NT; t += 2) {
        STEP(pB0, pB1, pA0, pA1, t, true, (t + 3 < NT), (t + 1 < NT), (t + 1 < NT));         ENDW(t);     RESC(); ROT();
        STEP(pA0, pA1, pB0, pB1, t + 1, true, (t + 4 < NT), (t + 2 < NT), (t + 2 < NT));     ENDW(t + 1); RESC(); ROT();
    }
    STEP(pB0, pB1, pA0, pA1, NT - 1, true, false, false, false); RESC();
    { float sacc = pB0[0] + pB0[1];
#pragma unroll
      for (int r = 2; r < 16; ++r) sacc += pB0[r];
#pragma unroll
      for (int r = 0; r < 16; ++r) sacc += pB1[r];
      l_reg += sacc;
      pw0 = (u32x4){PKW(pB0, 0), PKW(pB0, 2), PKW(pB0, 4), PKW(pB0, 6)}; pw1 = (u32x4){PKW(pB0, 8), PKW(pB0, 10), PKW(pB0, 12), PKW(pB0, 14)};
      pw2 = (u32x4){PKW(pB1, 0), PKW(pB1, 2), PKW(pB1, 4), PKW(pB1, 6)}; pw3 = (u32x4){PKW(pB1, 8), PKW(pB1, 10), PKW(pB1, 12), PKW(pB1, 14)};
      const lds_cptr vp_ = vp0 + sl_cur; _Pragma("unroll") for (int i = 0; i < 8; ++i) VRD(i);
      o[0] = MFMA(PAF(0), VFR(0), o[0]); o[1] = MFMA(PAF(0), VFR(4), o[1]); o[0] = MFMA(PAF(1), VFR(1), o[0]); o[1] = MFMA(PAF(1), VFR(5), o[1]);
      o[0] = MFMA(PAF(2), VFR(2), o[0]); o[1] = MFMA(PAF(2), VFR(6), o[1]); o[0] = MFMA(PAF(3), VFR(3), o[0]); o[1] = MFMA(PAF(3), VFR(7), o[1]); }
    { auto rr = __builtin_amdgcn_permlane32_swap(__float_as_uint(l_reg), __float_as_uint(l_reg), false, false); l_reg = __uint_as_float(rr[0]) + __uint_as_float(rr[1]); }
    if (hi == 0) wsf[32 + r32] = l_reg; asm volatile("s_waitcnt lgkmcnt(0)" ::: "memory");
    float rli[16];
#pragma unroll
    for (int r = 0; r < 16; ++r) rli[r] = __builtin_amdgcn_rcpf(wsf[32 + crow(r, hi)]);
    bf16_t* Ow = O + (rowbase + q0 + wid * QBLK) * OPITCH + h * D; bf16_t* stg = (bf16_t*)(lds + LDS_OST) + wid * 2048;
#pragma unroll
    for (int r = 0; r < 16; ++r) { const int orow = crow(r, hi);
#pragma unroll
        for (int d0 = 0; d0 < 2; ++d0) stg[orow * 64 + d0 * 32 + r32] = f2bf(o[d0][r] * rli[r]); }
    asm volatile("s_waitcnt lgkmcnt(0)" ::: "memory");
#pragma unroll
    for (int i = 0; i < 4; ++i) { const int row = i * 8 + (lane >> 3), ch = lane & 7; *(u32x4*)(Ow + (long)row * OPITCH + ch * 8) = *(const u32x4*)(stg + row * 64 + ch * 8); }
    asm volatile("s_waitcnt lgkmcnt(0)\n\ts_barrier" ::: "memory");
#undef DMA_K
#undef DMA_V
#undef ROT
#undef EX
#undef RESC
#undef PKW
#undef PAF
#undef VFR
#undef VRD
#undef KRD
#undef ENDW
#undef GAPA
#undef GAPB
#undef STEP
}
}

DEV void ffn_conv_gate(const Params& p, int hf) {
    unsigned char* ws = p.ws; const bf16_t* U = (const bf16_t*)(ws + W_U); bf16_t* ACT = (bf16_t*)(ws + W_ACT);
    const int nitems = (TA / 32) * 176;
    for (int it = blockIdx.x * 512 + threadIdx.x; it < nitems; it += gridDim.x * 512) {
        const int run = it / 176, cg8 = it % 176, row0 = run * 32; const int ja = hf * 1408 + cg8 * 8;
        const int lc = cg8 * 8, ug = (lc >> 7) * 256 + (lc & 127), uv = ug + 128;
        const bool smp = row0 >= TP;
        float wg[3][8], wv[3][8], bg[8], bv[8];
#pragma unroll
        for (int e = 0; e < 8; ++e) { bg[e] = p.ffn_conv_b[ja + e]; bv[e] = p.ffn_conv_b[DFF + ja + e];
#pragma unroll
            for (int j = 0; j < 3; ++j) { wg[j][e] = p.ffn_conv_w[j * NUP + ja + e]; wv[j][e] = p.ffn_conv_w[j * NUP + DFF + ja + e]; } }
        float g2[8], g1[8], v2[8], v1[8];
        auto unpack = [](const u32x4& a, float* o) {
#pragma unroll
            for (int e = 0; e < 4; ++e) { o[2 * e] = bflo(a[e]); o[2 * e + 1] = bfhi(a[e]); } };
        auto init_window = [&](int row) {
            if (smp) { const int b = (row - TP) >> 4; const float* s0 = p.state_ffn_conv + (size_t)(b * 2) * NUP, *s1 = s0 + NUP;
#pragma unroll
                for (int e = 0; e < 8; ++e) { g2[e] = s0[ja + e]; v2[e] = s0[DFF + ja + e]; g1[e] = s1[ja + e]; v1[e] = s1[DFF + ja + e]; } }
            else if ((row & 8191) == 0) {
#pragma unroll
                for (int e = 0; e < 8; ++e) { g2[e] = 0.f; v2[e] = 0.f; g1[e] = 0.f; v1[e] = 0.f; } }
            else { unpack(*(const u32x4*)(U + (size_t)(row - 2) * DFF + ug), g2); unpack(*(const u32x4*)(U + (size_t)(row - 2) * DFF + uv), v2);
                   unpack(*(const u32x4*)(U + (size_t)(row - 1) * DFF + ug), g1); unpack(*(const u32x4*)(U + (size_t)(row - 1) * DFF + uv), v1); } };
        init_window(row0);
#pragma unroll 4
        for (int r = 0; r < 32; ++r) { const int row = row0 + r;
            if (smp && r == 16) init_window(row);
            float g0[8], v0[8]; unpack(*(const u32x4*)(U + (size_t)row * DFF + ug), g0); unpack(*(const u32x4*)(U + (size_t)row * DFF + uv), v0);
            u32x4 o;
#pragma unroll
            for (int e = 0; e < 4; ++e) { float a[2];
#pragma unroll
                for (int q = 0; q < 2; ++q) { const int i = 2 * e + q; const float cg = bg[i] + wg[0][i] * g2[i] + wg[1][i] * g1[i] + wg[2][i] * g0[i], cv = bv[i] + wv[0][i] * v2[i] + wv[1][i] * v1[i] + wv[2][i] * v0[i];
                    a[q] = silu_f(cg) * cv; }
                o[e] = cvtpk(a[0], a[1]); }
            *(u32x4*)(ACT + (size_t)row * DFF + ja) = o;
#pragma unroll
            for (int e = 0; e < 8; ++e) { g2[e] = g1[e]; g1[e] = g0[e]; v2[e] = v1[e]; v1[e] = v0[e]; }
        }
    }
}

#define XB_TMO      128
#define XB_XCNT(j)  (256  + 64 * (j))
#define XB_XSUB(j)  (1280 + 64 * (j))
#define XB_XGEN(j)  (2304 + 64 * (j))
#define XB_TOP      3328
#define XB_TOPGEN   3392
#define XCD_BAR_WORDS 3456
#define XB_SPIN_CAP (1u << 18)
#define LAS __attribute__((address_space(3)))
DEV unsigned xb_ld(unsigned* p)              { return __hip_atomic_load(p, __ATOMIC_RELAXED, __HIP_MEMORY_SCOPE_AGENT); }
DEV unsigned xb_add(unsigned* p, unsigned v) { return __hip_atomic_fetch_add(p, v, __ATOMIC_RELAXED, __HIP_MEMORY_SCOPE_AGENT); }
DEV unsigned xb_xcc_id() { return (unsigned)__builtin_amdgcn_s_getreg((3 << 11) | 20) & 0xFu; }
#define XB_SPIN(cond, bar) do { unsigned _sp = 0; while (cond) { __builtin_amdgcn_s_sleep(1); \
    if ((++_sp & 255u) == 0u) { if (xb_ld(&(bar)[XB_TMO])) break; if (_sp > XB_SPIN_CAP) { atomicAdd(&(bar)[XB_TMO], 1u); break; } } } } while (0)
struct XcdBarrier { unsigned* bar; unsigned x; volatile LAS unsigned* st; };
DEV XcdBarrier xcd_barrier_post(unsigned* bar, volatile LAS unsigned* st) {
    XcdBarrier b; b.bar = bar; b.x = xb_xcc_id(); b.st = st;
    if (threadIdx.x == 0) (void)xb_add(&bar[XB_XCNT(b.x)], 1u);
    return b;
}
DEV void xcd_barrier_complete(unsigned* bar, unsigned x, unsigned& nloc, unsigned& nx) {
    const unsigned G = gridDim.x * gridDim.y * gridDim.z;
    unsigned sum, cnt, mine, sp = 0u;
    for (;;) {
        sum = 0u; cnt = 0u; mine = 0u;
#pragma unroll
        for (unsigned j = 0; j < 16; ++j) { const unsigned c = xb_ld(&bar[XB_XCNT(j)]); sum += c; cnt += (c > 0u) ? 1u : 0u; mine = (j == x) ? c : mine; }
        if (sum == G) break;
        __builtin_amdgcn_s_sleep(1);
        if ((++sp & 255u) == 0u) { if (xb_ld(&bar[XB_TMO])) break; if (sp > XB_SPIN_CAP) { atomicAdd(&bar[XB_TMO], 1u); break; } }
    }
    nloc = mine > 0u ? mine : 1u; nx = cnt > 0u ? cnt : 1u;
}
DEV void xcd_barrier(const XcdBarrier& b) {
    asm volatile("s_waitcnt vmcnt(0)" ::: "memory");
    __syncthreads();
    if (threadIdx.x == 0) {
        unsigned* bar = b.bar;
        __builtin_amdgcn_s_waitcnt(0);
        unsigned nloc = b.st[0], nx = b.st[1];
        if (nloc == 0u) { xcd_barrier_complete(bar, b.x, nloc, nx); b.st[0] = nloc; b.st[1] = nx; }
        const unsigned old = xb_add(&bar[XB_XSUB(b.x)], 1u);
        const unsigned gen = old / nloc;
        if (old + 1u == (gen + 1u) * nloc) {
            __builtin_amdgcn_fence(__ATOMIC_RELEASE, "agent");
            asm volatile("s_waitcnt vmcnt(0)" ::: "memory");
            const unsigned og = xb_add(&bar[XB_TOP], 1u);
            const unsigned tg = og / nx;
            if (og + 1u == (tg + 1u) * nx) xb_add(&bar[XB_TOPGEN], 1u);
            else XB_SPIN(xb_ld(&bar[XB_TOPGEN]) == tg, bar);
            __builtin_amdgcn_fence(__ATOMIC_ACQUIRE, "agent");
            xb_add(&bar[XB_XGEN(b.x)], 1u);
            asm volatile("s_waitcnt vmcnt(0)" ::: "memory");
        } else {
            XB_SPIN(xb_ld(&bar[XB_XGEN(b.x)]) == gen, bar);
            __builtin_amdgcn_fence(__ATOMIC_ACQUIRE, "agent");
            asm volatile("s_waitcnt vmcnt(0)" ::: "memory");
        }
    }
    __syncthreads();
}

struct EpiDownNorm {
    const bf16_t* Hb; float* X; unsigned* cnt; unsigned* tmo; const float* g; float* Y; char* lds;
    DEV void operator()(f32x4 (&acc)[2][2][4][2], int pm, int pn, int wr, int wc, int fr, int fq) const {
        float* Pl = (float*)lds; float* Sl = (float*)(lds + 4096);
        EPI_LOOP_BEGIN
            float ss = 0.f;
            EPI_COLS_BEGIN
                const u32x2 hb = *(const u32x2*)(Hb + (size_t)row * 1024 + col); const f32x4 h = v + (f32x4){bflo(hb[0]), bfhi(hb[0]), bflo(hb[1]), bfhi(hb[1])};
                acc[ai][bj][m][n] = h; ss += h[0] * h[0] + h[1] * h[1] + h[2] * h[2] + h[3] * h[3];
            }
            ss += __shfl_xor(ss, 16); ss += __shfl_xor(ss, 32);
            if (fq == 0) Pl[(row - pm * BM) * 4 + wc] = ss;
        }
        __syncthreads();
        int tid = threadIdx.x; asm volatile("" : "+v"(tid));
        if (tid < 256) { const f32x4 q = *(const f32x4*)(Pl + tid * 4); __hip_atomic_store(X + ((size_t)pm * 256 + tid) * 4 + pn, (q[0] + q[1]) + (q[2] + q[3]), __ATOMIC_RELAXED, __HIP_MEMORY_SCOPE_AGENT); }
        asm volatile("s_waitcnt vmcnt(0)" ::: "memory");
        __syncthreads();
        if (tid == 0) { (void)xb_add(cnt + pm * 16, 1u); unsigned sp = 0u;
            while (xb_ld(cnt + pm * 16) < 4u) { __builtin_amdgcn_s_sleep(1); if (++sp > (1u << 20)) { atomicAdd(tmo, 1u); break; } } }
        __syncthreads();
        if (tid < 256) { const float* xs = X + ((size_t)pm * 256 + tid) * 4; float q[4];
#pragma unroll
            for (int i = 0; i < 4; ++i) q[i] = __hip_atomic_load(xs + i, __ATOMIC_RELAXED, __HIP_MEMORY_SCOPE_AGENT);
            Sl[tid] = rsqrtf(((q[0] + q[1]) + (q[2] + q[3])) * (1.f / 1024.f) + EPS); }
        __syncthreads();
        EPI_LOOP_BEGIN
            const float rs = Sl[row - pm * BM];
            EPI_COLS_BEGIN
                const f32x4 gg = *(const f32x4*)(g + col);
                *(f32x4*)(Y + (size_t)row * 1024 + col) = v * rs * gg;
            }
        }
        __syncthreads();
    }
};
struct SampleNormPost {
    float* Y; float* SS; const float* g; unsigned* cnt; char* lds;
    DEV void operator()(int mt) const {
        int tid = threadIdx.x; asm volatile("" : "+v"(tid)); const int rg = mt & 7;
        unsigned* flag = (unsigned*)(lds + 36864);
        __builtin_amdgcn_fence(__ATOMIC_RELEASE, "agent"); asm volatile("s_waitcnt vmcnt(0)" ::: "memory");
        __syncthreads();
        if (tid == 0) *flag = xb_add(cnt + (64 + rg) * 16, 1u);
        __syncthreads();
        if (*flag == 31u) {
            __builtin_amdgcn_fence(__ATOMIC_ACQUIRE, "agent"); asm volatile("s_waitcnt vmcnt(0)" ::: "memory");
            const int row = TP + rg * 32 + (tid >> 4);
            const float ssv = __hip_atomic_load(SS + row, __ATOMIC_RELAXED, __HIP_MEMORY_SCOPE_AGENT); const float rs = rsqrtf(ssv * (1.f / 1024.f) + EPS);
#pragma unroll 4
            for (int i = 0; i < 16; ++i) { const int col = ((tid & 15) + 16 * i) * 4; float* yp = Y + (size_t)row * 1024 + col; const f32x4 gg = *(const f32x4*)(g + col); *(f32x4*)yp = *(const f32x4*)yp * rs * gg; }
        }
        __syncthreads();
    }
};

#ifndef PROBE
#define PROBE 0
#endif
template <int PH> DEV void run_phase(const Params& p, char* lds) {
    unsigned char* ws = p.ws;
    if constexpr (PH == 0) { phase0(p, lds); }
    else if constexpr (PH == 1) { EpiIn e{(bf16_t*)(ws + W_Z), (bf16_t*)(ws + W_RB), (bf16_t*)(ws + W_Q), (bf16_t*)(ws + W_K), (bf16_t*)(ws + W_V), p.out};
        EpiInE ee{(bf16_t*)(ws + W_Z), (bf16_t*)(ws + W_RB), (bf16_t*)(ws + W_Q), (bf16_t*)(ws + W_K), (bf16_t*)(ws + W_V), p.out};
        sample_gemm<3>((const bf16_t*)(ws + W_RA), (const bf16_t*)(ws + W_WIN), 3072, 1024, ee, lds);
        gemm_phase((const bf16_t*)(ws + W_RA), (const bf16_t*)(ws + W_WIN), TP, 3072, 1024, e); }
    else if constexpr (PH == 2) {
        for (int u = (int)blockIdx.x + ((2 + 128 + 544 - 1 - (int)blockIdx.x) / (int)gridDim.x) * (int)gridDim.x; u >= 0; u -= (int)gridDim.x) {
#ifndef P2_MASK
#define P2_MASK 7
#endif
#ifndef P2_REP
#define P2_REP 0
#endif
            if (u < 544) { for (int rep = 0; rep < ((P2_REP & 4) ? 2 : 1); ++rep) ssd_chunk_unit(p, u, lds); }
            else if (u < 672) { for (int rep = 0; rep < ((P2_REP & 2) ? 2 : 1); ++rep) sample_attn_unit(p, (u - 544) >> 3, (u - 544) & 7, lds); }
            else { for (int rep = 0; rep < ((P2_REP & 1) ? 2 : 1); ++rep) cumsum_prompt_unit(p, u - 672, lds); }
        }
        weight_units_on_idle(p, 192, 608, 162, lds); }
    else if constexpr (PH == 3) {
#ifndef NO_SCAN
#if PROBE == 101
        ssd_scan(p, (float*)(ws + W_ACT + (size_t)16 * 1024 * 1024));
#endif
        ssd_scan(p);
#endif
#ifndef ATT_REP
#define ATT_REP 1
#endif
        for (int rep = 0; rep < ATT_REP; ++rep)
        for (int u = blockIdx.x; u < 256; u += gridDim.x) {
            const int x = u & 7, kk = u >> 3, bh = x + 8 * (kk / 16), j = kk % 16;
            att::attn64_unit(bh >> 3, bh & 7, j, att::NQB - 1 - j, (const bf16_t*)(ws + W_Q), (const bf16_t*)(ws + W_K), (const bf16_t*)(ws + W_V), (const float*)(ws + W_G), (bf16_t*)(ws + W_RB) + 512, lds);
            att::attn64_unit(bh >> 3, bh & 7, att::NQB - 1 - j, -1, (const bf16_t*)(ws + W_Q), (const bf16_t*)(ws + W_K), (const bf16_t*)(ws + W_V), (const float*)(ws + W_G), (bf16_t*)(ws + W_RB) + 512, lds); } }
    else if constexpr (PH == 4) { for (int u = blockIdx.x; u < 544; u += gridDim.x) ssd_final_unit(p, u, lds);
    }
    else if constexpr (PH == 5) { EpiOut e{p.x_prompt, p.x_sample, p.out + O_Y, (bf16_t*)(ws + W_RA), (float*)(ws + W_SS2)};
        EpiResE ee{p.x_sample - (size_t)TP * 1024, nullptr, nullptr, (bf16_t*)(ws + W_RA), (float*)(ws + W_SS2)};
        sample_gemm((const bf16_t*)(ws + W_RB), (const bf16_t*)(ws + W_WOUT), 1024, 1024, ee, lds);
        gemm_phase((const bf16_t*)(ws + W_RB), (const bf16_t*)(ws + W_WOUT), TP, 1024, 1024, e); }
    else if constexpr (PH == 6) { EpiUpFused e{(const float*)(ws + W_SS2), p.out, (bf16_t*)(ws + W_ACT), (bf16_t*)(ws + W_HALO), p.ffn_conv_w, p.ffn_conv_b, p.state_ffn_conv, lds};
        gemm_phase((const bf16_t*)(ws + W_RA), (const bf16_t*)(ws + W_WUP), TA, NUP, 1024, e);
        weight_units_on_idle(p, 608, 784, 150, lds); }
    else if constexpr (PH == 10) {
        EpiDownNorm e{(const bf16_t*)(ws + W_RA), (float*)(ws + W_DT), (unsigned*)(ws + W_CNT), (unsigned*)(ws + W_BAR) + XB_TMO, p.final_norm_g, p.out + O_Y, lds};
        EpiResE ee{nullptr, (const bf16_t*)(ws + W_RA), p.out + O_Y, nullptr, (float*)(ws + W_SS3)};
        sample_gemm((const bf16_t*)(ws + W_ACT), (const bf16_t*)(ws + W_WDN), 1024, DFF, ee, lds);
        gemm_phase((const bf16_t*)(ws + W_ACT), (const bf16_t*)(ws + W_WDN), TP, 1024, DFF, e, FfnFixup{&p}); }
    else if constexpr (PH == 11) { const int lane = threadIdx.x & 63, wid = threadIdx.x >> 6; const float* SS = (const float*)(ws + W_SS3);
        for (int row = TP + blockIdx.x * 8 + wid; row < TA; row += gridDim.x * 8) { const float rs = rsqrtf(SS[row] * (1.f / 1024.f) + EPS); float* yr = p.out + O_Y + (size_t)row * 1024;
#pragma unroll
            for (int i = 0; i < 4; ++i) { const f32x4 g = *(const f32x4*)(p.final_norm_g + i * 256 + lane * 4); f32x4 x = *(f32x4*)(yr + i * 256 + lane * 4); x = x * rs * g; *(f32x4*)(yr + i * 256 + lane * 4) = x; } } }
}
constexpr int NPH = 12;

#ifndef N_LAUNCH_SPLIT
#define N_LAUNCH_SPLIT 0
#endif
#if N_LAUNCH_SPLIT
template <int PH> __global__ void __launch_bounds__(512) ph_kernel(Params p) {
    extern __shared__ __attribute__((aligned(16))) bf16_t shm[];
    run_phase<PH>(p, (char*)shm);
}
template <int PH> static void launch_ph(const Params& p, int grid, hipStream_t stream) {
    (void)hipFuncSetAttribute((const void*)ph_kernel<PH>, hipFuncAttributeMaxDynamicSharedMemorySize, LDS_TOTAL);
    hipLaunchKernelGGL(ph_kernel<PH>, dim3(grid), dim3(512), LDS_TOTAL, stream, p);
}
#else
__global__ void __launch_bounds__(512) hymba_fwd(Params p) {
    extern __shared__ __attribute__((aligned(16))) bf16_t shm[];
    __shared__ uint4 xb_words;
    char* lds = (char*)shm;
    if (threadIdx.x == 0) xb_words = make_uint4(0u, 0u, 0u, 0u);
    __syncthreads();
    const XcdBarrier bar = xcd_barrier_post((unsigned*)(p.ws + W_BAR), (volatile LAS unsigned*)&xb_words);
#ifndef REP_PH
#define REP_PH -1
#endif
#define RUN(PH) do { run_phase<PH>(p, lds); if (REP_PH == PH) { xcd_barrier(bar); run_phase<PH>(p, lds); } } while (0)
    RUN(0); xcd_barrier(bar);
    RUN(1); xcd_barrier(bar);
    RUN(2); xcd_barrier(bar);
    RUN(3); xcd_barrier(bar);
    RUN(4); xcd_barrier(bar);
    RUN(5); xcd_barrier(bar);
    RUN(6); xcd_barrier(bar);
    RUN(10); xcd_barrier(bar);
    RUN(11);
}
#endif

extern "C" void kernel_launch(void* const* d_in, const int* in_sizes, int n_in, void* d_out, int out_size, void* d_ws, size_t ws_size, hipStream_t stream) {
    static int grid_blocks = 0;
    if (!grid_blocks) {
        if (n_in != 24 || (size_t)out_size != O_END || ws_size < W_END) { fprintf(stderr, "kernel_launch: unexpected sizes n_in %d out %d (want %zu) ws %zu (want %zu)\n", n_in, out_size, (size_t)O_END, ws_size, (size_t)W_END); }
        int dev = 0, cus = 0;
        (void)hipGetDevice(&dev);
        (void)hipDeviceGetAttribute(&cus, hipDeviceAttributeMultiprocessorCount, dev);
#if !N_LAUNCH_SPLIT
        int per_cu = 0;
        (void)hipFuncSetAttribute((const void*)hymba_fwd, hipFuncAttributeMaxDynamicSharedMemorySize, LDS_TOTAL);
        (void)hipOccupancyMaxActiveBlocksPerMultiprocessor(&per_cu, (const void*)hymba_fwd, 512, LDS_TOTAL);
        if (per_cu < 1) fprintf(stderr, "kernel_launch: occupancy query returned %d\n", per_cu);
#endif
        grid_blocks = cus > 0 ? cus : 256;
    }
    Params p{};
    const float** pp = (const float**)&p;
    for (int i = 0; i < 24; ++i) pp[i] = (const float*)d_in[i];
    p.out = (float*)d_out; p.ws = (unsigned char*)d_ws;
#if N_LAUNCH_SPLIT
    launch_ph<0>(p, grid_blocks, stream); launch_ph<1>(p, grid_blocks, stream); launch_ph<2>(p, grid_blocks, stream); launch_ph<3>(p, grid_blocks, stream);
    launch_ph<4>(p, grid_blocks, stream); launch_ph<5>(p, grid_blocks, stream); launch_ph<6>(p, grid_blocks, stream);
    launch_ph<10>(p, grid_blocks, stream);
#else
    (void)hipMemsetAsync((char*)d_ws + W_BAR, 0, 32768, stream);
    void* args[] = {&p};
    hipError_t e = hipLaunchCooperativeKernel((void*)hymba_fwd, dim3(grid_blocks), dim3(512), args, LDS_TOTAL, stream);
    if (e != hipSuccess) fprintf(stderr, "cooperative launch failed: %s (grid %d)\n", hipGetErrorString(e), grid_blocks);
#endif
}
```

```cpp
#include <hip/hip_runtime.h>
#include <hip/hip_cooperative_groups.h>
#include <cstdint>
#include <cstdio>
namespace cg = cooperative_groups;

typedef unsigned short bf16_t;
typedef __attribute__((ext_vector_type(8))) short bf16x8;
typedef __attribute__((ext_vector_type(4))) short s16x4;
typedef __attribute__((ext_vector_type(4))) float f32x4;
typedef __attribute__((ext_vector_type(16))) float f32x16;
typedef __attribute__((ext_vector_type(4))) unsigned u32x4;
typedef __attribute__((ext_vector_type(2))) unsigned u32x2;
#define DEV __device__ __forceinline__

constexpr int TP = 16384, TS = 256, TA = TP + TS;
constexpr int DM = 1024, SEQ = 8192, DFF = 2816, NUP = 5632, INC = 3088;
constexpr float EPS = 1e-6f;
constexpr float LOG2E = 1.4426950408889634f;
constexpr float QSCALE = 0.125f * LOG2E;
constexpr int LDS_TOTAL = 135168;

constexpr size_t O_Y = 0;
constexpr size_t O_PK = (size_t)TA * 1024;
constexpr size_t O_PV = O_PK + (size_t)TP * 512;
constexpr size_t O_PLF = O_PV + (size_t)TP * 512;
constexpr size_t O_PSSD = O_PLF + (size_t)TP * 8;
constexpr size_t O_PSC = O_PSSD + 2 * 8 * 64 * 128;
constexpr size_t O_PFC = O_PSC + 2 * 3 * 1024;
constexpr size_t O_SK = O_PFC + 2 * 2 * 5632;
constexpr size_t O_SV = O_SK + (size_t)TS * 512;
constexpr size_t O_SLF = O_SV + (size_t)TS * 512;
constexpr size_t O_SSSD = O_SLF + (size_t)TS * 8;
constexpr size_t O_SSC = O_SSSD + 16 * 8 * 64 * 128;
constexpr size_t O_SFC = O_SSC + 16 * 3 * 1024;
constexpr size_t O_END = O_SFC + 16 * 2 * 5632;

constexpr size_t W_WIN = 0;
constexpr size_t W_WOUT = W_WIN + (size_t)3072 * 1024 * 2;
constexpr size_t W_WUP = W_WOUT + (size_t)1024 * 1024 * 2;
constexpr size_t W_WDN = W_WUP + (size_t)5632 * 1024 * 2;
constexpr size_t W_DT = W_WDN + (size_t)1024 * 2816 * 2;
constexpr size_t W_ACS = W_DT + (size_t)TA * 8 * 4;
constexpr size_t W_DEC = W_ACS + (size_t)TA * 8 * 4;
constexpr size_t W_G = W_DEC + (size_t)272 * 8 * 4;
constexpr size_t W_SS2 = W_G + (size_t)16 * 8192 * 4;
constexpr size_t W_SS3 = W_SS2 + (size_t)TA * 4;
constexpr size_t W_CSS = W_SS3 + (size_t)TA * 4;
constexpr size_t W_BAR = W_CSS + (size_t)16 * 65536 * 4;
constexpr size_t W_CNT = W_BAR + 16384;
constexpr size_t W_SATT = W_BAR + 32768;
constexpr size_t W_RA = (W_SATT + (size_t)256 * 512 * 2 + 255) / 256 * 256;
constexpr size_t SZ_RA = (size_t)TA * 1024 * 2;
constexpr size_t W_RB = W_RA + SZ_RA;
constexpr size_t W_Z = W_RB + SZ_RA;
constexpr size_t SZ_H = (size_t)TA * 512 * 2;
constexpr size_t W_Q = W_Z + SZ_H;
constexpr size_t W_K = W_Q + SZ_H;
constexpr size_t W_V = W_K + SZ_H;
constexpr size_t W_CG = W_V + SZ_H;
constexpr size_t W_U = W_RB;
constexpr size_t W_HALO = W_RB;
constexpr size_t SZ_U = (size_t)TA * 2816 * 2;
constexpr size_t W_ACT = W_V + SZ_H;
constexpr size_t W_END = W_ACT + SZ_U;
static_assert(W_U + SZ_U <= W_ACT, "U overlaps ACT");
static_assert(W_END <= (size_t)256 * 1024 * 1024, "workspace too large");

struct Params {
    const float* x_prompt; const float* x_sample; const float* cache_k; const float* cache_v; const float* cache_logf;
    const float* state_ssd; const float* state_ssd_conv; const float* state_ffn_conv; const float* norm1_g; const float* w_in;
    const float* ssd_conv_w; const float* ssd_conv_b; const float* ssd_dt_bias; const float* ssd_a_log; const float* ssd_d;
    const float* ssd_norm_g; const float* fox_f_bias; const float* w_out; const float* norm2_g; const float* w_up;
    const float* ffn_conv_w; const float* ffn_conv_b; const float* w_down; const float* final_norm_g;
    float* out; unsigned char* ws;
};

DEV unsigned cvtpk(float lo, float hi) { unsigned r; asm("v_cvt_pk_bf16_f32 %0, %1, %2" : "=v"(r) : "v"(lo), "v"(hi)); return r; }
DEV bf16_t f2bf(float f) { return (bf16_t)(cvtpk(f, 0.f) & 0xffffu); }
DEV float bf2f(bf16_t b) { return __uint_as_float(((unsigned)b) << 16); }
DEV float bflo(unsigned u) { return __uint_as_float(u << 16); }
DEV float bfhi(unsigned u) { return __uint_as_float(u & 0xffff0000u); }
DEV float silu_f(float x) { return x * __builtin_amdgcn_rcpf(1.f + __builtin_amdgcn_exp2f(x * -LOG2E)); }
DEV float softplus_f(float x) { return x > 20.f ? x : log1pf(expf(x)); }
DEV float wave_sum(float v) {
#pragma unroll
    for (int o = 32; o > 0; o >>= 1) v += __shfl_xor(v, o);
    return v;
}
DEV float wave_max(float v) {
#pragma unroll
    for (int o = 32; o > 0; o >>= 1) v = fmaxf(v, __shfl_xor(v, o));
    return v;
}
DEV int up_natcol(int r) { const int pn = r >> 8, i = r & 255; return i < 128 ? pn * 128 + i : DFF + pn * 128 + (i - 128); }

constexpr int BM = 256, BK = 64, HALF = 128, HT = HALF * BK;
DEV int lds_byte(int r, int c) { int st = (r >> 4) * 2 + (c >> 5), rr = r & 15, cc = c & 31, ob = rr * 64 + cc * 2; return st * 1024 + (ob ^ (((ob >> 9) & 1) << 5)); }
DEV void stage_rc(int b, int& R, int& C) { int st = b / 1024, sb = b % 1024, swz = sb ^ (((sb >> 9) & 1) << 5); R = (st >> 1) * 16 + swz / 64; C = (st & 1) * 32 + (swz % 64) / 2; }

struct NoPre { DEV void operator()(int, int) const {} };
template <class Epi, class Pre = NoPre>
DEV void gemm_phase(const bf16_t* __restrict__ A, const bf16_t* __restrict__ Bt, const int M, const int N, const int K, const Epi& epi, const Pre& pre = Pre()) {
    extern __shared__ __attribute__((aligned(16))) bf16_t shm[];
#define SA(b, h) (shm + ((b) * 2 + (h)) * HT)
#define SB(b, h) (shm + (4 + (b) * 2 + (h)) * HT)
#define STAGE(P, BASE, br, kt) do { const char* _gb = (const char*)(BASE + (long)(br) * K + (long)(kt) * BK); \
      __builtin_amdgcn_global_load_lds((const unsigned*)(_gb + so0), (unsigned*)((char*)(P) + tid16), 16, 0, 0); \
      __builtin_amdgcn_global_load_lds((const unsigned*)(_gb + so1), (unsigned*)((char*)(P) + tid16 + 8192), 16, 0, 0); } while (0)
#define LDA(dst, b, h) for (int m = 0; m < 4; ++m) for (int k = 0; k < 2; ++k) \
    dst[m][k] = *reinterpret_cast<const bf16x8*>((char*)SA(b, h) + lds_byte(wr * 64 + m * 16 + fr, k * 32 + fq * 8))
#define LDB(dst, b, h) for (int n = 0; n < 2; ++n) for (int k = 0; k < 2; ++k) \
    dst[n][k] = *reinterpret_cast<const bf16x8*>((char*)SB(b, h) + lds_byte(wc * 32 + n * 16 + fr, k * 32 + fq * 8))
#define MMA(ai, bj, At_, Bt_) do { __builtin_amdgcn_s_setprio(1); \
    for (int m = 0; m < 4; ++m) for (int n = 0; n < 2; ++n) for (int k = 0; k < 2; ++k) \
      acc[ai][bj][m][n] = __builtin_amdgcn_mfma_f32_16x16x32_bf16(Bt_[n][k], At_[m][k], acc[ai][bj][m][n], 0, 0, 0); \
    __builtin_amdgcn_s_setprio(0); } while (0)
#define WAIT_V(n) asm volatile("s_waitcnt vmcnt(" #n ")" ::: "memory")
#define WAIT_L(n) asm volatile("s_waitcnt lgkmcnt(" #n ")" ::: "memory")
#define BAR __builtin_amdgcn_s_barrier()
#define SCHED __builtin_amdgcn_sched_barrier(0)
    const int nM = M / BM, nN = N / BM, nwg = nM * nN;
    int tidg = threadIdx.x; asm volatile("" : "+v"(tidg));
    const int wid = tidg >> 6, lane = tidg & 63, wr = wid >> 2, wc = wid & 3, fr = lane & 15, fq = lane >> 4;
    const int nt = K / BK;
    const int tid16 = tidg * 16;
    unsigned so0, so1; { int r_, c_; stage_rc(tid16, r_, c_); so0 = (unsigned)(r_ * K + c_) * 2u; stage_rc(tid16 + 8192, r_, c_); so1 = (unsigned)(r_ * K + c_) * 2u; }
    for (int L = blockIdx.x; L < nwg; L += gridDim.x) {
        int wgid = L;
        { int q = nwg / 8, r = nwg % 8, xcd = wgid % 8, off = wgid / 8; wgid = (xcd < r ? xcd * (q + 1) : r * (q + 1) + (xcd - r) * q) + off; }
        const int nig = 8 * nN, gid = wgid / nig, fm = gid * 8, gsz = min(nM - fm, 8);
        const int pm = fm + ((wgid % nig) % gsz), pn = (wgid % nig) / gsz, brow = pm * BM, bcol = pn * BM;
        pre(pm, pn);
        f32x4 acc[2][2][4][2];
#pragma unroll
        for (int a = 0; a < 2; ++a)
#pragma unroll
            for (int b = 0; b < 2; ++b)
#pragma unroll
                for (int m = 0; m < 4; ++m)
#pragma unroll
                    for (int n = 0; n < 2; ++n) acc[a][b][m][n] = (f32x4){0.f, 0.f, 0.f, 0.f};
        bf16x8 At[4][2], B0[2][2], B1[2][2];
        STAGE(SB(0, 0), Bt, bcol, 0); STAGE(SA(0, 0), A, brow, 0);
        STAGE(SB(0, 1), Bt, bcol + HALF, 0); STAGE(SA(0, 1), A, brow + HALF, 0);
        if (wr == 1) BAR;
        WAIT_V(4); BAR;
        STAGE(SB(1, 0), Bt, bcol, 1); STAGE(SA(1, 0), A, brow, 1); STAGE(SB(1, 1), Bt, bcol + HALF, 1);
        WAIT_V(6); BAR;
        for (int t = 0; t < nt - 2; t += 2) {
            LDB(B0, 0, 0); SCHED; LDA(At, 0, 0); STAGE(SA(1, 1), A, brow + HALF, t + 1);
            WAIT_L(8); BAR; WAIT_L(0); MMA(0, 0, At, B0); BAR; SCHED;
            LDB(B1, 0, 1); STAGE(SB(0, 0), Bt, bcol, t + 2);
            BAR; WAIT_L(0); MMA(0, 1, At, B1); BAR;
            LDA(At, 0, 1); STAGE(SA(0, 0), A, brow, t + 2);
            BAR; WAIT_L(0); MMA(1, 0, At, B0); BAR; SCHED;
            STAGE(SB(0, 1), Bt, bcol + HALF, t + 2);
            WAIT_V(6); BAR; MMA(1, 1, At, B1); BAR;
            LDB(B0, 1, 0); SCHED; LDA(At, 1, 0); STAGE(SA(0, 1), A, brow + HALF, t + 2);
            WAIT_L(8); BAR; WAIT_L(0); MMA(0, 0, At, B0); BAR; SCHED;
            LDB(B1, 1, 1); STAGE(SB(1, 0), Bt, bcol, t + 3);
            BAR; WAIT_L(0); MMA(0, 1, At, B1); BAR;
            LDA(At, 1, 1); STAGE(SA(1, 0), A, brow, t + 3);
            BAR; WAIT_L(0); MMA(1, 0, At, B0); BAR; SCHED;
            STAGE(SB(1, 1), Bt, bcol + HALF, t + 3);
            WAIT_V(6); BAR; MMA(1, 1, At, B1); BAR;
        }
        { LDB(B0, 0, 0); LDA(At, 0, 0); STAGE(SA(1, 1), A, brow + HALF, nt - 1);
          BAR; WAIT_L(0); MMA(0, 0, At, B0); BAR;
          LDB(B1, 0, 1); BAR; WAIT_L(0); MMA(0, 1, At, B1); BAR;
          LDA(At, 0, 1); WAIT_V(4); BAR; WAIT_L(0); MMA(1, 0, At, B0); MMA(1, 1, At, B1); BAR; }
        { LDB(B0, 1, 0); LDA(At, 1, 0); WAIT_V(2); BAR; WAIT_L(0); MMA(0, 0, At, B0); BAR;
          LDB(B1, 1, 1); WAIT_V(0); BAR; WAIT_L(0); MMA(0, 1, At, B1); BAR;
          LDA(At, 1, 1); BAR; WAIT_L(0); MMA(1, 0, At, B0); MMA(1, 1, At, B1); BAR; }
        if (wr == 0) BAR;
        { int t2 = threadIdx.x; asm volatile("" : "+v"(t2)); const int w2 = t2 >> 6, l2 = t2 & 63; epi(acc, pm, pn, w2 >> 2, w2 & 3, l2 & 15, l2 >> 4); }
    }
#undef SA
#undef SB
#undef STAGE
#undef LDA
#undef LDB
#undef MMA
}

#define EPI_LOOP_BEGIN \
    _Pragma("unroll") for (int ai = 0; ai < 2; ++ai) _Pragma("unroll") for (int m = 0; m < 4; ++m) { \
        const int row = pm * BM + ai * HALF + wr * 64 + m * 16 + fr;
#define EPI_COLS_BEGIN \
        _Pragma("unroll") for (int bj = 0; bj < 2; ++bj) _Pragma("unroll") for (int n = 0; n < 2; ++n) { \
            const int col = pn * BM + bj * HALF + wc * 32 + n * 16 + fq * 4; const f32x4 v = acc[ai][bj][m][n];

struct EpiIn {
    bf16_t *Z, *XBC, *Q, *K, *V; float* out;
    DEV void operator()(const f32x4 (&acc)[2][2][4][2], int pm, int pn, int wr, int wc, int fr, int fq) const {
        EPI_LOOP_BEGIN
            const bool smp = row >= TP; const int rs = row - TP;
            EPI_COLS_BEGIN
                if (pn < 2) { *(u32x2*)(Z + (size_t)row * 512 + col) = (u32x2){cvtpk(v[0], v[1]), cvtpk(v[2], v[3])}; }
                else if (pn < 6) { const int c = col - 512; *(u32x2*)(XBC + (size_t)row * 1024 + c) = (u32x2){cvtpk(v[0], v[1]), cvtpk(v[2], v[3])};
                    if (!smp) { const int t = row & 8191; if (t >= 8189) *(f32x4*)(out + O_PSC + (size_t)((row >> 13) * 3 + (t - 8189)) * 1024 + c) = v; }
                    else { const int t = rs & 15; if (t >= 13) *(f32x4*)(out + O_SSC + (size_t)((rs >> 4) * 3 + (t - 13)) * 1024 + c) = v; } }
                else if (pn < 8) { const int c = col - 1536; *(u32x2*)(Q + (size_t)row * 512 + c) = (u32x2){cvtpk(v[0] * QSCALE, v[1] * QSCALE), cvtpk(v[2] * QSCALE, v[3] * QSCALE)}; }
                else if (pn < 10) { const int c = col - 2048; *(u32x2*)(K + (size_t)row * 512 + c) = (u32x2){cvtpk(v[0], v[1]), cvtpk(v[2], v[3])};
                    if (!smp) *(f32x4*)(out + O_PK + (size_t)row * 512 + c) = v; else *(f32x4*)(out + O_SK + (size_t)rs * 512 + c) = v; }
                else { const int c = col - 2560; *(u32x2*)(V + (size_t)row * 512 + c) = (u32x2){cvtpk(v[0], v[1]), cvtpk(v[2], v[3])};
                    if (!smp) *(f32x4*)(out + O_PV + (size_t)row * 512 + c) = v; else *(f32x4*)(out + O_SV + (size_t)rs * 512 + c) = v; }
            }
        }
    }
};

struct EpiOut {
    const float* xp; const float* xs; float* H; bf16_t* Hb; float* SS;
    DEV void operator()(const f32x4 (&acc)[2][2][4][2], int pm, int pn, int wr, int wc, int fr, int fq) const {
        EPI_LOOP_BEGIN
            const float* xr = row < TP ? xp + (size_t)row * 1024 : xs + (size_t)(row - TP) * 1024; float ss = 0.f;
            EPI_COLS_BEGIN
                const f32x4 h = v + *(const f32x4*)(xr + col);
                *(u32x2*)(Hb + (size_t)row * 1024 + col) = (u32x2){cvtpk(h[0], h[1]), cvtpk(h[2], h[3])};
                ss += h[0] * h[0] + h[1] * h[1] + h[2] * h[2] + h[3] * h[3];
            }
            ss += __shfl_xor(ss, 16); ss += __shfl_xor(ss, 32);
            if (fq == 0) atomicAdd(SS + row, ss);
        }
    }
};

struct EpiUp {
    const float* SS; bf16_t* U; float* out; int hf;
    DEV void operator()(const f32x4 (&acc)[2][2][4][2], int pm, int pn, int wr, int wc, int fr, int fq) const {
        EPI_LOOP_BEGIN
            const float rs = rsqrtf(SS[row] * (1.f / 1024.f) + EPS);
            float* st = nullptr;
            if (row < TP) { const int t = row & 8191; if (t >= 8190) st = out + O_PFC + (size_t)((row >> 13) * 2 + (t - 8190)) * NUP; }
            else { const int r2 = row - TP, t = r2 & 15; if (t >= 14) st = out + O_SFC + (size_t)((r2 >> 4) * 2 + (t - 14)) * NUP; }
            EPI_COLS_BEGIN
                const f32x4 u = v * rs;
                *(u32x2*)(U + (size_t)row * DFF + col) = (u32x2){cvtpk(u[0], u[1]), cvtpk(u[2], u[3])};
                if (st) *(f32x4*)(st + up_natcol(hf * DFF + col)) = u;
            }
        }
    }
};

constexpr int TPITCH = 528;
struct EpiUpFused {
    const float* SS; float* out; bf16_t* ACT; bf16_t* HALO; const float* cw; const float* cbias; const float* stf; char* lds;
    DEV void operator()(const f32x4 (&acc)[2][2][4][2], int pm, int pn, int wr, int wc, int fr, int fq) const {
        int tid = threadIdx.x; asm volatile("" : "+v"(tid));
        const int lc = (tid & 31) * 4, run = tid >> 5, ja = pn * 128 + lc; const bool smp = pm == 64;
        float wg[3][4], wv[3][4], bg[4], bv[4];
#pragma unroll
        for (int e = 0; e < 4; ++e) { bg[e] = cbias[ja + e]; bv[e] = cbias[DFF + ja + e];
#pragma unroll
            for (int j = 0; j < 3; ++j) { wg[j][e] = cw[j * NUP + ja + e]; wv[j][e] = cw[j * NUP + DFF + ja + e]; } }
        float ssq[8];
#pragma unroll
        for (int q = 0; q < 8; ++q) ssq[q] = SS[pm * BM + (q >> 2) * HALF + wr * 64 + (q & 3) * 16 + fr];
        EPI_LOOP_BEGIN
            const float rs = rsqrtf(ssq[ai * 4 + m] * (1.f / 1024.f) + EPS);
            float* st = nullptr;
            if (row < TP) { const int t = row & 8191; if (t >= 8190) st = out + O_PFC + (size_t)((row >> 13) * 2 + (t - 8190)) * NUP; }
            else { const int r2 = row - TP, t = r2 & 15; if (t >= 14) st = out + O_SFC + (size_t)((r2 >> 4) * 2 + (t - 14)) * NUP; }
            const int rl = row - pm * BM;
            EPI_COLS_BEGIN
                const f32x4 u = v * rs;
                *(u32x2*)(lds + rl * TPITCH + (col - pn * BM) * 2) = (u32x2){cvtpk(u[0], u[1]), cvtpk(u[2], u[3])};
                if (st) *(f32x4*)(st + up_natcol(col)) = u;
            }
        }
        __syncthreads();
        if (tid < 256) { const int r4 = tid >> 6, c = (tid & 63) * 4, rowl = r4 < 2 ? r4 : 252 + r4;
            *(u32x2*)(HALO + (size_t)(pm * 4 + r4) * NUP + pn * BM + c) = *(const u32x2*)(lds + rowl * TPITCH + c * 2); }
        auto ldrow = [&](int rowl, float* g, float* vv) { const u32x2 a = *(const u32x2*)(lds + rowl * TPITCH + lc * 2), c = *(const u32x2*)(lds + rowl * TPITCH + (128 + lc) * 2);
            g[0] = bflo(a[0]); g[1] = bfhi(a[0]); g[2] = bflo(a[1]); g[3] = bfhi(a[1]); vv[0] = bflo(c[0]); vv[1] = bfhi(c[0]); vv[2] = bflo(c[1]); vv[3] = bfhi(c[1]); };
        float g2[4], g1[4], v2[4], v1[4]; int rstart = 0;
        if (smp) { const float* s0 = stf + (size_t)(run * 2) * NUP, *s1 = s0 + NUP;
#pragma unroll
            for (int e = 0; e < 4; ++e) { g2[e] = s0[ja + e]; v2[e] = s0[DFF + ja + e]; g1[e] = s1[ja + e]; v1[e] = s1[DFF + ja + e]; } }
        else if (run == 0) { ldrow(0, g2, v2); ldrow(1, g1, v1); rstart = 2; }
        else { ldrow(16 * run - 2, g2, v2); ldrow(16 * run - 1, g1, v1); }
#pragma unroll 4
        for (int r = rstart; r < 16; ++r) { const int rowl = 16 * run + r; float g0[4], v0[4]; ldrow(rowl, g0, v0);
            float a[4];
#pragma unroll
            for (int e = 0; e < 4; ++e) { const float cg = bg[e] + wg[0][e] * g2[e] + wg[1][e] * g1[e] + wg[2][e] * g0[e], cv = bv[e] + wv[0][e] * v2[e] + wv[1][e] * v1[e] + wv[2][e] * v0[e];
                a[e] = silu_f(cg) * cv; g2[e] = g1[e]; g1[e] = g0[e]; v2[e] = v1[e]; v1[e] = v0[e]; }
            *(u32x2*)(ACT + (size_t)(pm * BM + rowl) * DFF + ja) = (u32x2){cvtpk(a[0], a[1]), cvtpk(a[2], a[3])}; }
        __syncthreads();
    }
};
struct FfnFixup { const Params* pp;
    DEV void operator()(int pm, int pn) const {
        const Params& p = *pp; unsigned char* ws = p.ws; const bf16_t* HALO = (const bf16_t*)(ws + W_HALO); bf16_t* ACT = (bf16_t*)(ws + W_ACT);
        if (pm >= 64) return;
        int tid = threadIdx.x; asm volatile("" : "+v"(tid));
        for (int it = tid; it < 2 * 352; it += 512) {
            const int cg8 = it % 352, rr = it / 352; const int ja = cg8 * 8, pc = (ja >> 7) * 256 + (ja & 127);
            const bool first = (pm & 31) == 0;
            float g[3][8], v[3][8];
            auto unpack = [&](const bf16_t* rowp, float* go, float* vo) { const u32x4 a = *(const u32x4*)(rowp + pc), c = *(const u32x4*)(rowp + pc + 128);
#pragma unroll
                for (int e = 0; e < 4; ++e) { go[2 * e] = bflo(a[e]); go[2 * e + 1] = bfhi(a[e]); vo[2 * e] = bflo(c[e]); vo[2 * e + 1] = bfhi(c[e]); } };
            auto zero = [&](float* go, float* vo) {
#pragma unroll
                for (int e = 0; e < 8; ++e) { go[e] = 0.f; vo[e] = 0.f; } };
            const bf16_t* mine = HALO + (size_t)(pm * 4) * NUP; const bf16_t* prev = HALO + (size_t)((pm - 1) * 4) * NUP;
            unpack(mine + (size_t)rr * NUP, g[2], v[2]);
            if (rr == 1) { unpack(mine, g[1], v[1]); if (first) zero(g[0], v[0]); else unpack(prev + (size_t)3 * NUP, g[0], v[0]); }
            else { if (first) { zero(g[1], v[1]); zero(g[0], v[0]); } else { unpack(prev + (size_t)3 * NUP, g[1], v[1]); unpack(prev + (size_t)2 * NUP, g[0], v[0]); } }
            u32x4 o;
#pragma unroll
            for (int e = 0; e < 4; ++e) { float a[2];
#pragma unroll
                for (int q = 0; q < 2; ++q) { const int i = 2 * e + q; float cg = p.ffn_conv_b[ja + i], cv = p.ffn_conv_b[DFF + ja + i];
#pragma unroll
                    for (int j = 0; j < 3; ++j) { cg += p.ffn_conv_w[j * NUP + ja + i] * g[j][i]; cv += p.ffn_conv_w[j * NUP + DFF + ja + i] * v[j][i]; }
                    a[q] = silu_f(cg) * cv; }
                o[e] = cvtpk(a[0], a[1]); }
            *(u32x4*)(ACT + (size_t)(pm * BM + rr) * DFF + ja) = o;
        }
        asm volatile("s_waitcnt vmcnt(0)" ::: "memory");
        __syncthreads();
    }
};

struct EpiDown {
    const bf16_t* Hb; float* SS; float* Ho;
    DEV void operator()(const f32x4 (&acc)[2][2][4][2], int pm, int pn, int wr, int wc, int fr, int fq) const {
        EPI_LOOP_BEGIN
            float ss = 0.f;
            EPI_COLS_BEGIN
                const size_t hoff = (size_t)row * 1024 + col;
                const u32x2 hb = *(const u32x2*)(Hb + hoff); const f32x4 h = v + (f32x4){bflo(hb[0]), bfhi(hb[0]), bflo(hb[1]), bfhi(hb[1])};
                *(f32x4*)(Ho + hoff) = h;
                ss += h[0] * h[0] + h[1] * h[1] + h[2] * h[2] + h[3] * h[3];
            }
            ss += __shfl_xor(ss, 16); ss += __shfl_xor(ss, 32);
            if (fq == 0) atomicAdd(SS + row, ss);
        }
    }
};

struct NoPost { DEV void operator()(int) const {} };
template <int NT = 1, class EpiE, class Post = NoPost>
DEV void sample_gemm(const bf16_t* __restrict__ A, const bf16_t* __restrict__ Bt, const int N, const int K, const EpiE& epi, char* lds, const Post& post = Post()) {
    int tid = threadIdx.x; asm volatile("" : "+v"(tid));
    const int lane = tid & 63, wid = tid >> 6, fr = lane & 15, fq = lane >> 4;
    constexpr int TW = 32 * NT;
    float* red = (float*)lds;
    const int ntile = 8 * (N / TW), kw = K / 8;
    for (int mt = blockIdx.x; mt < ntile; mt += gridDim.x) {
        const int r0 = (mt & 7) * 32, c0 = (mt >> 3) * TW;
        f32x4 acc[2][2 * NT];
#pragma unroll
        for (int i = 0; i < 2; ++i)
#pragma unroll
            for (int j = 0; j < 2 * NT; ++j) acc[i][j] = (f32x4){0.f, 0.f, 0.f, 0.f};
        const bf16_t* Ap = A + (size_t)(TP + r0 + fr) * K + wid * kw + fq * 8;
        const bf16_t* Bp = Bt + (size_t)(c0 + fr) * K + wid * kw + fq * 8;
#pragma unroll
        for (int ks = 0; ks < kw; ks += 32) {
            const bf16x8 a0 = *(const bf16x8*)(Ap + ks), a1 = *(const bf16x8*)(Ap + (size_t)16 * K + ks);
#pragma unroll
            for (int j = 0; j < 2 * NT; ++j) { const bf16x8 bj = *(const bf16x8*)(Bp + (size_t)(16 * j) * K + ks);
                acc[0][j] = __builtin_amdgcn_mfma_f32_16x16x32_bf16(bj, a0, acc[0][j], 0, 0, 0); acc[1][j] = __builtin_amdgcn_mfma_f32_16x16x32_bf16(bj, a1, acc[1][j], 0, 0, 0); }
        }
#pragma unroll
        for (int i = 0; i < 2; ++i)
#pragma unroll
            for (int j = 0; j < 2 * NT; ++j) *(f32x4*)(red + wid * (32 * TW) + (16 * i + fr) * TW + 16 * j + 4 * fq) = acc[i][j];
        __syncthreads();
#pragma unroll
        for (int q = 0; q < NT; ++q) { const int idx = tid + 512 * q, row = idx / (TW / 2), col = (idx % (TW / 2)) * 2; float v0 = 0.f, v1 = 0.f;
#pragma unroll
            for (int w = 0; w < 8; ++w) { const float2 t = *(const float2*)(red + w * (32 * TW) + row * TW + col); v0 += t.x; v1 += t.y; }
            epi(TP + r0 + row, c0 + col, v0, v1, lane); }
        __syncthreads();
        post(mt);
    }
}
struct EpiInE { bf16_t *Z, *XBC, *Q, *K, *V; float* out;
    DEV void operator()(int row, int col, float v0, float v1, int lane) const { const int rs = row - TP;
        if (col < 512) *(unsigned*)(Z + (size_t)row * 512 + col) = cvtpk(v0, v1);
        else if (col < 1536) { const int c = col - 512; *(unsigned*)(XBC + (size_t)row * 1024 + c) = cvtpk(v0, v1); const int t = rs & 15;
            if (t >= 13) *(float2*)(out + O_SSC + (size_t)((rs >> 4) * 3 + (t - 13)) * 1024 + c) = make_float2(v0, v1); }
        else if (col < 2048) *(unsigned*)(Q + (size_t)row * 512 + col - 1536) = cvtpk(v0 * QSCALE, v1 * QSCALE);
        else if (col < 2560) { const int c = col - 2048; *(unsigned*)(K + (size_t)row * 512 + c) = cvtpk(v0, v1); *(float2*)(out + O_SK + (size_t)rs * 512 + c) = make_float2(v0, v1); }
        else { const int c = col - 2560; *(unsigned*)(V + (size_t)row * 512 + c) = cvtpk(v0, v1); *(float2*)(out + O_SV + (size_t)rs * 512 + c) = make_float2(v0, v1); } } };
struct EpiResE { const float* res; const bf16_t* resb; float* H; bf16_t* Hb; float* SS;
    DEV void operator()(int row, int col, float v0, float v1, int lane) const {
        float h0, h1; if (res) { const float2 r = *(const float2*)(res + (size_t)row * 1024 + col); h0 = r.x + v0; h1 = r.y + v1; } else { const unsigned r = *(const unsigned*)(resb + (size_t)row * 1024 + col); h0 = bflo(r) + v0; h1 = bfhi(r) + v1; }
        if (H) *(float2*)(H + (size_t)row * 1024 + col) = make_float2(h0, h1);
        if (Hb) *(unsigned*)(Hb + (size_t)row * 1024 + col) = cvtpk(h0, h1);
        float ss = h0 * h0 + h1 * h1; ss += __shfl_xor(ss, 1); ss += __shfl_xor(ss, 2); ss += __shfl_xor(ss, 4); ss += __shfl_xor(ss, 8);
        if ((lane & 15) == 0) atomicAdd(SS + row, ss); } };

DEV float reduce16(float (&a)[16], int lane) {
    { const bool hi = lane & 32;
#pragma unroll
      for (int i = 0; i < 8; ++i) { const float send = hi ? a[i] : a[i + 8]; const float keep = hi ? a[i + 8] : a[i]; a[i] = keep + __shfl_xor(send, 32); } }
    { const bool hi = lane & 16;
#pragma unroll
      for (int i = 0; i < 4; ++i) { const float send = hi ? a[i] : a[i + 4]; const float keep = hi ? a[i + 4] : a[i]; a[i] = keep + __shfl_xor(send, 16); } }
    { const bool hi = lane & 8;
#pragma unroll
      for (int i = 0; i < 2; ++i) { const float send = hi ? a[i] : a[i + 2]; const float keep = hi ? a[i + 2] : a[i]; a[i] = keep + __shfl_xor(send, 8); } }
    { const bool hi = lane & 4; const float send = hi ? a[0] : a[1]; const float keep = hi ? a[1] : a[0]; a[0] = keep + __shfl_xor(send, 4); }
    a[0] += __shfl_xor(a[0], 2); a[0] += __shfl_xor(a[0], 1);
    return a[0];
}

template <class CS>
DEV void transpose4(const float* __restrict__ W, int ldw, int k0, const CS& cs, bf16_t* __restrict__ WT, int ldt, int r0, const float* __restrict__ gk, float* tile) {
    int tid = threadIdx.x; asm volatile("" : "+v"(tid));
    float v[4][8];
#pragma unroll
    for (int s = 0; s < 4; ++s) { const int c0 = cs(s);
#pragma unroll
        for (int e = 0; e < 8; ++e) { const int idx = tid + e * 512, j = idx >> 6, i = idx & 63; v[s][e] = W[(size_t)(k0 + j) * ldw + c0 + i]; } }
#pragma unroll
    for (int e = 0; e < 8; ++e) { const int idx = tid + e * 512, j = idx >> 6, i = idx & 63; const float g = gk ? gk[k0 + j] : 1.f;
#pragma unroll
        for (int s = 0; s < 4; ++s) tile[s * 4160 + j * 65 + i] = v[s][e] * g; }
    __syncthreads();
#pragma unroll
    for (int s = 0; s < 4; ++s)
#pragma unroll
        for (int e = 0; e < 4; ++e) { const int idx = tid + e * 512, i = idx >> 5, j2 = (idx & 31) * 2;
            *(unsigned*)(WT + (size_t)(r0 + 64 * s + i) * ldt + k0 + j2) = cvtpk(tile[s * 4160 + j2 * 65 + i], tile[s * 4160 + (j2 + 1) * 65 + i]); }
    __syncthreads();
}

DEV void weight_unit(const Params& p, int u, float* tile) {
    unsigned char* ws = p.ws;
    if (u < 192) { const int kt = u & 15, nb = u >> 4; const int r0 = nb * 256; const int c0 = r0 < 1536 ? r0 : r0 + 8;
        transpose4(p.w_in, INC, kt * 64, [&](int s) { return c0 + 64 * s; }, (bf16_t*)(ws + W_WIN), 1024, r0, nullptr, tile); }
    else if (u < 256) { const int v = u - 192, kt = v & 15, nb = v >> 4;
        transpose4(p.w_out, 1024, kt * 64, [&](int s) { return nb * 256 + 64 * s; }, (bf16_t*)(ws + W_WOUT), 1024, nb * 256, nullptr, tile); }
    else if (u < 608) { const int v = u - 256, kt = v & 15, nb = v >> 4;
        transpose4(p.w_up, NUP, kt * 64, [&](int s) { return up_natcol(nb * 256 + 64 * s); }, (bf16_t*)(ws + W_WUP), 1024, nb * 256, p.norm2_g, tile); }
    else { const int v = u - 608, kt = v % 44, nb = v / 44;
        transpose4(p.w_down, 1024, kt * 64, [&](int s) { return nb * 256 + 64 * s; }, (bf16_t*)(ws + W_WDN), DFF, nb * 256, nullptr, tile); }
}
DEV void weight_units_on_idle(const Params& p, int u0, int u1, int lo_want, char* lds) {
    const int lo = (int)gridDim.x > lo_want + 32 ? lo_want : 0;
    if ((int)blockIdx.x >= lo) for (int u = u0 + (int)blockIdx.x - lo; u < u1; u += (int)gridDim.x - lo) weight_unit(p, u, (float*)lds);
}

DEV void phase0(const Params& p, char* lds) {
    unsigned char* ws = p.ws;
    const int tid = threadIdx.x, lane = tid & 63, wid = tid >> 6;
    float* tile = (float*)lds;
    float* thin = (float*)(lds + 32768);
    for (int u = blockIdx.x; u < 192; u += gridDim.x) weight_unit(p, u, tile);
    for (int idx = tid; idx < 4096; idx += 512) { const int k = idx >> 2, part = idx & 3; const f32x4 v = *(const f32x4*)(p.w_in + (size_t)k * INC + (part < 2 ? 1536 + 4 * part : 3080 + 4 * (part - 2)));
        thin[(4 * part) * 1024 + k] = v[0]; thin[(4 * part + 1) * 1024 + k] = v[1]; thin[(4 * part + 2) * 1024 + k] = v[2]; thin[(4 * part + 3) * 1024 + k] = v[3]; }
    for (int i = blockIdx.x * 512 + tid; i < 2 * TA; i += gridDim.x * 512) ((float*)(ws + W_SS2))[i] = 0.f;
    __syncthreads();
    bf16_t* XN = (bf16_t*)(ws + W_RA); float* DT = (float*)(ws + W_DT);
    const int rstep = gridDim.x * 8;
    f32x4 gq[4];
#pragma unroll
    for (int i = 0; i < 4; ++i) gq[i] = *(const f32x4*)(p.norm1_g + i * 256 + lane * 4);
    for (int row0 = blockIdx.x * 8 + wid; row0 < TA; row0 += 2 * rstep) {
        const bool two = row0 + rstep < TA;
        f32x4 x[2][4]; float ss[2] = {0.f, 0.f};
#pragma unroll
        for (int rr = 0; rr < 2; ++rr) { const int row = (rr == 0 || two) ? row0 + rr * rstep : row0;
            const float* xr = row < TP ? p.x_prompt + (size_t)row * 1024 : p.x_sample + (size_t)(row - TP) * 1024;
#pragma unroll
            for (int i = 0; i < 4; ++i) { x[rr][i] = *(const f32x4*)(xr + i * 256 + lane * 4); ss[rr] += x[rr][i][0] * x[rr][i][0] + x[rr][i][1] * x[rr][i][1] + x[rr][i][2] * x[rr][i][2] + x[rr][i][3] * x[rr][i][3]; } }
#pragma unroll
        for (int rr = 0; rr < 2; ++rr) { const int row = row0 + rr * rstep; ss[rr] = wave_sum(ss[rr]); const float rs = rsqrtf(ss[rr] * (1.f / 1024.f) + EPS);
#pragma unroll
            for (int i = 0; i < 4; ++i) { x[rr][i] = x[rr][i] * rs * gq[i];
                if (rr == 0 || two) *(u32x2*)(XN + (size_t)row * 1024 + i * 256 + lane * 4) = (u32x2){cvtpk(x[rr][i][0], x[rr][i][1]), cvtpk(x[rr][i][2], x[rr][i][3])}; } }
        float pa0[16], pa1[16];
#pragma unroll
        for (int j = 0; j < 16; ++j) { float a0 = 0.f, a1 = 0.f;
#pragma unroll
            for (int i = 0; i < 4; ++i) { const f32x4 w = *(const f32x4*)(thin + j * 1024 + i * 256 + lane * 4);
                a0 += x[0][i][0] * w[0] + x[0][i][1] * w[1] + x[0][i][2] * w[2] + x[0][i][3] * w[3]; a1 += x[1][i][0] * w[0] + x[1][i][1] * w[1] + x[1][i][2] * w[2] + x[1][i][3] * w[3]; }
            pa0[j] = a0; pa1[j] = a1; }
        const int jj = (lane >> 2) & 15;
        const float m0 = reduce16(pa0, lane), m1 = reduce16(pa1, lane);
#pragma unroll
        for (int rr = 0; rr < 2; ++rr) { const int row = row0 + rr * rstep; const float mine = rr ? m1 : m0;
            if ((rr == 0 || two) && (lane & 3) == 0) {
                if (jj < 8) { DT[(size_t)row * 8 + jj] = softplus_f(mine + p.ssd_dt_bias[jj]); }
                else { const int h = jj - 8; const float lf = -softplus_f(-(mine + p.fox_f_bias[h]));
                    if (row < TP) p.out[O_PLF + (size_t)row * 8 + h] = lf; else p.out[O_SLF + (size_t)(row - TP) * 8 + h] = lf; } } }
    }
}

DEV void cumsum_prompt_unit(const Params& p, int b, char* lds) {
    int tid = threadIdx.x; asm volatile("" : "+v"(tid)); const int lane = tid & 63, wid = tid >> 6;
    constexpr int PITCH = 2308;
    float* buf = (float*)lds;
    const float* lf = p.out + O_PLF + (size_t)b * SEQ * 8;
    float* G = (float*)(p.ws + W_G) + ((size_t)b * 8 + wid) * SEQ;
    float carry = 0.f;
    for (int q = 0; q < 4; ++q) { const int t0 = q * 2048;
#pragma unroll
        for (int i = 0; i < 8; ++i) { const int idx = tid + 512 * i, t = idx >> 1, hh = (idx & 1) * 4; const f32x4 v = *(const f32x4*)(lf + (size_t)(t0 + t) * 8 + hh);
            const int o = t + 4 * (t >> 5);
            buf[hh * PITCH + o] = v[0]; buf[(hh + 1) * PITCH + o] = v[1]; buf[(hh + 2) * PITCH + o] = v[2]; buf[(hh + 3) * PITCH + o] = v[3]; }
        __syncthreads();
        float* seg = buf + wid * PITCH + 36 * lane; f32x4 v[8]; float run = 0.f;
#pragma unroll
        for (int j = 0; j < 8; ++j) { v[j] = *(const f32x4*)(seg + 4 * j); v[j][0] += run; v[j][1] += v[j][0]; v[j][2] += v[j][1]; v[j][3] += v[j][2]; run = v[j][3]; }
        float sc = run;
#pragma unroll
        for (int o = 1; o < 64; o <<= 1) { const float t = __shfl_up(sc, o); if (lane >= o) sc += t; }
        const float pre = carry + sc - run;
#pragma unroll
        for (int j = 0; j < 8; ++j) { v[j] = (v[j] + pre) * (-LOG2E); *(f32x4*)(seg + 4 * j) = v[j]; }
        carry += __shfl(sc, 63);
        __syncthreads();
#pragma unroll
        for (int j = 0; j < 8; ++j) { const int t = 4 * (lane + 64 * j); *(f32x4*)(G + t0 + t) = *(const f32x4*)(buf + wid * PITCH + t + 4 * (t >> 5)); }
        __syncthreads();
    }
}

DEV void sample_attn_unit(const Params& p, int b, int h, char* lds) {
    int tid = threadIdx.x; asm volatile("" : "+v"(tid)); const int lane = tid & 63, wid = tid >> 6, fr = lane & 15, fq = lane >> 4;
    float* bl = (float*)lds;
    float* red = (float*)(lds + 8448);
    float* red2 = (float*)(lds + 8960);
    float* stat = (float*)(lds + 9472);
    float* ored = (float*)(lds + 16384);
    const bf16_t* Q = (const bf16_t*)(p.ws + W_Q);
    const float* clf = p.cache_logf + (size_t)b * 2048 * 8 + h;
    { float v4[4]; float run = 0.f;
#pragma unroll
      for (int i = 0; i < 4; ++i) { run += clf[(size_t)(tid * 4 + i) * 8]; v4[i] = run; }
      float v = run;
#pragma unroll
      for (int o = 1; o < 64; o <<= 1) { const float t = __shfl_up(v, o); if (lane >= o) v += t; }
      if (lane == 63) red[wid] = v;
      __syncthreads();
      float add = v - run; for (int w = 0; w < wid; ++w) add += red[w];
#pragma unroll
      for (int i = 0; i < 4; ++i) bl[tid * 4 + i] = -(add + v4[i]) * LOG2E;
      if (tid == 511) { float f = add + run; for (int i = 0; i < 16; ++i) { f += p.out[O_SLF + (size_t)(b * 16 + i) * 8 + h]; bl[2048 + i] = -f * LOG2E; } }
      __syncthreads(); }
    bf16x8 qf[2];
#pragma unroll
    for (int k = 0; k < 2; ++k) qf[k] = *(const bf16x8*)(Q + (size_t)(TP + b * 16 + fr) * 512 + h * 64 + k * 32 + fq * 8);
    f32x4 sc[17];
#pragma unroll
    for (int i = 0; i < 17; ++i) { const int kt = wid + 8 * i; f32x4 c = (f32x4){-INFINITY, -INFINITY, -INFINITY, -INFINITY};
        if (kt < 129) {
            const float* kr = kt < 128 ? p.cache_k + ((size_t)(b * 2048 + kt * 16 + fr) * 8 + h) * 64 : p.out + O_SK + ((size_t)(b * 16 + fr) * 8 + h) * 64;
            c = *(const f32x4*)(bl + kt * 16 + fq * 4);
#pragma unroll
            for (int k = 0; k < 2; ++k) { const f32x4 a0 = *(const f32x4*)(kr + k * 32 + fq * 8), a1 = *(const f32x4*)(kr + k * 32 + fq * 8 + 4);
                const u32x4 av = (u32x4){cvtpk(a0[0], a0[1]), cvtpk(a0[2], a0[3]), cvtpk(a1[0], a1[1]), cvtpk(a1[2], a1[3])};
                c = __builtin_amdgcn_mfma_f32_16x16x32_bf16(__builtin_bit_cast(bf16x8, av), qf[k], c, 0, 0, 0); }
            if (kt == 128) {
#pragma unroll
                for (int j = 0; j < 4; ++j) if (fq * 4 + j > fr) c[j] = -INFINITY; }
        }
        sc[i] = c; }
    float m = -INFINITY;
#pragma unroll
    for (int i = 0; i < 17; ++i) m = fmaxf(m, fmaxf(fmaxf(sc[i][0], sc[i][1]), fmaxf(sc[i][2], sc[i][3])));
    m = fmaxf(m, __shfl_xor(m, 16)); m = fmaxf(m, __shfl_xor(m, 32));
    if (fq == 0) red[wid * 16 + fr] = m;
    __syncthreads();
    m = red[fr];
#pragma unroll
    for (int w = 1; w < 8; ++w) m = fmaxf(m, red[w * 16 + fr]);
    float l = 0.f;
#pragma unroll
    for (int i = 0; i < 17; ++i) {
#pragma unroll
        for (int j = 0; j < 4; ++j) { sc[i][j] = exp2f(sc[i][j] - m); l += sc[i][j]; } }
    l += __shfl_xor(l, 16); l += __shfl_xor(l, 32);
    if (fq == 0) red2[wid * 16 + fr] = l;
    __syncthreads();
    if (tid < 16) { float a = 0.f; for (int w = 0; w < 8; ++w) a += red2[w * 16 + tid]; stat[tid] = a; }
    f32x4 oT[4];
#pragma unroll
    for (int dt = 0; dt < 4; ++dt) oT[dt] = (f32x4){0.f, 0.f, 0.f, 0.f};
#pragma unroll
    for (int ii = 0; ii < 9; ++ii) { const int ktA = wid + 16 * ii, ktB = ktA + 8;
        if (ktA < 129) {
            const f32x4 sA = sc[2 * ii]; f32x4 sB = (f32x4){0.f, 0.f, 0.f, 0.f}; if (2 * ii + 1 < 17) sB = sc[(2 * ii + 1 < 17) ? 2 * ii + 1 : 0];
            const bool vB = ktB < 129;
            const u32x4 bv = (u32x4){cvtpk(sA[0], sA[1]), cvtpk(sA[2], sA[3]), vB ? cvtpk(sB[0], sB[1]) : 0u, vB ? cvtpk(sB[2], sB[3]) : 0u};
            const int keyA = ktA * 16 + fq * 4, keyB = ktB * 16 + fq * 4;
            const float* vA = keyA < 2048 ? p.cache_v + ((size_t)(b * 2048 + keyA) * 8 + h) * 64 : p.out + O_SV + ((size_t)(b * 16 + keyA - 2048) * 8 + h) * 64;
            const float* vBp = keyB < 2048 ? p.cache_v + ((size_t)(b * 2048 + keyB) * 8 + h) * 64 : p.out + O_SV + ((size_t)(b * 16 + (keyB - 2048)) * 8 + h) * 64;
#pragma unroll
            for (int dt = 0; dt < 4; ++dt) { float va[8];
#pragma unroll
                for (int e = 0; e < 4; ++e) { va[e] = vA[(size_t)e * 512 + dt * 16 + fr]; va[4 + e] = vB ? vBp[(size_t)e * 512 + dt * 16 + fr] : 0.f; }
                const u32x4 av = (u32x4){cvtpk(va[0], va[1]), cvtpk(va[2], va[3]), cvtpk(va[4], va[5]), cvtpk(va[6], va[7])};
                oT[dt] = __builtin_amdgcn_mfma_f32_16x16x32_bf16(__builtin_bit_cast(bf16x8, av), __builtin_bit_cast(bf16x8, bv), oT[dt], 0, 0, 0); }
        } }
#pragma unroll
    for (int dt = 0; dt < 4; ++dt) *(f32x4*)(ored + (wid * 16 + fr) * 64 + dt * 16 + fq * 4) = oT[dt];
    __syncthreads();
    bf16_t* SATT = (bf16_t*)(p.ws + W_SATT);
    for (int idx = tid; idx < 1024; idx += 512) { const int qi = idx >> 6, d = idx & 63; float a = 0.f;
#pragma unroll
        for (int w = 0; w < 8; ++w) a += ored[(w * 16 + qi) * 64 + d];
        SATT[(size_t)(b * 16 + qi) * 512 + h * 64 + d] = f2bf(a / stat[qi]); }
    __syncthreads();
}

struct SsdSrc { bool smp; int b, c, g; };
DEV SsdSrc ssd_decode(int u) { SsdSrc s; if (u < 512) { s.smp = false; s.b = u >> 8; s.c = (u >> 1) & 127; s.g = u & 1; } else { const int v = u - 512; s.smp = true; s.b = v >> 1; s.c = 0; s.g = v & 1; } return s; }
DEV int ssd_token(const SsdSrc& s, int l) { if (!s.smp) return s.b * SEQ + s.c * 64 + l; return l >= 48 ? TP + s.b * 16 + (l - 48) : -1; }
typedef __attribute__((address_space(3))) char* ldsp_t;

constexpr int L_ACS = 0, L_DT = 1024, L_RDT = 2048, L_TE = 3072, L_BM = 4096, L_CM = L_BM + 17408, L_BT = L_CM + 17408, L_XT = L_BT + 18432, L_XTE = L_XT + 36864;
static_assert(L_XTE + 36864 <= LDS_TOTAL, "ssd lds");

DEV void ssd_chunk_unit(const Params& p, int u, char* lds) {
    const SsdSrc s = ssd_decode(u);
    int tid = threadIdx.x; asm volatile("" : "+v"(tid)); const int lane = tid & 63, wid = tid >> 6, fr = lane & 15, fq = lane >> 4;
    unsigned char* ws = p.ws;
    const bf16_t* XBC = (const bf16_t*)(ws + W_RB); const float* DT = (const float*)(ws + W_DT);
    float* acs_l = (float*)(lds + L_ACS); float* dt_l = (float*)(lds + L_DT); float* rdt_l = (float*)(lds + L_RDT); float* te_l = (float*)(lds + L_TE);
    bf16_t* Bm = (bf16_t*)(lds + L_BM); bf16_t* Cm = (bf16_t*)(lds + L_CM); bf16_t* BTl = (bf16_t*)(lds + L_BT); bf16_t* XT = (bf16_t*)(lds + L_XT); bf16_t* XTE = (bf16_t*)(lds + L_XTE);
    const int uidx = s.smp ? 256 + s.b : s.b * 128 + s.c;
    int col, role, li; if (tid < 256) { role = 0; li = tid; col = s.g * 256 + tid; } else if (tid < 384) { role = 1; li = tid - 256; col = 512 + s.g * 128 + li; } else { role = 2; li = tid - 384; col = 768 + s.g * 128 + li; }
    const bf16_t* xcol = XBC + (size_t)(s.smp ? TP + s.b * 16 - 48 : s.b * SEQ + s.c * 64) * 1024 + col;
    const float* scol = p.state_ssd_conv + (size_t)(s.b * 3) * 1024 + col;
    auto ldb = [&](int lb, float* o) {
        if (!s.smp) {
#pragma unroll
            for (int i = 0; i < 16; ++i) o[i] = bf2f(xcol[(size_t)(lb + i) * 1024]); }
        else {
#pragma unroll
            for (int i = 0; i < 16; ++i) { const int l = lb + i; o[i] = l >= 48 ? bf2f(xcol[(size_t)l * 1024]) : (l >= 45 ? scol[(size_t)(l - 45) * 1024] : 0.f); } } };
    float x3, x2, x1;
    if (!s.smp) { const bool has = s.c > 0; const bf16_t* xh = has ? xcol : xcol + 3 * 1024;
        const float a = bf2f(xh[-3 * 1024]), bb = bf2f(xh[-2 * 1024]), cc = bf2f(xh[-1 * 1024]); x3 = has ? a : 0.f; x2 = has ? bb : 0.f; x1 = has ? cc : 0.f; }
    else { x3 = 0.f; x2 = 0.f; x1 = 0.f; }
    float xv[16]; ldb(0, xv);
    const float w0 = p.ssd_conv_w[col], w1 = p.ssd_conv_w[1024 + col], w2 = p.ssd_conv_w[2048 + col], w3 = p.ssd_conv_w[3072 + col], cb = p.ssd_conv_b[col];
    if (wid < 4) { const int h = s.g * 4 + wid; const int tok = ssd_token(s, lane);
        const float dt = tok >= 0 ? DT[(size_t)tok * 8 + h] : 0.f; const float a = -expf(p.ssd_a_log[h]);
        float v = dt * a;
#pragma unroll
        for (int o = 1; o < 64; o <<= 1) { const float t = __shfl_up(v, o); if (lane >= o) v += t; }
        const float tot = __shfl(v, 63);
        acs_l[wid * 64 + lane] = v; dt_l[wid * 64 + lane] = dt; rdt_l[wid * 64 + lane] = dt > 0.f ? 1.f / dt : 0.f; te_l[wid * 64 + lane] = expf(tot - v);
        if (tok >= 0) ((float*)(ws + W_ACS))[(size_t)tok * 8 + h] = v;
        if (lane == 63) ((float*)(ws + W_DEC))[uidx * 8 + h] = expf(tot); }
    __syncthreads();
    { const int hl = li >> 6, pp = li & 63;
      bf16_t* CG = (bf16_t*)(ws + W_CG);
#pragma unroll
      for (int lb = 0; lb < 64; lb += 16) { float xn[16];
        if (lb + 16 < 64) ldb(lb + 16, xn);
        float vv[16];
#pragma unroll
        for (int i = 0; i < 16; ++i) { const float x0 = xv[i]; const float y = cb + w0 * x3 + w1 * x2 + w2 * x1 + w3 * x0; x3 = x2; x2 = x1; x1 = x0; vv[i] = silu_f(y); }
        if (role == 0) {
#pragma unroll
            for (int i8 = 0; i8 < 16; i8 += 8) { u32x4 a, b;
#pragma unroll
                for (int q = 0; q < 4; ++q) { const int i = i8 + 2 * q, l = lb + i; const float xd0 = vv[i] * dt_l[hl * 64 + l], xd1 = vv[i + 1] * dt_l[hl * 64 + l + 1];
                    a[q] = cvtpk(xd0, xd1); b[q] = cvtpk(xd0 * te_l[hl * 64 + l], xd1 * te_l[hl * 64 + l + 1]); }
                *(u32x4*)(XT + (hl * 64 + pp) * 72 + lb + i8) = a; *(u32x4*)(XTE + (hl * 64 + pp) * 72 + lb + i8) = b; } }
        else if (role == 1) {
#pragma unroll
            for (int i8 = 0; i8 < 16; i8 += 8) { u32x4 a;
#pragma unroll
                for (int q = 0; q < 4; ++q) { const int i = i8 + 2 * q, l = lb + i; const unsigned pk = cvtpk(vv[i], vv[i + 1]); a[q] = pk;
                    Bm[l * 136 + li] = (bf16_t)(pk & 0xffffu); Bm[(l + 1) * 136 + li] = (bf16_t)(pk >> 16); }
                *(u32x4*)(BTl + li * 72 + lb + i8) = a; } }
        else {
#pragma unroll
            for (int i = 0; i < 16; ++i) { const int l = lb + i; const bf16_t bv = f2bf(vv[i]); Cm[l * 136 + li] = bv; const int tok = ssd_token(s, l); if (tok >= 0) CG[(size_t)tok * 256 + s.g * 128 + li] = bv; } }
        if (lb + 16 < 64) {
#pragma unroll
            for (int i = 0; i < 16; ++i) xv[i] = xn[i]; } } }
    __syncthreads();
    const int hl = wid >> 1, half = wid & 1, h = s.g * 4 + hl; const float dsk = p.ssd_d[h];
    bf16_t* YD = (bf16_t*)(ws + W_RA);
    const bf16_t* XTh = XT + hl * 64 * 72; const bf16_t* XTEh = XTE + hl * 64 * 72;
#pragma unroll
    for (int lti = 0; lti < 2; ++lti) { const int lt = half * 2 + lti; const int l = lt * 16 + fr; const float acl = acs_l[hl * 64 + l];
        u32x2 pk[4];
#pragma unroll
        for (int st = 0; st < 4; ++st) { pk[st] = (u32x2){0u, 0u};
            if (st <= lt) { f32x4 c = (f32x4){0.f, 0.f, 0.f, 0.f};
#pragma unroll
                for (int k = 0; k < 4; ++k) { const bf16x8 a = *(const bf16x8*)(Bm + (st * 16 + fr) * 136 + k * 32 + fq * 8), bb = *(const bf16x8*)(Cm + l * 136 + k * 32 + fq * 8);
                    c = __builtin_amdgcn_mfma_f32_16x16x32_bf16(a, bb, c, 0, 0, 0); }
                float e[4];
#pragma unroll
                for (int j = 0; j < 4; ++j) { const int sp = st * 16 + fq * 4 + j; e[j] = (l >= sp) ? c[j] * __expf(acl - acs_l[hl * 64 + sp]) : 0.f; }
                pk[st] = (u32x2){cvtpk(e[0], e[1]), cvtpk(e[2], e[3])}; } }
        const int tok = ssd_token(s, l);
#pragma unroll
        for (int pt = 0; pt < 4; ++pt) { f32x4 y = (f32x4){0.f, 0.f, 0.f, 0.f};
#pragma unroll
            for (int i = 0; i < 2; ++i) { if (2 * i <= lt) {
                const u32x2 x0 = *(const u32x2*)(XTh + (pt * 16 + fr) * 72 + i * 32 + fq * 4), x1 = *(const u32x2*)(XTh + (pt * 16 + fr) * 72 + i * 32 + 16 + fq * 4);
                const u32x4 av = (u32x4){x0[0], x0[1], x1[0], x1[1]}, bv = (u32x4){pk[2 * i][0], pk[2 * i][1], pk[2 * i + 1][0], pk[2 * i + 1][1]};
                y = __builtin_amdgcn_mfma_f32_16x16x32_bf16(__builtin_bit_cast(bf16x8, av), __builtin_bit_cast(bf16x8, bv), y, 0, 0, 0); } }
            if (tok >= 0) { const float rd = rdt_l[hl * 64 + l] * dsk; f32x4 o;
#pragma unroll
                for (int j = 0; j < 4; ++j) o[j] = y[j] + bf2f(XTh[(pt * 16 + fq * 4 + j) * 72 + l]) * rd;
                *(u32x2*)(YD + (size_t)tok * 512 + h * 64 + pt * 16 + fq * 4) = (u32x2){cvtpk(o[0], o[1]), cvtpk(o[2], o[3])}; } } }
    float* CS = s.smp ? (float*)(ws + W_CSS) + ((size_t)s.b * 8 + h) * 8192 : p.out + O_Y + ((size_t)(s.b * 128 + s.c) * 8 + h) * 8192;
#pragma unroll
    for (int nti = 0; nti < 4; ++nti) { const int nt = half * 4 + nti;
#pragma unroll
        for (int pt = 0; pt < 4; ++pt) { f32x4 c = (f32x4){0.f, 0.f, 0.f, 0.f};
#pragma unroll
            for (int i = 0; i < 2; ++i) { const bf16x8 a = *(const bf16x8*)(BTl + (nt * 16 + fr) * 72 + i * 32 + fq * 8), bb = *(const bf16x8*)(XTEh + (pt * 16 + fr) * 72 + i * 32 + fq * 8);
                c = __builtin_amdgcn_mfma_f32_16x16x32_bf16(a, bb, c, 0, 0, 0); }
            *(f32x4*)(CS + (size_t)(pt * 16 + fr) * 128 + nt * 16 + fq * 4) = c; } }
    __syncthreads();
}

DEV void ssd_scan(const Params& p, float* dummy = nullptr) {
    unsigned char* ws = p.ws; const float* DEC = (const float*)(ws + W_DEC);
    if (threadIdx.x < 256) {
        typedef __attribute__((ext_vector_type(2))) float f32x2v;
        for (int e2 = blockIdx.x * 256 + threadIdx.x; e2 < 2 * 32768; e2 += gridDim.x * 256) { const int e = e2 * 2, b = e >> 16, rest = e & 65535, h = rest >> 13;
            float* cs = p.out + O_Y + (size_t)b * 128 * 65536 + rest; float* cd = dummy ? dummy + (size_t)b * 128 * 65536 + rest : cs; f32x2v sv = (f32x2v){0.f, 0.f};
#pragma unroll 32
            for (int c = 0; c < 128; ++c) { const f32x2v t = *(const f32x2v*)(cs + (size_t)c * 65536); *(f32x2v*)(cd + (size_t)c * 65536) = sv; sv = sv * DEC[(b * 128 + c) * 8 + h] + t; }
            *(f32x2v*)((dummy ? dummy : p.out + O_PSSD) + e) = sv; }
    } else {
        for (int e4 = blockIdx.x * 256 + (threadIdx.x - 256); e4 < 16 * 16384; e4 += gridDim.x * 256) { const int e = e4 * 4, b = e >> 16, h = (e >> 13) & 7;
            const f32x4 s0 = *(const f32x4*)(p.state_ssd + e), c0 = *(const f32x4*)((const float*)(ws + W_CSS) + e);
            *(f32x4*)((dummy ? dummy : p.out + O_SSSD) + e) = s0 * DEC[(256 + b) * 8 + h] + c0; }
    }
}

DEV void ssd_final_unit(const Params& p, int u, char* lds) {
    const SsdSrc s = ssd_decode(u);
    int tid = threadIdx.x; asm volatile("" : "+v"(tid)); const int lane = tid & 63, wid = tid >> 6, fr = lane & 15, fq = lane >> 4;
    unsigned char* ws = p.ws;
    const int hl = wid >> 1, half = wid & 1, h = s.g * 4 + hl;
    float* ssl = (float*)lds;
    const float* sp = s.smp ? p.state_ssd + ((size_t)s.b * 8 + h) * 8192 : p.out + O_Y + ((size_t)(s.b * 128 + s.c) * 8 + h) * 8192;
    const bf16_t* CG = (const bf16_t*)(ws + W_CG); const bf16_t* YD = (const bf16_t*)(ws + W_RA); const float* ACS = (const float*)(ws + W_ACS);
    const bf16_t* Z = (const bf16_t*)(ws + W_Z); bf16_t* MIX = (bf16_t*)(ws + W_RB);
    if (s.smp) { const int r = tid >> 5, c8 = (tid & 31) * 8;
        *(u32x4*)(MIX + (size_t)(TP + s.b * 16 + r) * 1024 + 512 + s.g * 256 + c8) = *(const u32x4*)((const bf16_t*)(ws + W_SATT) + (size_t)(s.b * 16 + r) * 512 + s.g * 256 + c8); }
    f32x4 acc[2][4]; int tok[2]; bool tv[2];
#pragma unroll
    for (int lti = 0; lti < 2; ++lti) { tok[lti] = ssd_token(s, (half * 2 + lti) * 16 + fr); tv[lti] = !s.smp || (half * 2 + lti == 3);
#pragma unroll
        for (int pt = 0; pt < 4; ++pt) acc[lti][pt] = (f32x4){0.f, 0.f, 0.f, 0.f}; }
    f32x4 yd[2][4]; u32x2 zz[2][4]; float ea[2] = {0.f, 0.f}; f32x4 ng[4];
#pragma unroll
    for (int pt = 0; pt < 4; ++pt) ng[pt] = *(const f32x4*)(p.ssd_norm_g + h * 64 + pt * 16 + fq * 4);
#pragma unroll
    for (int lti = 0; lti < 2; ++lti) if (tv[lti]) { ea[lti] = ACS[(size_t)tok[lti] * 8 + h];
#pragma unroll
        for (int pt = 0; pt < 4; ++pt) { const int ch = h * 64 + pt * 16 + fq * 4; { const u32x2 yb = *(const u32x2*)(YD + (size_t)tok[lti] * 512 + ch); yd[lti][pt] = (f32x4){bflo(yb[0]), bfhi(yb[0]), bflo(yb[1]), bfhi(yb[1])}; } zz[lti][pt] = *(const u32x2*)(Z + (size_t)tok[lti] * 512 + ch); } }
    if (tv[0] || tv[1]) {
#pragma unroll
        for (int k = 0; k < 4; ++k) { bf16x8 cb[2];
#pragma unroll
            for (int lti = 0; lti < 2; ++lti) { u32x4 t = (u32x4){0u, 0u, 0u, 0u}; if (tv[lti]) t = *(const u32x4*)(CG + (size_t)tok[lti] * 256 + s.g * 128 + k * 32 + fq * 8); cb[lti] = __builtin_bit_cast(bf16x8, t); }
#pragma unroll
            for (int pt = 0; pt < 4; ++pt) { const float* r = sp + (size_t)(pt * 16 + fr) * 128 + k * 32 + fq * 8; const f32x4 a0 = *(const f32x4*)r, a1 = *(const f32x4*)(r + 4);
                const u32x4 av = (u32x4){cvtpk(a0[0], a0[1]), cvtpk(a0[2], a0[3]), cvtpk(a1[0], a1[1]), cvtpk(a1[2], a1[3])};
#pragma unroll
                for (int lti = 0; lti < 2; ++lti) if (tv[lti]) acc[lti][pt] = __builtin_amdgcn_mfma_f32_16x16x32_bf16(__builtin_bit_cast(bf16x8, av), cb[lti], acc[lti][pt], 0, 0, 0); } } }
#pragma unroll
    for (int lti = 0; lti < 2; ++lti) { const int l = (half * 2 + lti) * 16 + fr; float ss = 0.f;
        if (tv[lti]) { const float eav = __expf(ea[lti]);
#pragma unroll
            for (int pt = 0; pt < 4; ++pt) { const u32x2 z2 = zz[lti][pt];
                const float z0 = bflo(z2[0]), z1 = bfhi(z2[0]), z2f = bflo(z2[1]), z3 = bfhi(z2[1]);
                f32x4 y = yd[lti][pt] + acc[lti][pt] * eav; y[0] *= silu_f(z0); y[1] *= silu_f(z1); y[2] *= silu_f(z2f); y[3] *= silu_f(z3);
                acc[lti][pt] = y; ss += y[0] * y[0] + y[1] * y[1] + y[2] * y[2] + y[3] * y[3]; }
            ss += __shfl_xor(ss, 16); ss += __shfl_xor(ss, 32);
            if (fq == 0) ssl[l * 4 + hl] = ss; } }
    __syncthreads();
#pragma unroll
    for (int lti = 0; lti < 2; ++lti) { const int l = (half * 2 + lti) * 16 + fr;
        if (tv[lti]) { const f32x4 q = *(const f32x4*)(ssl + l * 4); const float rs = rsqrtf((q[0] + q[1] + q[2] + q[3]) * (1.f / 256.f) + EPS);
#pragma unroll
            for (int pt = 0; pt < 4; ++pt) { const int ch = h * 64 + pt * 16 + fq * 4; const f32x4 y = acc[lti][pt] * rs * ng[pt];
                *(u32x2*)(MIX + (size_t)tok[lti] * 1024 + ch) = (u32x2){cvtpk(y[0], y[1]), cvtpk(y[2], y[3])}; } } }
    __syncthreads();
}

namespace att {
constexpr int D = 64, QDM = 512, NW = 8, QBLK = 32, QB = QBLK * NW, KVBLK = 64, NQB = SEQ / QB, OPITCH = 1024;
constexpr float C2 = 1.0f;
constexpr int THR = 96;
constexpr int SLOTB = 8192, LDS_K = 0, LDS_V = 3 * SLOTB, LDS_WS = 6 * SLOTB, LDS_OST = LDS_WS + NW * 256, LDS_BYTES = LDS_OST + NW * 4096, LDS_GB = LDS_BYTES;
static_assert(LDS_GB + SEQ * 4 <= LDS_TOTAL, "attention lds");
#define SBAR() __builtin_amdgcn_sched_barrier(0)
#define PIN(x) asm volatile("" : "+v"(x))
#define MFMA(a, b, c) __builtin_amdgcn_mfma_f32_32x32x16_bf16(a, b, c, 0, 0, 0)
#define WAIT_BAR(N) asm volatile("s_waitcnt vmcnt(" #N ") lgkmcnt(0)\n\ts_barrier" ::: "memory")
DEV int crow(int r, int hi) { return (r & 3) + 8 * (r >> 2) + 4 * hi; }
DEV void glds16(const void* g, unsigned lds_base) {
    unsigned sv; asm volatile("s_mov_b32 %0, m0\n\ts_mov_b32 m0, %2\n\ts_nop 0\n\tglobal_load_lds_dwordx4 %1, off\n\ts_mov_b32 m0, %0" : "=&s"(sv) : "v"(g), "s"(lds_base) : "memory"); }
typedef __attribute__((address_space(3))) const char* lds_cptr;
typedef short v4i16_t __attribute__((ext_vector_type(4)));
DEV void kload2(bf16x8* kf, lds_cptr kp, int d0) { kf[2 * d0] = *(const __attribute__((address_space(3))) bf16x8*)(kp + d0 * 2048); kf[2 * d0 + 1] = *(const __attribute__((address_space(3))) bf16x8*)(kp + d0 * 2048 + 512); }
DEV s16x4 vtr(lds_cptr p) { return __builtin_bit_cast(s16x4, __builtin_amdgcn_ds_read_tr16_b64_v4i16((__attribute__((address_space(3))) v4i16_t*)p)); }
#define MX3(a, b, c) __builtin_fmaxf(__builtin_fmaxf((a), (b)), (c))
DEV float rowmax(const f32x16& p0, const f32x16& p1) {
    float a = MX3(p0[0], p0[1], p1[0]), b = MX3(p0[2], p0[3], p1[1]); a = MX3(a, p1[2], p1[3]);
#pragma unroll
    for (int r = 4; r < 16; r += 4) { a = MX3(a, p0[r], p0[r + 1]); b = MX3(b, p0[r + 2], p0[r + 3]); a = MX3(a, p1[r], p1[r + 1]); b = MX3(b, p1[r + 2], p1[r + 3]); }
    float m = __builtin_fmaxf(a, b); auto rr = __builtin_amdgcn_permlane32_swap(__float_as_uint(m), __float_as_uint(m), false, false);
    return __builtin_fmaxf(__uint_as_float(rr[0]), __uint_as_float(rr[1])); }
DEV void cmask(f32x16& p0, f32x16& p1, int jb, int qrel, int hi) {
    const int kb = 64 * jb + 4 * hi;
#pragma unroll
    for (int r = 0; r < 16; ++r) { const int kv = kb + (r & 3) + 8 * (r >> 2); if (kv > qrel) p0[r] = -INFINITY; if (kv + 32 > qrel) p1[r] = -INFINITY; } }
typedef __attribute__((address_space(3))) const f32x4* lds_f4p;
DEV void loadbias(f32x16& c0, f32x16& c1, lds_f4p gb, int t, int hi) {
#pragma unroll
    for (int i = 0; i < 4; ++i) { const f32x4 a = gb[16 * t + hi + 2 * i], b = gb[16 * t + 8 + hi + 2 * i];
        c0[4 * i] = a[0]; c0[4 * i + 1] = a[1]; c0[4 * i + 2] = a[2]; c0[4 * i + 3] = a[3]; c1[4 * i] = b[0]; c1[4 * i + 1] = b[1]; c1[4 * i + 2] = b[2]; c1[4 * i + 3] = b[3]; } }

DEV void attn64_unit(int b, int h, int qb, int bias_qb, const bf16_t* Q, const bf16_t* __restrict__ K, const bf16_t* __restrict__ V, const float* __restrict__ G, bf16_t* O, char* lds) {
    int tid = threadIdx.x; asm volatile("" : "+v"(tid));
    const int lane = tid & 63, r32 = lane & 31, hi = lane >> 5; const int wid = __builtin_amdgcn_readfirstlane(tid >> 6);
    const long rowbase = (long)b * SEQ; const int q0 = qb * QB, NT = (q0 + QB) / KVBLK;
    const bf16_t* Qw = Q + (rowbase + q0 + wid * QBLK) * QDM + h * D;
    const unsigned lds0 = (unsigned)(uintptr_t)lds; float* wsf = (float*)(lds + LDS_WS) + wid * 64;
    if (bias_qb >= 0) { const f32x4* src = (const f32x4*)(G + ((size_t)b * 8 + h) * SEQ); f32x4* dst = (f32x4*)(lds + LDS_GB); const int n4 = (bias_qb * QB + QB) / 4;
      for (int i = tid; i < n4; i += 512) dst[i] = src[i];
      asm volatile("s_waitcnt vmcnt(0) lgkmcnt(0)" ::: "memory"); }
    const lds_f4p gb = (lds_f4p)((lds_cptr)lds + LDS_GB);
    const bf16_t* ksrc = K + rowbase * QDM + h * D + (long)lane * QDM + wid * 8;
    const bf16_t* vsrc = V + rowbase * QDM + h * D + (long)(16 * (wid & 3) + (lane >> 2)) * QDM + (wid >> 2) * 32 + (lane & 3) * 8;
    const unsigned kdst = lds0 + LDS_K + wid * 1024, vdst = lds0 + LDS_V + wid * 1024;
#define DMA_K(t, slot) glds16(ksrc + (long)(t) * KVBLK * QDM, (unsigned)__builtin_amdgcn_readfirstlane(kdst + (slot)))
#define DMA_V(t, slot) glds16(vsrc + (long)(t) * KVBLK * QDM, (unsigned)__builtin_amdgcn_readfirstlane(vdst + (slot)))
    const lds_cptr vp0 = (lds_cptr)lds + LDS_V + ((lane >> 4) & 1) * 32 + (lane & 3) * 8 + (4 * hi + ((lane & 15) >> 2)) * 64;
    const lds_cptr kp0 = (lds_cptr)lds + LDS_K + hi * 1024 + r32 * 16;
    DMA_K(0, 0); DMA_V(0, 0); DMA_K(1, SLOTB);
    bf16x8 qr[4];
#pragma unroll
    for (int d0 = 0; d0 < 4; ++d0) qr[d0] = *reinterpret_cast<const bf16x8*>(&Qw[(long)r32 * QDM + d0 * 16 + hi * 8]);
    float mhat = 0.f, l_reg = 0.f; f32x16 o[2]; o[0] = f32x16{}; o[1] = f32x16{};
    const int qrel = wid * QBLK + r32; bool resc = false;
    f32x16 pA0, pA1, pB0, pB1; bf16x8 kf[8]; s16x4 vlo[8], vhi[8]; u32x4 pw0, pw1, pw2, pw3;
    int sl_prev = 0, sl_cur = 0, sl_next = SLOTB;
#define ROT() do { sl_prev = sl_cur; sl_cur = sl_next; sl_next = (sl_next == 2 * SLOTB) ? 0 : sl_next + SLOTB; } while (0)
#define EX(v) __builtin_amdgcn_exp2f(__builtin_fmaf((v), C2, nmh))
#define RESC() do { if (resc) { _Pragma("unroll") for (int d_ = 0; d_ < 2; ++d_) _Pragma("unroll") for (int r = 0; r < 16; ++r) o[d_][r] *= wsf[crow(r, hi)]; } } while (0)
    DMA_K(2, 2 * SLOTB);
    WAIT_BAR(3);
    _Pragma("unroll") for (int d0 = 0; d0 < 4; ++d0) kload2(kf, kp0, d0);
    loadbias(pA0, pA1, gb, 0, hi);
    pA0 = MFMA(kf[0], qr[0], pA0); pA1 = MFMA(kf[1], qr[0], pA1); pA0 = MFMA(kf[2], qr[1], pA0); pA1 = MFMA(kf[3], qr[1], pA1);
    pA0 = MFMA(kf[4], qr[2], pA0); pA1 = MFMA(kf[5], qr[2], pA1); pA0 = MFMA(kf[6], qr[3], pA0); pA1 = MFMA(kf[7], qr[3], pA1);
    if (NT == 4) cmask(pA0, pA1, 0, qrel, hi);
    { const float rm = rowmax(pA0, pA1); mhat = rm * C2; const float nmh = -mhat;
#pragma unroll
      for (int r = 0; r < 16; ++r) { pA0[r] = EX(pA0[r]); pA1[r] = EX(pA1[r]); } }
    WAIT_BAR(0);
    DMA_K(3, 0); DMA_V(1, SLOTB); ROT();
    _Pragma("unroll") for (int d0 = 0; d0 < 4; ++d0) kload2(kf, kp0 + sl_cur, d0);
    WAIT_BAR(2);
#define PKW(P, i) cvtpk(P[i], P[i + 1])
#define PAF(k) __builtin_bit_cast(bf16x8, pw##k)
#define VFR(i) (bf16x8){vlo[i][0], vlo[i][1], vlo[i][2], vlo[i][3], vhi[i][0], vhi[i][1], vhi[i][2], vhi[i][3]}
#define VRD(i) do { vlo[i] = vtr(vp_ + (((i) >> 2) * 4096 + ((i) & 3) * 1024)); vhi[i] = vtr(vp_ + (((i) >> 2) * 4096 + ((i) & 3) * 1024 + 512)); } while (0)
#define KRD(G_, d0) do { if (G_) { kload2(kf, kp0 + sl_next, d0); SBAR(); } } while (0)
#define GAPA(MF, a0, a1, a2, a3, W0, W1, PW) do { MF; sacc += a0; sacc += a1; sacc += a2; sacc += a3; W0; W1; PIN(PW); PIN(sacc); SBAR(); } while (0)
#define GAPB(MF, X, i) do { MF; X[i] = EX(X[i]); X[i + 1] = EX(X[i + 1]); X[i + 2] = EX(X[i + 2]); X[i + 3] = EX(X[i + 3]); PIN(X); SBAR(); } while (0)
#define STEP(C0, C1, P0, P1, t, MASK, GK, GV, GL) do { SBAR(); \
    const lds_cptr vp_ = vp0 + sl_prev; \
    VRD(0); SBAR(); float sacc = P0[0] + P0[1]; \
                    GAPA(C0 = MFMA(kf[0], qr[0], C0), P0[2], P0[3], P0[4], P0[5],     pw0[0] = PKW(P0, 0),  pw0[1] = PKW(P0, 2),  pw0); \
    VRD(4); SBAR(); GAPA(C1 = MFMA(kf[1], qr[0], C1), P0[6], P0[7], P0[8], P0[9],     pw0[2] = PKW(P0, 4),  pw0[3] = PKW(P0, 6),  pw0); \
    VRD(1); SBAR(); GAPA(C0 = MFMA(kf[2], qr[1], C0),    P0[10], P0[11], P0[12], P0[13], pw1[0] = PKW(P0, 8),  pw1[1] = PKW(P0, 10), pw1); \
    VRD(5); SBAR(); GAPA(C1 = MFMA(kf[3], qr[1], C1),    P0[14], P0[15], P1[0], P1[1],   pw1[2] = PKW(P0, 12), pw1[3] = PKW(P0, 14), pw1); \
    VRD(2); SBAR(); GAPA(C0 = MFMA(kf[4], qr[2], C0),    P1[2], P1[3], P1[4], P1[5],     pw2[0] = PKW(P1, 0),  pw2[1] = PKW(P1, 2),  pw2); \
    VRD(6); SBAR(); GAPA(C1 = MFMA(kf[5], qr[2], C1),    P1[6], P1[7], P1[8], P1[9],     pw2[2] = PKW(P1, 4),  pw2[3] = PKW(P1, 6),  pw2); \
    VRD(3); SBAR(); GAPA(C0 = MFMA(kf[6], qr[3], C0),    P1[10], P1[11], P1[12], P1[13], pw3[0] = PKW(P1, 8),  pw3[1] = PKW(P1, 10), pw3); \
    VRD(7); SBAR(); GAPA(C1 = MFMA(kf[7], qr[3], C1),    P1[14], P1[15], 0.f, 0.f,       pw3[2] = PKW(P1, 12), pw3[3] = PKW(P1, 14), pw3); \
    l_reg += sacc; \
    if (GK) DMA_K((t) + 3, sl_cur); if (GV) DMA_V((t) + 1, sl_next); \
    if (MASK) cmask(C0, C1, (t) - (NT - 4), qrel, hi); \
    { const float rm = __builtin_fmaf(rowmax(C0, C1), C2, -mhat); resc = false; \
      if (__any(rm > (float)THR)) { const float dl = __builtin_fmaxf(rm, 0.f); mhat += dl; \
          const float f = __builtin_amdgcn_exp2f(-dl); l_reg *= f; if (hi == 0) wsf[r32] = f; resc = true; } } \
    const float nmh = -mhat; SBAR(); \
    if (GL) { loadbias(P0, P1, gb, (t) + 1, hi); SBAR(); }            \
    GAPB(o[0] = MFMA(PAF(0), VFR(0), o[0]), C0, 0);              GAPB(o[1] = MFMA(PAF(0), VFR(4), o[1]), C0, 4); \
    KRD(GL, 0); GAPB(o[0] = MFMA(PAF(1), VFR(1), o[0]), C0, 8);  KRD(GL, 1); GAPB(o[1] = MFMA(PAF(1), VFR(5), o[1]), C0, 12); \
    KRD(GL, 2); GAPB(o[0] = MFMA(PAF(2), VFR(2), o[0]), C1, 0);  KRD(GL, 3); GAPB(o[1] = MFMA(PAF(2), VFR(6), o[1]), C1, 4); \
    GAPB(o[0] = MFMA(PAF(3), VFR(3), o[0]), C1, 8);              GAPB(o[1] = MFMA(PAF(3), VFR(7), o[1]), C1, 12); \
    } while (0)
    loadbias(pB0, pB1, gb, 1, hi);
    int t = 1;
    for (; t + 5 < NT; t += 2) {
        STEP(pB0, pB1, pA0, pA1, t, false, true, true, true);     WAIT_BAR(2); RESC(); ROT();
        STEP(pA0, pA1, pB0, pB1, t + 1, false, true, true, true); WAIT_BAR(2); RESC(); ROT();
    }
#define ENDW(tt) do { if ((tt) + 3 < NT) { WAIT_BAR(2); } else if ((tt) + 2 < NT) { WAIT_BAR(1); } else { WAIT_BAR(0); } } while (0)
    for (; t + 1 < NT; t += 2) {
        STEP(pB0, pB1, pA0, pA1, t, true, (t + 3 < NT), (t + 1 < NT), (t + 1 < NT));         ENDW(t);     RESC(); ROT();
        STEP(pA0, pA1, pB0, pB1, t + 1, true, (t + 4 < NT), (t + 2 < NT), (t + 2 < NT));     ENDW(t + 1); RESC(); ROT();
    }
    STEP(pB0, pB1, pA0, pA1, NT - 1, true, false, false, false); RESC();
    { float sacc = pB0[0] + pB0[1];
#pragma unroll
      for (int r = 2; r < 16; ++r) sacc += pB0[r];
#pragma unroll
      for (int r = 0; r < 16; ++r) sacc += pB1[r];
      l_reg += sacc;
      pw0 = (u32x4){PKW(pB0, 0), PKW(pB0, 2), PKW(pB0, 4), PKW(pB0, 6)}; pw1 = (u32x4){PKW(pB0, 8), PKW(pB0, 10), PKW(pB0, 12), PKW(pB0, 14)};
      pw2 = (u32x4){PKW(pB1, 0), PKW(pB1, 2), PKW(pB1, 4), PKW(pB1, 6)}; pw3 = (u32x4){PKW(pB1, 8), PKW(pB1, 10), PKW(pB1, 12), PKW(pB1, 14)};
      const lds_cptr vp_ = vp0 + sl_cur; _Pragma("unroll") for (int i = 0; i < 8; ++i) VRD(i);
      o[0] = MFMA(PAF(0), VFR(0), o[0]); o[1] = MFMA(PAF(0), VFR(4), o[1]); o[0] = MFMA(PAF(1), VFR(1), o[0]); o[1] = MFMA(PAF(1), VFR(5), o[1]);
      o[0] = MFMA(PAF(2), VFR(2), o[0]); o[1] = MFMA(PAF(2), VFR(6), o[1]); o[0] = MFMA(PAF(3), VFR(3), o[0]); o[1] = MFMA(PAF(3), VFR(7), o[1]); }
    { auto rr = __builtin_amdgcn_permlane32_swap(__float_as_uint(l_reg), __float_as_uint(l_reg), false, false); l_reg = __uint_as_float(rr[0]) + __uint_as_float(rr[1]); }
    if (hi == 0) wsf[32 + r32] = l_reg; asm volatile("s_waitcnt lgkmcnt(0)" ::: "memory");
    float rli[16];
#pragma unroll
    for (int r = 0; r < 16; ++r) rli[r] = __builtin_amdgcn_rcpf(wsf[32 + crow(r, hi)]);
    bf16_t* Ow = O + (rowbase + q0 + wid * QBLK) * OPITCH + h * D; bf16_t* stg = (bf16_t*)(lds + LDS_OST) + wid * 2048;
#pragma unroll
    for (int r = 0; r < 16; ++r) { const int orow = crow(r, hi);
#pragma unroll
        for (int d0 = 0; d0 < 2; ++d0) stg[orow * 64 + d0 * 32 + r32] = f2bf(o[d0][r] * rli[r]); }
    asm volatile("s_waitcnt lgkmcnt(0)" ::: "memory");
#pragma unroll
    for (int i = 0; i < 4; ++i) { const int row = i * 8 + (lane >> 3), ch = lane & 7; *(u32x4*)(Ow + (long)row * OPITCH + ch * 8) = *(const u32x4*)(stg + row * 64 + ch * 8); }
    asm volatile("s_waitcnt lgkmcnt(0)\n\ts_barrier" ::: "memory");
#undef DMA_K
#undef DMA_V
#undef ROT
#undef EX
#undef RESC
#undef PKW
#undef PAF
#undef VFR
#undef VRD
#undef KRD
#undef ENDW
#undef GAPA
#undef GAPB
#undef STEP
}
}

DEV void ffn_conv_gate(const Params& p, int hf) {
    unsigned char* ws = p.ws; const bf16_t* U = (const bf16_t*)(ws + W_U); bf16_t* ACT = (bf16_t*)(ws + W_ACT);
    const int nitems = (TA / 32) * 176;
    for (int it = blockIdx.x * 512 + threadIdx.x; it < nitems; it += gridDim.x * 512) {
        const int run = it / 176, cg8 = it % 176, row0 = run * 32; const int ja = hf * 1408 + cg8 * 8;
        const int lc = cg8 * 8, ug = (lc >> 7) * 256 + (lc & 127), uv = ug + 128;
        const bool smp = row0 >= TP;
        float wg[3][8], wv[3][8], bg[8], bv[8];
#pragma unroll
        for (int e = 0; e < 8; ++e) { bg[e] = p.ffn_conv_b[ja + e]; bv[e] = p.ffn_conv_b[DFF + ja + e];
#pragma unroll
            for (int j = 0; j < 3; ++j) { wg[j][e] = p.ffn_conv_w[j * NUP + ja + e]; wv[j][e] = p.ffn_conv_w[j * NUP + DFF + ja + e]; } }
        float g2[8], g1[8], v2[8], v1[8];
        auto unpack = [](const u32x4& a, float* o) {
#pragma unroll
            for (int e = 0; e < 4; ++e) { o[2 * e] = bflo(a[e]); o[2 * e + 1] = bfhi(a[e]); } };
        auto init_window = [&](int row) {
            if (smp) { const int b = (row - TP) >> 4; const float* s0 = p.state_ffn_conv + (size_t)(b * 2) * NUP, *s1 = s0 + NUP;
#pragma unroll
                for (int e = 0; e < 8; ++e) { g2[e] = s0[ja + e]; v2[e] = s0[DFF + ja + e]; g1[e] = s1[ja + e]; v1[e] = s1[DFF + ja + e]; } }
            else if ((row & 8191) == 0) {
#pragma unroll
                for (int e = 0; e < 8; ++e) { g2[e] = 0.f; v2[e] = 0.f; g1[e] = 0.f; v1[e] = 0.f; } }
            else { unpack(*(const u32x4*)(U + (size_t)(row - 2) * DFF + ug), g2); unpack(*(const u32x4*)(U + (size_t)(row - 2) * DFF + uv), v2);
                   unpack(*(const u32x4*)(U + (size_t)(row - 1) * DFF + ug), g1); unpack(*(const u32x4*)(U + (size_t)(row - 1) * DFF + uv), v1); } };
        init_window(row0);
#pragma unroll 4
        for (int r = 0; r < 32; ++r) { const int row = row0 + r;
            if (smp && r == 16) init_window(row);
            float g0[8], v0[8]; unpack(*(const u32x4*)(U + (size_t)row * DFF + ug), g0); unpack(*(const u32x4*)(U + (size_t)row * DFF + uv), v0);
            u32x4 o;
#pragma unroll
            for (int e = 0; e < 4; ++e) { float a[2];
#pragma unroll
                for (int q = 0; q < 2; ++q) { const int i = 2 * e + q; const float cg = bg[i] + wg[0][i] * g2[i] + wg[1][i] * g1[i] + wg[2][i] * g0[i], cv = bv[i] + wv[0][i] * v2[i] + wv[1][i] * v1[i] + wv[2][i] * v0[i];
                    a[q] = silu_f(cg) * cv; }
                o[e] = cvtpk(a[0], a[1]); }
            *(u32x4*)(ACT + (size_t)row * DFF + ja) = o;
#pragma unroll
            for (int e = 0; e < 8; ++e) { g2[e] = g1[e]; g1[e] = g0[e]; v2[e] = v1[e]; v1[e] = v0[e]; }
        }
    }
}

#define XB_TMO      128
#define XB_XCNT(j)  (256  + 64 * (j))
#define XB_XSUB(j)  (1280 + 64 * (j))
#define XB_XGEN(j)  (2304 + 64 * (j))
#define XB_TOP      3328
#define XB_TOPGEN   3392
#define XCD_BAR_WORDS 3456
#define XB_SPIN_CAP (1u << 18)
#define LAS __attribute__((address_space(3)))
DEV unsigned xb_ld(unsigned* p)              { return __hip_atomic_load(p, __ATOMIC_RELAXED, __HIP_MEMORY_SCOPE_AGENT); }
DEV unsigned xb_add(unsigned* p, unsigned v) { return __hip_atomic_fetch_add(p, v, __ATOMIC_RELAXED, __HIP_MEMORY_SCOPE_AGENT); }
DEV unsigned xb_xcc_id() { return (unsigned)__builtin_amdgcn_s_getreg((3 << 11) | 20) & 0xFu; }
#define XB_SPIN(cond, bar) do { unsigned _sp = 0; while (cond) { __builtin_amdgcn_s_sleep(1); \
    if ((++_sp & 255u) == 0u) { if (xb_ld(&(bar)[XB_TMO])) break; if (_sp > XB_SPIN_CAP) { atomicAdd(&(bar)[XB_TMO], 1u); break; } } } } while (0)
struct XcdBarrier { unsigned* bar; unsigned x; volatile LAS unsigned* st; };
DEV XcdBarrier xcd_barrier_post(unsigned* bar, volatile LAS unsigned* st) {
    XcdBarrier b; b.bar = bar; b.x = xb_xcc_id(); b.st = st;
    if (threadIdx.x == 0) (void)xb_add(&bar[XB_XCNT(b.x)], 1u);
    return b;
}
DEV void xcd_barrier_complete(unsigned* bar, unsigned x, unsigned& nloc, unsigned& nx) {
    const unsigned G = gridDim.x * gridDim.y * gridDim.z;
    unsigned sum, cnt, mine, sp = 0u;
    for (;;) {
        sum = 0u; cnt = 0u; mine = 0u;
#pragma unroll
        for (unsigned j = 0; j < 16; ++j) { const unsigned c = xb_ld(&bar[XB_XCNT(j)]); sum += c; cnt += (c > 0u) ? 1u : 0u; mine = (j == x) ? c : mine; }
        if (sum == G) break;
        __builtin_amdgcn_s_sleep(1);
        if ((++sp & 255u) == 0u) { if (xb_ld(&bar[XB_TMO])) break; if (sp > XB_SPIN_CAP) { atomicAdd(&bar[XB_TMO], 1u); break; } }
    }
    nloc = mine > 0u ? mine : 1u; nx = cnt > 0u ? cnt : 1u;
}
DEV void xcd_barrier(const XcdBarrier& b) {
    asm volatile("s_waitcnt vmcnt(0)" ::: "memory");
    __syncthreads();
    if (threadIdx.x == 0) {
        unsigned* bar = b.bar;
        __builtin_amdgcn_s_waitcnt(0);
        unsigned nloc = b.st[0], nx = b.st[1];
        if (nloc == 0u) { xcd_barrier_complete(bar, b.x, nloc, nx); b.st[0] = nloc; b.st[1] = nx; }
        const unsigned old = xb_add(&bar[XB_XSUB(b.x)], 1u);
        const unsigned gen = old / nloc;
        if (old + 1u == (gen + 1u) * nloc) {
            __builtin_amdgcn_fence(__ATOMIC_RELEASE, "agent");
            asm volatile("s_waitcnt vmcnt(0)" ::: "memory");
            const unsigned og = xb_add(&bar[XB_TOP], 1u);
            const unsigned tg = og / nx;
            if (og + 1u == (tg + 1u) * nx) xb_add(&bar[XB_TOPGEN], 1u);
            else XB_SPIN(xb_ld(&bar[XB_TOPGEN]) == tg, bar);
            __builtin_amdgcn_fence(__ATOMIC_ACQUIRE, "agent");
            xb_add(&bar[XB_XGEN(b.x)], 1u);
            asm volatile("s_waitcnt vmcnt(0)" ::: "memory");
        } else {
            XB_SPIN(xb_ld(&bar[XB_XGEN(b.x)]) == gen, bar);
            __builtin_amdgcn_fence(__ATOMIC_ACQUIRE, "agent");
            asm volatile("s_waitcnt vmcnt(0)" ::: "memory");
        }
    }
    __syncthreads();
}

struct EpiDownNorm {
    const bf16_t* Hb; float* X; unsigned* cnt; unsigned* tmo; const float* g; float* Y; char* lds;
    DEV void operator()(f32x4 (&acc)[2][2][4][2], int pm, int pn, int wr, int wc, int fr, int fq) const {
        float* Pl = (float*)lds; float* Sl = (float*)(lds + 4096);
        EPI_LOOP_BEGIN
            float ss = 0.f;
            EPI_COLS_BEGIN
                const u32x2 hb = *(const u32x2*)(Hb + (size_t)row * 1024 + col); const f32x4 h = v + (f32x4){bflo(hb[0]), bfhi(hb[0]), bflo(hb[1]), bfhi(hb[1])};
                acc[ai][bj][m][n] = h; ss += h[0] * h[0] + h[1] * h[1] + h[2] * h[2] + h[3] * h[3];
            }
            ss += __shfl_xor(ss, 16); ss += __shfl_xor(ss, 32);
            if (fq == 0) Pl[(row - pm * BM) * 4 + wc] = ss;
        }
        __syncthreads();
        int tid = threadIdx.x; asm volatile("" : "+v"(tid));
        if (tid < 256) { const f32x4 q = *(const f32x4*)(Pl + tid * 4); __hip_atomic_store(X + ((size_t)pm * 256 + tid) * 4 + pn, (q[0] + q[1]) + (q[2] + q[3]), __ATOMIC_RELAXED, __HIP_MEMORY_SCOPE_AGENT); }
        asm volatile("s_waitcnt vmcnt(0)" ::: "memory");
        __syncthreads();
        if (tid == 0) { (void)xb_add(cnt + pm * 16, 1u); unsigned sp = 0u;
            while (xb_ld(cnt + pm * 16) < 4u) { __builtin_amdgcn_s_sleep(1); if (++sp > (1u << 20)) { atomicAdd(tmo, 1u); break; } } }
        __syncthreads();
        if (tid < 256) { const float* xs = X + ((size_t)pm * 256 + tid) * 4; float q[4];
#pragma unroll
            for (int i = 0; i < 4; ++i) q[i] = __hip_atomic_load(xs + i, __ATOMIC_RELAXED, __HIP_MEMORY_SCOPE_AGENT);
            Sl[tid] = rsqrtf(((q[0] + q[1]) + (q[2] + q[3])) * (1.f / 1024.f) + EPS); }
        __syncthreads();
        EPI_LOOP_BEGIN
            const float rs = Sl[row - pm * BM];
            EPI_COLS_BEGIN
                const f32x4 gg = *(const f32x4*)(g + col);
                *(f32x4*)(Y + (size_t)row * 1024 + col) = v * rs * gg;
            }
        }
        __syncthreads();
    }
};
struct SampleNormPost {
    float* Y; float* SS; const float* g; unsigned* cnt; char* lds;
    DEV void operator()(int mt) const {
        int tid = threadIdx.x; asm volatile("" : "+v"(tid)); const int rg = mt & 7;
        unsigned* flag = (unsigned*)(lds + 36864);
        __builtin_amdgcn_fence(__ATOMIC_RELEASE, "agent"); asm volatile("s_waitcnt vmcnt(0)" ::: "memory");
        __syncthreads();
        if (tid == 0) *flag = xb_add(cnt + (64 + rg) * 16, 1u);
        __syncthreads();
        if (*flag == 31u) {
            __builtin_amdgcn_fence(__ATOMIC_ACQUIRE, "agent"); asm volatile("s_waitcnt vmcnt(0)" ::: "memory");
            const int row = TP + rg * 32 + (tid >> 4);
            const float ssv = __hip_atomic_load(SS + row, __ATOMIC_RELAXED, __HIP_MEMORY_SCOPE_AGENT); const float rs = rsqrtf(ssv * (1.f / 1024.f) + EPS);
#pragma unroll 4
            for (int i = 0; i < 16; ++i) { const int col = ((tid & 15) + 16 * i) * 4; float* yp = Y + (size_t)row * 1024 + col; const f32x4 gg = *(const f32x4*)(g + col); *(f32x4*)yp = *(const f32x4*)yp * rs * gg; }
        }
        __syncthreads();
    }
};

#ifndef PROBE
#define PROBE 0
#endif
template <int PH> DEV void run_phase(const Params& p, char* lds) {
    unsigned char* ws = p.ws;
    if constexpr (PH == 0) { phase0(p, lds); }
    else if constexpr (PH == 1) { EpiIn e{(bf16_t*)(ws + W_Z), (bf16_t*)(ws + W_RB), (bf16_t*)(ws + W_Q), (bf16_t*)(ws + W_K), (bf16_t*)(ws + W_V), p.out};
        EpiInE ee{(bf16_t*)(ws + W_Z), (bf16_t*)(ws + W_RB), (bf16_t*)(ws + W_Q), (bf16_t*)(ws + W_K), (bf16_t*)(ws + W_V), p.out};
        sample_gemm<3>((const bf16_t*)(ws + W_RA), (const bf16_t*)(ws + W_WIN), 3072, 1024, ee, lds);
        gemm_phase((const bf16_t*)(ws + W_RA), (const bf16_t*)(ws + W_WIN), TP, 3072, 1024, e); }
    else if constexpr (PH == 2) {
        for (int u = (int)blockIdx.x + ((2 + 128 + 544 - 1 - (int)blockIdx.x) / (int)gridDim.x) * (int)gridDim.x; u >= 0; u -= (int)gridDim.x) {
#ifndef P2_MASK
#define P2_MASK 7
#endif
#ifndef P2_REP
#define P2_REP 0
#endif
            if (u < 544) { for (int rep = 0; rep < ((P2_REP & 4) ? 2 : 1); ++rep) ssd_chunk_unit(p, u, lds); }
            else if (u < 672) { for (int rep = 0; rep < ((P2_REP & 2) ? 2 : 1); ++rep) sample_attn_unit(p, (u - 544) >> 3, (u - 544) & 7, lds); }
            else { for (int rep = 0; rep < ((P2_REP & 1) ? 2 : 1); ++rep) cumsum_prompt_unit(p, u - 672, lds); }
        }
        weight_units_on_idle(p, 192, 608, 162, lds); }
    else if constexpr (PH == 3) {
#ifndef NO_SCAN
#if PROBE == 101
        ssd_scan(p, (float*)(ws + W_ACT + (size_t)16 * 1024 * 1024));
#endif
        ssd_scan(p);
#endif
#ifndef ATT_REP
#define ATT_REP 1
#endif
        for (int rep = 0; rep < ATT_REP; ++rep)
        for (int u = blockIdx.x; u < 256; u += gridDim.x) {
            const int x = u & 7, kk = u >> 3, bh = x + 8 * (kk / 16), j = kk % 16;
            att::attn64_unit(bh >> 3, bh & 7, j, att::NQB - 1 - j, (const bf16_t*)(ws + W_Q), (const bf16_t*)(ws + W_K), (const bf16_t*)(ws + W_V), (const float*)(ws + W_G), (bf16_t*)(ws + W_RB) + 512, lds);
            att::attn64_unit(bh >> 3, bh & 7, att::NQB - 1 - j, -1, (const bf16_t*)(ws + W_Q), (const bf16_t*)(ws + W_K), (const bf16_t*)(ws + W_V), (const float*)(ws + W_G), (bf16_t*)(ws + W_RB) + 512, lds); } }
    else if constexpr (PH == 4) { for (int u = blockIdx.x; u < 544; u += gridDim.x) ssd_final_unit(p, u, lds);
    }
    else if constexpr (PH == 5) { EpiOut e{p.x_prompt, p.x_sample, p.out + O_Y, (bf16_t*)(ws + W_RA), (float*)(ws + W_SS2)};
        EpiResE ee{p.x_sample - (size_t)TP * 1024, nullptr, nullptr, (bf16_t*)(ws + W_RA), (float*)(ws + W_SS2)};
        sample_gemm((const bf16_t*)(ws + W_RB), (const bf16_t*)(ws + W_WOUT), 1024, 1024, ee, lds);
        gemm_phase((const bf16_t*)(ws + W_RB), (const bf16_t*)(ws + W_WOUT), TP, 1024, 1024, e); }
    else if constexpr (PH == 6) { EpiUpFused e{(const float*)(ws + W_SS2), p.out, (bf16_t*)(ws + W_ACT), (bf16_t*)(ws + W_HALO), p.ffn_conv_w, p.ffn_conv_b, p.state_ffn_conv, lds};
        gemm_phase((const bf16_t*)(ws + W_RA), (const bf16_t*)(ws + W_WUP), TA, NUP, 1024, e);
        weight_units_on_idle(p, 608, 784, 150, lds); }
    else if constexpr (PH == 10) {
        EpiDownNorm e{(const bf16_t*)(ws + W_RA), (float*)(ws + W_DT), (unsigned*)(ws + W_CNT), (unsigned*)(ws + W_BAR) + XB_TMO, p.final_norm_g, p.out + O_Y, lds};
        EpiResE ee{nullptr, (const bf16_t*)(ws + W_RA), p.out + O_Y, nullptr, (float*)(ws + W_SS3)};
        sample_gemm((const bf16_t*)(ws + W_ACT), (const bf16_t*)(ws + W_WDN), 1024, DFF, ee, lds);
        gemm_phase((const bf16_t*)(ws + W_ACT), (const bf16_t*)(ws + W_WDN), TP, 1024, DFF, e, FfnFixup{&p}); }
    else if constexpr (PH == 11) { const int lane = threadIdx.x & 63, wid = threadIdx.x >> 6; const float* SS = (const float*)(ws + W_SS3);
        for (int row = TP + blockIdx.x * 8 + wid; row < TA; row += gridDim.x * 8) { const float rs = rsqrtf(SS[row] * (1.f / 1024.f) + EPS); float* yr = p.out + O_Y + (size_t)row * 1024;
#pragma unroll
            for (int i = 0; i < 4; ++i) { const f32x4 g = *(const f32x4*)(p.final_norm_g + i * 256 + lane * 4); f32x4 x = *(f32x4*)(yr + i * 256 + lane * 4); x = x * rs * g; *(f32x4*)(yr + i * 256 + lane * 4) = x; } } }
}
constexpr int NPH = 12;

#ifndef N_LAUNCH_SPLIT
#define N_LAUNCH_SPLIT 0
#endif
#if N_LAUNCH_SPLIT
template <int PH> __global__ void __launch_bounds__(512) ph_kernel(Params p) {
    extern __shared__ __attribute__((aligned(16))) bf16_t shm[];
    run_phase<PH>(p, (char*)shm);
}
template <int PH> static void launch_ph(const Params& p, int grid, hipStream_t stream) {
    (void)hipFuncSetAttribute((const void*)ph_kernel<PH>, hipFuncAttributeMaxDynamicSharedMemorySize, LDS_TOTAL);
    hipLaunchKernelGGL(ph_kernel<PH>, dim3(grid), dim3(512), LDS_TOTAL, stream, p);
}
#else
__global__ void __launch_bounds__(512) hymba_fwd(Params p) {
    extern __shared__ __attribute__((aligned(16))) bf16_t shm[];
    __shared__ uint4 xb_words;
    char* lds = (char*)shm;
    if (threadIdx.x == 0) xb_words = make_uint4(0u, 0u, 0u, 0u);
    __syncthreads();
    const XcdBarrier bar = xcd_barrier_post((unsigned*)(p.ws + W_BAR), (volatile LAS unsigned*)&xb_words);
#ifndef REP_PH
#define REP_PH -1
#endif
#define RUN(PH) do { run_phase<PH>(p, lds); if (REP_PH == PH) { xcd_barrier(bar); run_phase<PH>(p, lds); } } while (0)
    RUN(0); xcd_barrier(bar);
    RUN(1); xcd_barrier(bar);
    RUN(2); xcd_barrier(bar);
    RUN(3); xcd_barrier(bar);
    RUN(4); xcd_barrier(bar);
    RUN(5); xcd_barrier(bar);
    RUN(6); xcd_barrier(bar);
    RUN(10); xcd_barrier(bar);
    RUN(11);
}
#endif

extern "C" void kernel_launch(void* const* d_in, const int* in_sizes, int n_in, void* d_out, int out_size, void* d_ws, size_t ws_size, hipStream_t stream) {
    static int grid_blocks = 0;
    if (!grid_blocks) {
        if (n_in != 24 || (size_t)out_size != O_END || ws_size < W_END) { fprintf(stderr, "kernel_launch: unexpected sizes n_in %d out %d (want %zu) ws %zu (want %zu)\n", n_in, out_size, (size_t)O_END, ws_size, (size_t)W_END); }
        int dev = 0, cus = 0;
        (void)hipGetDevice(&dev);
        (void)hipDeviceGetAttribute(&cus, hipDeviceAttributeMultiprocessorCount, dev);
#if !N_LAUNCH_SPLIT
        int per_cu = 0;
        (void)hipFuncSetAttribute((const void*)hymba_fwd, hipFuncAttributeMaxDynamicSharedMemorySize, LDS_TOTAL);
        (void)hipOccupancyMaxActiveBlocksPerMultiprocessor(&per_cu, (const void*)hymba_fwd, 512, LDS_TOTAL);
        if (per_cu < 1) fprintf(stderr, "kernel_launch: occupancy query returned %d\n", per_cu);
#endif
        grid_blocks = cus > 0 ? cus : 256;
    }
    Params p{};
    const float** pp = (const float**)&p;
    for (int i = 0; i < 24; ++i) pp[i] = (const float*)d_in[i];
    p.out = (float*)d_out; p.ws = (unsigned char*)d_ws;
#if N_LAUNCH_SPLIT
    launch_ph<0>(p, grid_blocks, stream); launch_ph<1>(p, grid_blocks, stream); launch_ph<2>(p, grid_blocks, stream); launch_ph<3>(p, grid_blocks, stream);
    launch_ph<4>(p, grid_blocks, stream); launch_ph<5>(p, grid_blocks, stream); launch_ph<6>(p, grid_blocks, stream);
    launch_ph<10>(p, grid_blocks, stream);
#else
    (void)hipMemsetAsync((char*)d_ws + W_BAR, 0, 32768, stream);
    void* args[] = {&p};
    hipError_t e = hipLaunchCooperativeKernel((void*)hymba_fwd, dim3(grid_blocks), dim3(512), args, LDS_TOTAL, stream);
    if (e != hipSuccess) fprintf(stderr, "cooperative launch failed: %s (grid %d)\n", hipGetErrorString(e), grid_blocks);
#endif
}
```
